# Optimizing an MI355X kernel written in HIP

```python
import math
import jax, jax.numpy as jnp
from jax import lax
import numpy as np

D_MODEL = 1024
BATCH = 32
SEQ = 2048
DEPTH = 2

GRID_W = 64
CTX_LEN = 256
D_MIX = D_MODEL
D_RWKV = D_MIX // 4
RWKV_HEAD_DIM = 64
RWKV_HEADS = D_RWKV // RWKV_HEAD_DIM
DECAY_LORA = 64
ICL_LORA = 64
D_CONV = D_MIX // 4
CONV_WIDTH = 3
D_ATTN = D_MIX // 2
DIFF_HEAD_DIM = 64
DIFF_V_DIM = 2 * DIFF_HEAD_DIM
DIFF_HEADS = D_ATTN // DIFF_V_DIM
Q_BLOCK = 128
ROPE_THETA = 10000.0
ROPE_AXIS_DIM = DIFF_HEAD_DIM // 2
NORM_EPS = 1e-6
RWKV_GN_EPS = 64e-5
IN_SPLITS = (D_RWKV, D_RWKV, D_RWKV, DECAY_LORA, DECAY_LORA, ICL_LORA, ICL_LORA, D_RWKV,
             D_CONV, D_CONV, D_CONV, D_CONV,
             D_ATTN, D_ATTN, D_ATTN, D_ATTN)
D_IN = 4 * D_RWKV + 2 * DECAY_LORA + 2 * ICL_LORA + 4 * D_CONV + 4 * D_ATTN

kernel_name = 'hybrid_rwkv7_shortconv_diffattn_prefix_dit'


def rms_norm(x, g):
    xf = x.astype(jnp.float32)
    y = xf * lax.rsqrt(jnp.mean(xf * xf, axis=-1, keepdims=True) + NORM_EPS)
    return (y * g.astype(jnp.float32)).astype(x.dtype)


def modulation(cond, mod_w, mod_b):
    m = jax.nn.silu(cond) @ mod_w + mod_b
    return jnp.split(m, 3, axis=-1)


def split_projection(u):
    idx = np.cumsum(IN_SPLITS)[:-1].tolist()
    return jnp.split(u, idx, axis=-1)


def axial_rope_tables(seq_len):
    rows = seq_len // GRID_W
    row = jnp.repeat(jnp.arange(rows, dtype=jnp.float32), GRID_W)
    col = jnp.tile(jnp.arange(GRID_W, dtype=jnp.float32), rows)
    inv_freq = ROPE_THETA ** (-jnp.arange(0, ROPE_AXIS_DIM, 2, dtype=jnp.float32) / ROPE_AXIS_DIM)
    ang_r = row[:, None] * inv_freq
    ang_c = col[:, None] * inv_freq
    return (jnp.cos(ang_r), jnp.sin(ang_r), jnp.cos(ang_c), jnp.sin(ang_c))


def rotate(x, cos, sin):
    half = x.shape[-1] // 2
    x1, x2 = x[..., :half], x[..., half:]
    return jnp.concatenate([x1 * cos - x2 * sin, x2 * cos + x1 * sin], axis=-1)


def apply_axial_rope(x, tables):
    cos_r, sin_r, cos_c, sin_c = (t[None, :, None, None, :] for t in tables)
    xf = x.astype(jnp.float32)
    out = jnp.concatenate([rotate(xf[..., :ROPE_AXIS_DIM], cos_r, sin_r),
                           rotate(xf[..., ROPE_AXIS_DIM:], cos_c, sin_c)], axis=-1)
    return out.astype(x.dtype)


def to_heads(t):
    return t.reshape(t.shape[0], t.shape[1], RWKV_HEADS, RWKV_HEAD_DIM)


def rwkv_direction_inputs(parts, d, w0, w_up, a0, a_up, k_k, k_a):
    r, k, v, lw_f, lw_b, la_f, la_b, _ = parts
    lw = lw_f if d == 0 else lw_b
    la = la_f if d == 0 else la_b
    w = -jax.nn.softplus(-(w0[d] + jnp.tanh(lw) @ w_up[d])) - 0.5
    decay = jnp.exp(-jnp.exp(w))
    a = jax.nn.sigmoid(a0[d] + la @ a_up[d])
    kk = to_heads(k * k_k)
    kk = kk / jnp.maximum(jnp.linalg.norm(kk, axis=-1, keepdims=True), 1e-12)
    k_mod = k * (1.0 + (a - 1.0) * k_a)
    return (to_heads(r), to_heads(decay), to_heads(k_mod), to_heads(v), -kk, kk * to_heads(a))


def rwkv_scan(state0, terms, reverse, with_output):
    seq_terms = terms if with_output else terms[1:]
    xs = tuple(jnp.moveaxis(t, 1, 0) for t in seq_terms)

    def step(S, inp):
        w_t, k_t, v_t, a_t, b_t = inp[-5:]
        sa = jnp.einsum('bhvk,bhk->bhv', S, a_t)
        S = S * w_t[:, :, None, :] + sa[..., None] * b_t[:, :, None, :] + v_t[..., None] * k_t[:, :, None, :]
        y_t = jnp.einsum('bhvk,bhk->bhv', S, inp[0]) if with_output else None
        return S, y_t

    S, ys = lax.scan(step, state0, xs, reverse=reverse)
    return S, (jnp.moveaxis(ys, 0, 1) if with_output else None)


def rwkv_readout(ys, ks, parts, r_k, ln_g, ln_b):
    r, v, z = to_heads(parts[0]), to_heads(parts[2]), parts[7]
    y = ys[0] + ys[1]
    mu = jnp.mean(y, axis=-1, keepdims=True)
    var = jnp.mean(jnp.square(y - mu), axis=-1, keepdims=True)
    y = (y - mu) * lax.rsqrt(var + RWKV_GN_EPS)
    B, T = y.shape[0], y.shape[1]
    y = y.reshape(B, T, D_RWKV) * ln_g + ln_b
    bonus = jnp.sum(r * (ks[0] + ks[1]) * r_k, axis=-1, keepdims=True) * v
    y = y + bonus.reshape(B, T, D_RWKV)
    return y * jax.nn.silu(z)


def rwkv_mixer(lat, ctx, w0, w_up, a0, a_up, k_k, k_a, r_k, ln_g, ln_b, need_ctx_out):
    f32 = jnp.float32
    lat = [t.astype(f32) for t in lat]
    ctx = [t.astype(f32) for t in ctx]
    w0, w_up, a0, a_up, k_k, k_a, r_k, ln_g, ln_b = (
        p.astype(f32) for p in (w0, w_up, a0, a_up, k_k, k_a, r_k, ln_g, ln_b))
    B = lat[0].shape[0]
    state0 = jnp.zeros((B, RWKV_HEADS, RWKV_HEAD_DIM, RWKV_HEAD_DIM), f32)
    ys_l, ks_l, ys_c, ks_c = [], [], [], []
    for d, reverse in ((0, False), (1, True)):
        tc = rwkv_direction_inputs(ctx, d, w0, w_up, a0, a_up, k_k, k_a)
        tl = rwkv_direction_inputs(lat, d, w0, w_up, a0, a_up, k_k, k_a)
        s_ctx, y_c = rwkv_scan(state0, tc, reverse, need_ctx_out)
        _, y_l = rwkv_scan(s_ctx, tl, reverse, True)
        ys_l.append(y_l)
        ks_l.append(tl[2])
        ys_c.append(y_c)
        ks_c.append(tc[2])
    out_l = rwkv_readout(ys_l, ks_l, lat, r_k, ln_g, ln_b)
    out_c = rwkv_readout(ys_c, ks_c, ctx, r_k, ln_g, ln_b) if need_ctx_out else None
    return out_l, out_c


def short_conv_mixer(b_gate, c_gate, h, z, conv_w):
    u = c_gate * h
    T = u.shape[1]
    up = jnp.pad(u, ((0, 0), (CONV_WIDTH // 2, CONV_WIDTH // 2), (0, 0)))
    y = up[:, 0:T] * conv_w[0]
    for j in range(1, CONV_WIDTH):
        y = y + up[:, j:j + T] * conv_w[j]
    return b_gate * y * jax.nn.silu(z)


def diff_attend(q, k, v, lam, scale):
    s = jnp.einsum('bqhjd,bkhjd->bhjqk', q, k).astype(jnp.float32) * scale
    p = jax.nn.softmax(s, axis=-1)
    attn = p[:, :, 0] - lam * p[:, :, 1]
    return jnp.einsum('bhqk,bkhe->bqhe', attn.astype(v.dtype), v)


def diff_attention_mixer(lat, ctx, diff_lambda, subln_g, rope, layer_idx, need_ctx_out):
    q_l, k_l, v_l, z_l = lat
    q_c, k_c, v_c, z_c = ctx
    B, T = q_l.shape[0], q_l.shape[1]

    def qk_heads(t):
        return t.reshape(t.shape[0], t.shape[1], DIFF_HEADS, 2, DIFF_HEAD_DIM)

    def v_heads(t):
        return t.reshape(t.shape[0], t.shape[1], DIFF_HEADS, DIFF_V_DIM)

    q_l = apply_axial_rope(qk_heads(q_l), rope)
    k_l = apply_axial_rope(qk_heads(k_l), rope)
    v_l = v_heads(v_l)
    q_c, k_c, v_c = qk_heads(q_c), qk_heads(k_c), v_heads(v_c)

    lam_init = 0.8 - 0.6 * math.exp(-0.3 * layer_idx)
    lf = diff_lambda.astype(jnp.float32)
    lam = jnp.exp(jnp.sum(lf[0] * lf[1])) - jnp.exp(jnp.sum(lf[2] * lf[3])) + lam_init
    scale = DIFF_HEAD_DIM ** -0.5

    def finish(o, z):
        o = rms_norm(o, subln_g) * (1.0 - lam_init)
        return o.reshape(o.shape[0], o.shape[1], D_ATTN) * jax.nn.silu(z)

    k_all = jnp.concatenate([k_l, k_c], axis=1)
    v_all = jnp.concatenate([v_l, v_c], axis=1)
    nb = T // Q_BLOCK
    qb = jnp.moveaxis(q_l.reshape(B, nb, Q_BLOCK, DIFF_HEADS, 2, DIFF_HEAD_DIM), 1, 0)
    o = lax.map(lambda qblk: diff_attend(qblk, k_all, v_all, lam, scale), qb)
    o = jnp.moveaxis(o, 0, 1).reshape(B, T, DIFF_HEADS, DIFF_V_DIM)
    out_l = finish(o, z_l)
    out_c = finish(diff_attend(q_c, k_c, v_c, lam, scale), z_c) if need_ctx_out else None
    return out_l, out_c


def hybrid_layer(x, xc, c, c_ctx, mod_w, mod_b, pre_g, post_g, w_in, w_out,
                 rwkv_w0, rwkv_w_up, rwkv_a0, rwkv_a_up, rwkv_k_k, rwkv_k_a, rwkv_r_k,
                 rwkv_ln_g, rwkv_ln_b, conv_w, diff_lambda, diff_subln_g,
                 rope, layer_idx, need_ctx_out):
    shift, scale, gate = modulation(c, mod_w, mod_b)
    shift_c, scale_c, gate_c = modulation(c_ctx, mod_w, mod_b)
    h = rms_norm(x, pre_g) * (1.0 + scale[:, None, :]) + shift[:, None, :]
    hc = rms_norm(xc, pre_g) * (1.0 + scale_c) + shift_c
    p_l = split_projection(h @ w_in)
    p_c = split_projection(hc @ w_in)

    y_rwkv_l, y_rwkv_c = rwkv_mixer(p_l[0:8], p_c[0:8], rwkv_w0, rwkv_w_up, rwkv_a0, rwkv_a_up,
                                    rwkv_k_k, rwkv_k_a, rwkv_r_k, rwkv_ln_g, rwkv_ln_b, need_ctx_out)
    y_conv_l = short_conv_mixer(*p_l[8:12], conv_w)
    y_attn_l, y_attn_c = diff_attention_mixer(p_l[12:16], p_c[12:16], diff_lambda, diff_subln_g,
                                              rope, layer_idx, need_ctx_out)

    y_l = jnp.concatenate([y_rwkv_l.astype(x.dtype), y_conv_l, y_attn_l], axis=-1) @ w_out
    x = x + gate[:, None, :] * rms_norm(y_l, post_g)
    if need_ctx_out:
        y_conv_c = short_conv_mixer(*p_c[8:12], conv_w)
        y_c = jnp.concatenate([y_rwkv_c.astype(xc.dtype), y_conv_c, y_attn_c], axis=-1) @ w_out
        xc = xc + gate_c * rms_norm(y_c, post_g)
    return x, xc


def setup_inputs(seed: int = 0) -> dict:
    key = jax.random.key(seed)
    ks = jax.random.split(key, 24)
    f32 = jnp.float32
    L = DEPTH

    def nrm(k, shape, s):
        return jax.random.normal(k, shape, f32) * s

    return {
        'x': nrm(ks[0], (BATCH, SEQ, D_MODEL), 1.0),
        'c': nrm(ks[1], (BATCH, D_MODEL), 1.0),
        'ctx': nrm(ks[2], (BATCH, CTX_LEN, D_MODEL), 1.0),
        'c_ctx': nrm(ks[3], (D_MODEL,), 1.0),
        'mod_w': nrm(ks[4], (L, D_MODEL, 3 * D_MODEL), 0.5 * D_MODEL ** -0.5),
        'mod_b': nrm(ks[5], (L, 3 * D_MODEL), 0.01),
        'norm_pre_g': 1.0 + nrm(ks[6], (L, D_MODEL), 0.05),
        'norm_post_g': 1.0 + nrm(ks[7], (L, D_MODEL), 0.05),
        'w_in': nrm(ks[8], (L, D_MODEL, D_IN), D_MODEL ** -0.5),
        'w_out': nrm(ks[9], (L, D_MIX, D_MODEL), D_MIX ** -0.5),
        'rwkv_w0': jax.random.uniform(ks[10], (L, 2, D_RWKV), f32, -6.0, -1.0),
        'rwkv_w_up': nrm(ks[11], (L, 2, DECAY_LORA, D_RWKV), 0.05),
        'rwkv_a0': nrm(ks[12], (L, 2, D_RWKV), 0.5),
        'rwkv_a_up': nrm(ks[13], (L, 2, ICL_LORA, D_RWKV), 0.3 * ICL_LORA ** -0.5),
        'rwkv_k_k': 0.85 + nrm(ks[14], (L, D_RWKV), 0.05),
        'rwkv_k_a': 1.0 + nrm(ks[15], (L, D_RWKV), 0.05),
        'rwkv_r_k': nrm(ks[16], (L, RWKV_HEADS, RWKV_HEAD_DIM), 0.1),
        'rwkv_ln_g': 1.0 + nrm(ks[17], (L, D_RWKV), 0.05),
        'rwkv_ln_b': nrm(ks[18], (L, D_RWKV), 0.01),
        'conv_w': nrm(ks[19], (L, CONV_WIDTH, D_CONV), CONV_WIDTH ** -0.5),
        'diff_lambda': nrm(ks[20], (L, 4, DIFF_HEAD_DIM), 0.1),
        'diff_subln_g': 1.0 + nrm(ks[21], (L, DIFF_V_DIM), 0.05),
    }


def reference(x, c, ctx, c_ctx, mod_w, mod_b, norm_pre_g, norm_post_g, w_in, w_out,
              rwkv_w0, rwkv_w_up, rwkv_a0, rwkv_a_up, rwkv_k_k, rwkv_k_a, rwkv_r_k,
              rwkv_ln_g, rwkv_ln_b, conv_w, diff_lambda, diff_subln_g):
    rope = axial_rope_tables(x.shape[1])
    xc = ctx
    for l in range(DEPTH):
        x, xc = hybrid_layer(x, xc, c, c_ctx, mod_w[l], mod_b[l], norm_pre_g[l], norm_post_g[l],
                             w_in[l], w_out[l], rwkv_w0[l], rwkv_w_up[l], rwkv_a0[l], rwkv_a_up[l],
                             rwkv_k_k[l], rwkv_k_a[l], rwkv_r_k[l], rwkv_ln_g[l], rwkv_ln_b[l],
                             conv_w[l], diff_lambda[l], diff_subln_g[l],
                             rope, l, l < DEPTH - 1)
    return x
```

```cpp
#include <hip/hip_runtime.h>
#include <hip/hip_cooperative_groups.h>
#include <cstdio>
#include <cstdint>
namespace cg = cooperative_groups;

#define LAS __attribute__((address_space(3)))
typedef unsigned short bf16_t;
typedef short bf16x8 __attribute__((ext_vector_type(8)));
typedef short s16x4 __attribute__((ext_vector_type(4)));
typedef float f32x2 __attribute__((ext_vector_type(2)));
typedef float f32x4 __attribute__((ext_vector_type(4)));
typedef float f32x16 __attribute__((ext_vector_type(16)));
typedef unsigned u32x2 __attribute__((ext_vector_type(2)));
typedef unsigned u32x4 __attribute__((ext_vector_type(4)));

constexpr int DM = 1024, SEQ = 2048, CTX = 256, DIN = 4352;
constexpr int HB = 16;
constexpr int LATH = HB * SEQ;
constexpr int CTXH = HB * CTX;
constexpr int MH = LATH + CTXH;
constexpr int C_R = 0, C_K = 256, C_V = 512, C_LWF = 768, C_LWB = 832, C_LAF = 896, C_LAB = 960, C_ZR = 1024,
              C_CB = 1280, C_CC = 1536, C_CH = 1792, C_CZ = 2048, C_AQ = 2304, C_AK = 2816, C_AV = 3328, C_AZ = 3840;
constexpr float C2 = 0.125f * 1.4426950408889634f;
constexpr float NORM_EPS = 1e-6f, GN_EPS = 64e-5f;

constexpr size_t MiB = 1u << 20;
constexpr size_t WS_WIN = 1 * MiB, WS_WOUT = 18 * MiB, WS_WUP = 22 * MiB, WS_MOD = 23 * MiB, WS_ROPE = 24 * MiB, WS_XC1 = 25 * MiB,
                 WS_H = 57 * MiB, WS_P = 129 * MiB, WS_SC = 435 * MiB, WS_YS = 687 * MiB, WS_END = 759 * MiB;
static_assert(WS_WIN + 2ull * DIN * DM * 2 <= WS_WOUT && WS_H + (size_t)MH * DM * 2 <= WS_P && WS_P + (size_t)MH * DIN * 2 <= WS_SC &&
              WS_SC + 7ull * MH * 256 * 4 <= WS_YS && WS_YS + 2ull * MH * 256 * 4 <= WS_END, "ws map");
constexpr int LDS_BYTES = 131072 + 2048;

struct Ctx {
    const float *x, *c, *ctx, *c_ctx, *mod_w, *mod_b, *pre_g, *post_g, *w_in, *w_out, *w0, *w_up, *a0, *a_up, *k_k, *k_a, *r_k, *ln_g, *ln_b, *conv_w, *dlam, *subg;
    float* out;
    bf16_t *WinT, *WoutT, *WupT; float *mod, *rope, *xc1; bf16_t *H, *P, *Y; float *SC, *YS;
};

__device__ __forceinline__ unsigned cvt_pk_bf16(float lo, float hi) { unsigned r; asm volatile("v_cvt_pk_bf16_f32 %0, %1, %2" : "=v"(r) : "v"(lo), "v"(hi)); return r; }
__device__ __forceinline__ float bf_lo(unsigned w) { return __uint_as_float(w << 16); }
__device__ __forceinline__ float bf_hi(unsigned w) { return __uint_as_float(w & 0xffff0000u); }
__device__ __forceinline__ float bf2f(bf16_t b) { return __uint_as_float((unsigned)b << 16); }
__device__ __forceinline__ f32x4 ld_bf4(const bf16_t* p) { const u32x2 w = *(const u32x2*)p; return (f32x4){bf_lo(w.x), bf_hi(w.x), bf_lo(w.y), bf_hi(w.y)}; }
__device__ __forceinline__ void st_bf4(bf16_t* p, f32x4 v) { u32x2 w; w.x = cvt_pk_bf16(v[0], v[1]); w.y = cvt_pk_bf16(v[2], v[3]); *(u32x2*)p = w; }
__device__ __forceinline__ int opaque(int v) { asm volatile("" : "+v"(v)); return v; }
__device__ __forceinline__ int opaque_s(int v) { asm volatile("" : "+s"(v)); return v; }
__device__ __forceinline__ float fexp2(float x) { return __builtin_amdgcn_exp2f(x); }
__device__ __forceinline__ float frcp(float x) { return __builtin_amdgcn_rcpf(x); }
__device__ __forceinline__ float sigmoidf_(float x) { return frcp(1.f + fexp2(-1.4426950408889634f * x)); }
__device__ __forceinline__ float siluf_(float x) { return x * sigmoidf_(x); }
__device__ __forceinline__ float wave_sum(float v) {
#pragma unroll
    for (int o = 1; o < 64; o <<= 1) v += __shfl_xor(v, o);
    return v;
}
__device__ __forceinline__ float sum16(float v) {
    v += __int_as_float(__builtin_amdgcn_update_dpp(0, __float_as_int(v), 0xB1, 0xF, 0xF, true));
    v += __int_as_float(__builtin_amdgcn_update_dpp(0, __float_as_int(v), 0x4E, 0xF, 0xF, true));
    v += __int_as_float(__builtin_amdgcn_update_dpp(0, __float_as_int(v), 0x141, 0xF, 0xF, true));
    v += __int_as_float(__builtin_amdgcn_update_dpp(0, __float_as_int(v), 0x140, 0xF, 0xF, true));
    return v;
}
__device__ __forceinline__ float sum32(float v) {
#pragma unroll
    for (int o = 1; o < 32; o <<= 1) v += __shfl_xor(v, o);
    return v;
}

namespace pg8 {
constexpr int BM = 256, BK = 64, HALF = 128, HTB = HALF * BK * 2, STAGE_BYTES = 8 * HTB, NXCD = 8, WGM = 8;
__host__ __device__ __forceinline__ int lds_byte(int r, int c) { const int st = (r >> 4) * 2 + (c >> 5), rr = r & 15, cc = c & 31, ob = rr * 64 + cc * 2; return st * 1024 + (ob ^ (((ob >> 9) & 1) << 5)); }
__host__ __device__ __forceinline__ void stage_rc(int b, int& R, int& C) { const int st = b / 1024, sb = b % 1024, swz = sb ^ (((sb >> 9) & 1) << 5); R = (st >> 1) * 16 + swz / 64; C = (st & 1) * 32 + (swz % 64) / 2; }
__host__ __device__ __forceinline__ int perm32(int rho) { const int n = rho >> 4, i = rho & 15; return 8 * (i >> 2) + 4 * n + (i & 3); }
struct Unit { int pm, pn; };
struct Gemm { const bf16_t* A; const bf16_t* Bt; int M, N, K; };
struct StaticOrder {
    int nM, nN, nwg, G, c;
    __host__ __device__ void init(int M, int N, int G_, int c_) { nM = M / BM; nN = N / BM; nwg = nM * nN; G = G_; c = c_; }
    __host__ __device__ bool next(int i, Unit& u) const {
        const long L = (long)i * G + c; if (L >= nwg) return false;
        int wgid = (int)L; { const int q = nwg / NXCD, r = nwg % NXCD, xcd = wgid % NXCD, off = wgid / NXCD; wgid = (xcd < r ? xcd * (q + 1) : r * (q + 1) + (xcd - r) * q) + off; }
        const int nig = WGM * nN, gid = wgid / nig, fm = gid * WGM, gsz = (nM - fm) < WGM ? (nM - fm) : WGM;
        u.pm = fm + ((wgid % nig) % gsz); u.pn = (wgid % nig) / gsz; return true;
    }
};
struct EpiBf16 {
    static constexpr bool PERM = true;
    bf16_t* O; int ldc;
    __device__ __forceinline__ void operator()(const f32x4 (&acc)[2][2][4][2], const Unit& u, int wr, int wc, int fr, int fq) const {
        const int row0 = u.pm * BM + wr * 64 + fr, col0 = u.pn * BM + wc * 32 + 8 * fq;
        int ld = ldc; asm volatile("" : "+s"(ld));
#pragma unroll
        for (int ai = 0; ai < 2; ++ai)
#pragma unroll
            for (int m = 0; m < 4; ++m) { bf16_t* rowp = O + (size_t)(row0 + ai * HALF + m * 16) * ld + col0;
#pragma unroll
                for (int bj = 0; bj < 2; ++bj) { const f32x4 v0 = acc[ai][bj][m][0], v1 = acc[ai][bj][m][1];
                    u32x4 w; w.x = cvt_pk_bf16(v0[0], v0[1]); w.y = cvt_pk_bf16(v0[2], v0[3]); w.z = cvt_pk_bf16(v1[0], v1[1]); w.w = cvt_pk_bf16(v1[2], v1[3]);
                    *(u32x4*)(rowp + bj * HALF) = w; } }
    }
};
template <class Epi, bool ALIGN_EPI = true>
__device__ __forceinline__ void gemm_phase(LAS unsigned char* lds, const Gemm g, const StaticOrder& S, const Epi& E) {
    const int tid = opaque(threadIdx.x), wid = __builtin_amdgcn_readfirstlane(tid >> 6), lane = tid & 63, wr = wid >> 2, wc = wid & 3, fr = lane & 15, fq = lane >> 4;
    const int K = g.K, nt = K / BK;
    unsigned voffA[2], voffB[2];
#pragma unroll
    for (int i = 0; i < 2; ++i) { int R, C; stage_rc(tid * 16 + i * 8192, R, C); const int Rb = Epi::PERM ? ((R & ~31) + perm32(R & 31)) : R;
        voffA[i] = (unsigned)(R * K + C) * 2u; voffB[i] = (unsigned)(Rb * K + C) * 2u; }
    const size_t kstep = (size_t)(BK * 2);
    const size_t hstep = (size_t)HALF * K * 2;
    const size_t tstep = 2 * hstep;
    const unsigned ldsw = (unsigned)wid * 1024u;
    const int aoff = lds_byte(wr * 64 + fr, fq * 8), boff = lds_byte(wc * 32 + fr, fq * 8);
#define PG8_SA(b, h) (((b) * 2 + (h)) * HTB)
#define PG8_SB(b, h) ((4 + (b) * 2 + (h)) * HTB)
#define PG8_STAGE(bufoff, gbase, voff) do { _Pragma("unroll") for (int _i = 0; _i < 2; ++_i) \
        __builtin_amdgcn_global_load_lds((const unsigned*)((const char*)(gbase) + (voff)[_i]), (LAS unsigned*)(lds + (bufoff) + ldsw + _i * 8192), 16, 0, 0); } while (0)
#define PG8_LDA(dst, b, h) do { _Pragma("unroll") for (int m = 0; m < 4; ++m) _Pragma("unroll") for (int k = 0; k < 2; ++k) dst[m][k] = *(const LAS bf16x8*)(lds + PG8_SA(b, h) + aoff + m * 2048 + k * 1024); } while (0)
#define PG8_LDB(dst, b, h) do { _Pragma("unroll") for (int n = 0; n < 2; ++n) _Pragma("unroll") for (int k = 0; k < 2; ++k) dst[n][k] = *(const LAS bf16x8*)(lds + PG8_SB(b, h) + boff + n * 2048 + k * 1024); } while (0)
#define PG8_MMA(ai, bj, At, Bt) do { __builtin_amdgcn_s_setprio(1); _Pragma("unroll") for (int m = 0; m < 4; ++m) _Pragma("unroll") for (int n = 0; n < 2; ++n) _Pragma("unroll") for (int k = 0; k < 2; ++k) \
        acc[ai][bj][m][n] = __builtin_amdgcn_mfma_f32_16x16x32_bf16(Bt[n][k], At[m][k], acc[ai][bj][m][n], 0, 0, 0); __builtin_amdgcn_s_setprio(0); } while (0)
#define PG8_WAIT_V(n) asm volatile("s_waitcnt vmcnt(" #n ")" ::: "memory")
#define PG8_WAIT_L(n) asm volatile("s_waitcnt lgkmcnt(" #n ")" ::: "memory")
#define PG8_BAR __builtin_amdgcn_s_barrier()
#define PG8_SCHED __builtin_amdgcn_sched_barrier(0)
    Unit cur, nxt; int ui = 0;
    if (!S.next(0, cur)) return;
    f32x4 acc[2][2][4][2];
#pragma unroll
    for (int a = 0; a < 2; ++a)
#pragma unroll
        for (int b = 0; b < 2; ++b)
#pragma unroll
            for (int m = 0; m < 4; ++m)
#pragma unroll
                for (int n = 0; n < 2; ++n) acc[a][b][m][n] = (f32x4){0.f, 0.f, 0.f, 0.f};
    bf16x8 At[4][2], B0[2][2], B1[2][2];
    const char* cA = (const char*)g.A + (size_t)cur.pm * tstep; const char* cB = (const char*)g.Bt + (size_t)cur.pn * tstep;
    PG8_STAGE(PG8_SB(0, 0), cB, voffB); PG8_STAGE(PG8_SB(0, 1), cB + hstep, voffB); PG8_STAGE(PG8_SA(0, 0), cA, voffA); PG8_STAGE(PG8_SA(0, 1), cA + hstep, voffA);
    if (wr == 1) PG8_BAR;
    PG8_WAIT_V(2); PG8_BAR;
    PG8_STAGE(PG8_SB(1, 0), cB + kstep, voffB); PG8_STAGE(PG8_SA(1, 0), cA + kstep, voffA); PG8_STAGE(PG8_SB(1, 1), cB + hstep + kstep, voffB);
    PG8_WAIT_V(6); PG8_BAR;
    for (;;) {
        const bool has_next = S.next(ui + 1, nxt);
        const char* nA = has_next ? (const char*)g.A + (size_t)nxt.pm * tstep : cA; const char* nB = has_next ? (const char*)g.Bt + (size_t)nxt.pn * tstep : cB;
        for (int t = 0; t < nt; t += 2) {
            const bool last = (t == nt - 2);
            const char* a1 = cA + (size_t)(t + 1) * kstep;
            const char* a2 = last ? nA : cA + (size_t)(t + 2) * kstep; const char* b2 = last ? nB : cB + (size_t)(t + 2) * kstep;
            const char* a3 = a2 + kstep; const char* b3 = b2 + kstep;
            PG8_LDB(B0, 0, 0); PG8_LDB(B1, 0, 1); PG8_SCHED; PG8_LDA(At, 0, 0); PG8_STAGE(PG8_SA(1, 1), a1 + hstep, voffA);
            PG8_WAIT_V(8); PG8_WAIT_L(0); PG8_BAR; PG8_MMA(0, 0, At, B0); PG8_MMA(0, 1, At, B1); PG8_BAR; PG8_SCHED;
            PG8_LDA(At, 0, 1); PG8_STAGE(PG8_SB(0, 0), b2, voffB); PG8_STAGE(PG8_SB(0, 1), b2 + hstep, voffB); PG8_STAGE(PG8_SA(0, 0), a2, voffA);
            PG8_WAIT_V(8); PG8_WAIT_L(0); PG8_BAR; PG8_MMA(1, 0, At, B0); PG8_MMA(1, 1, At, B1); PG8_BAR; PG8_SCHED;
            PG8_LDB(B0, 1, 0); PG8_LDB(B1, 1, 1); PG8_SCHED; PG8_LDA(At, 1, 0); PG8_STAGE(PG8_SA(0, 1), a2 + hstep, voffA);
            PG8_WAIT_V(8); PG8_WAIT_L(0); PG8_BAR; PG8_MMA(0, 0, At, B0); PG8_MMA(0, 1, At, B1); PG8_BAR; PG8_SCHED;
            PG8_LDA(At, 1, 1); PG8_STAGE(PG8_SB(1, 0), b3, voffB); PG8_STAGE(PG8_SB(1, 1), b3 + hstep, voffB); PG8_STAGE(PG8_SA(1, 0), a3, voffA);
            PG8_WAIT_V(8); PG8_WAIT_L(0); PG8_BAR; PG8_MMA(1, 0, At, B0); PG8_MMA(1, 1, At, B1); PG8_BAR; PG8_SCHED;
        }
        if constexpr (ALIGN_EPI) { if (wr == 0) PG8_BAR; }
        E(acc, cur, wr, wc, fr, fq);
        if (!has_next) break;
#pragma unroll
        for (int a = 0; a < 2; ++a)
#pragma unroll
            for (int b = 0; b < 2; ++b)
#pragma unroll
                for (int m = 0; m < 4; ++m)
#pragma unroll
                    for (int n = 0; n < 2; ++n) acc[a][b][m][n] = (f32x4){0.f, 0.f, 0.f, 0.f};
        cur = nxt; cA = nA; cB = nB; ++ui;
        if constexpr (ALIGN_EPI) { if (wr == 1) PG8_BAR; }
    }
    PG8_WAIT_V(0);
    if constexpr (!ALIGN_EPI) { if (wr == 0) PG8_BAR; }
    PG8_BAR;
#undef PG8_SA
#undef PG8_SB
#undef PG8_STAGE
#undef PG8_LDA
#undef PG8_LDB
#undef PG8_MMA
#undef PG8_WAIT_V
#undef PG8_WAIT_L
#undef PG8_BAR
#undef PG8_SCHED
}
}

__device__ __forceinline__ void transpose_item(const float* W, int K, int N, bf16_t* WT, LAS float* scr, int item, int lane, bool qscale) {
    const int nblk = N / 32, kb = item / nblk, nb = item % nblk, k0 = 64 * kb, n0 = 32 * nb;
    const float wsc = (qscale && n0 >= C_AQ && n0 < C_AK) ? C2 : 1.f;
#pragma unroll 8
    for (int i = 0; i < 32; ++i) { const int kk = 2 * i + (lane >> 5); scr[kk * 33 + (lane & 31)] = wsc * W[(size_t)(k0 + kk) * N + n0 + (lane & 31)]; }
    asm volatile("s_waitcnt lgkmcnt(0)" ::: "memory");
    const int c = lane & 7;
#pragma unroll
    for (int j = 0; j < 4; ++j) { const int n = (lane >> 3) + 8 * j; const LAS float* s = scr + (8 * c) * 33 + n;
        u32x4 o; o.x = cvt_pk_bf16(s[0 * 33], s[1 * 33]); o.y = cvt_pk_bf16(s[2 * 33], s[3 * 33]); o.z = cvt_pk_bf16(s[4 * 33], s[5 * 33]); o.w = cvt_pk_bf16(s[6 * 33], s[7 * 33]);
        *(u32x4*)(WT + (size_t)(n0 + n) * K + k0 + 8 * c) = o; }
    asm volatile("s_waitcnt lgkmcnt(0)" ::: "memory");
}
__device__ __forceinline__ void sincos_d(double x, float& s, float& c) {
    const double q = __builtin_rint(x * 0.63661977236758134308); const double r = x - q * 1.57079632679489661923; const int qi = (int)q & 3;
    const double r2 = r * r;
    const double sp = r * (1.0 + r2 * (-1.0 / 6 + r2 * (1.0 / 120 + r2 * (-1.0 / 5040 + r2 * (1.0 / 362880 + r2 * (-1.0 / 39916800 + r2 * (1.0 / 6227020800.0)))))));
    const double cp = 1.0 + r2 * (-0.5 + r2 * (1.0 / 24 + r2 * (-1.0 / 720 + r2 * (1.0 / 40320 + r2 * (-1.0 / 3628800 + r2 * (1.0 / 479001600.0))))));
    const double ss = (qi == 0) ? sp : (qi == 1) ? cp : (qi == 2) ? -sp : -cp;
    const double cc = (qi == 0) ? cp : (qi == 1) ? -sp : (qi == 2) ? -cp : sp;
    s = (float)ss; c = (float)cc;
}
__device__ __forceinline__ void g0_prologue(const Ctx& C, LAS unsigned char* lds) {
    const int tid = opaque(threadIdx.x), lane = tid & 63, wid = tid >> 6, G = gridDim.x, bx = blockIdx.x;
    if (bx == G - 1) {
        for (int e = tid; e < 1024; e += 512) { const int pos = e >> 4, i = e & 15;
            const float invf = fexp2(-(float)i * 0.83048202372f);
            const float ang = (float)pos * invf; float s, c; sincos_d((double)ang, s, c);
            C.rope[e * 2] = c; C.rope[e * 2 + 1] = s; }
    }
    constexpr int NMODT = 2 * 48;
    const int nmodb = (G >= 2 * NMODT) ? NMODT : G;
    if (bx < nmodb) {
        LAS float* sl = (LAS float*)lds + wid * (33 * 64);
        for (int task = bx; task < NMODT; task += nmodb) {
            const int l = task / 48, cb = task % 48, col = cb * 64 + lane;
            const float* W = C.mod_w + (size_t)l * DM * 3072;
            float acc[33];
#pragma unroll
            for (int r = 0; r < 33; ++r) acc[r] = 0.f;
            for (int kc = 0; kc < 2; ++kc) {
                const int k0 = wid * 128 + kc * 64;
#pragma unroll
                for (int r = 0; r < 33; ++r) { const float v = (r < 32) ? C.c[r * DM + k0 + lane] : C.c_ctx[k0 + lane]; sl[r * 64 + lane] = siluf_(v); }
                asm volatile("s_waitcnt lgkmcnt(0)" ::: "memory");
                for (int k4 = 0; k4 < 16; ++k4) {
                    const float w0 = W[(size_t)(k0 + 4 * k4 + 0) * 3072 + col], w1 = W[(size_t)(k0 + 4 * k4 + 1) * 3072 + col],
                                w2 = W[(size_t)(k0 + 4 * k4 + 2) * 3072 + col], w3 = W[(size_t)(k0 + 4 * k4 + 3) * 3072 + col];
#pragma unroll
                    for (int r = 0; r < 33; ++r) { const f32x4 sv = *(const LAS f32x4*)(sl + r * 64 + 4 * k4); acc[r] += sv[0] * w0 + sv[1] * w1 + sv[2] * w2 + sv[3] * w3; }
                }
                asm volatile("s_waitcnt lgkmcnt(0)" ::: "memory");
            }
            __syncthreads();
#pragma unroll
            for (int r = 0; r < 33; ++r) sl[r * 64 + lane] = acc[r];
            __syncthreads();
            for (int e = tid; e < 33 * 64; e += 512) { float s = 0.f;
#pragma unroll
                for (int w = 0; w < 8; ++w) s += ((LAS float*)lds)[w * (33 * 64) + e];
                const int r = e >> 6, cc = cb * 64 + (e & 63);
                C.mod[((size_t)l * 33 + r) * 3072 + cc] = s + C.mod_b[l * 3072 + cc]; }
            __syncthreads();
        }
    }
    {
        const bool all = (nmodb == G);
        if (all || bx >= nmodb) {
            const int nb = all ? G : G - nmodb, b0 = all ? bx : bx - nmodb;
            LAS float* scr = (LAS float*)lds + wid * (64 * 33 + 16);
            constexpr int I_IN = 16 * (DIN / 32), I_OUT = 16 * 32, I_UP = 8;
            constexpr int NITEMS = 2 * I_IN + 2 * I_OUT + 16 * I_UP;
            for (int it = b0 * 8 + wid; it < NITEMS; it += nb * 8) {
                int r = it;
                if (r < 2 * I_IN) { const int l = r / I_IN; transpose_item(C.w_in + (size_t)l * DM * DIN, DM, DIN, C.WinT + (size_t)l * DIN * DM, scr, r % I_IN, lane, true); continue; } r -= 2 * I_IN;
                if (r < 2 * I_OUT) { const int l = r / I_OUT; transpose_item(C.w_out + (size_t)l * DM * DM, DM, DM, C.WoutT + (size_t)l * DM * DM, scr, r % I_OUT, lane, false); continue; } r -= 2 * I_OUT;
                { const int mi = r / I_UP, l = mi >> 2, m = mi & 3, d = m & 1;
                  const float* src = ((m < 2) ? C.w_up : C.a_up) + (size_t)(l * 2 + d) * 64 * 256;
                  transpose_item(src, 64, 256, C.WupT + (size_t)(l * 4 + m) * 256 * 64, scr, r % I_UP, lane, false); }
            }
        }
    }
}

template <int MODE>
__device__ __forceinline__ void norm_phase(const Ctx& C, int hf, int gw, int ngw, int lane_in) {
    const int lane = opaque(lane_in);
    const int nrows = (MODE == 2) ? LATH : MH;
    for (int lr = gw; lr < nrows; lr += ngw) {
        const bool lat = lr < LATH;
        int mrow; const float* xin; float* x1p;
        if (lat) { const size_t g = (size_t)hf * LATH + lr; mrow = hf * HB + lr / SEQ; xin = C.x + g * DM; x1p = C.out + g * DM; }
        else { const size_t g = (size_t)hf * CTXH + (lr - LATH); mrow = 32; xin = C.ctx + g * DM; x1p = C.xc1 + g * DM; }
        f32x4 v[4];
        const float* base = (MODE == 2) ? x1p : xin;
#pragma unroll
        for (int j = 0; j < 4; ++j) v[j] = *(const f32x4*)(base + 4 * lane + 256 * j);
        if (MODE >= 1) {
            const float* gate = C.mod + ((size_t)(MODE - 1) * 33 + mrow) * 3072 + 2048;
            const float* pg = C.post_g + (MODE - 1) * DM;
            const bf16_t* yr = C.Y + (size_t)lr * DM;
            f32x4 y[4]; float ss = 0.f;
#pragma unroll
            for (int j = 0; j < 4; ++j) { y[j] = ld_bf4(yr + 4 * lane + 256 * j); ss += (y[j][0] * y[j][0] + y[j][1] * y[j][1]) + (y[j][2] * y[j][2] + y[j][3] * y[j][3]); }
            const float rstd = __builtin_amdgcn_rsqf(wave_sum(ss) * (1.f / DM) + NORM_EPS);
#pragma unroll
            for (int j = 0; j < 4; ++j) { const f32x4 gt = *(const f32x4*)(gate + 4 * lane + 256 * j), pgv = *(const f32x4*)(pg + 4 * lane + 256 * j);
                v[j] = v[j] + gt * (y[j] * rstd * pgv); *(f32x4*)(x1p + 4 * lane + 256 * j) = v[j]; }
        }
        if (MODE <= 1) {
            const float* md = C.mod + ((size_t)MODE * 33 + mrow) * 3072;
            const float* pre = C.pre_g + MODE * DM;
            float ss = 0.f;
#pragma unroll
            for (int j = 0; j < 4; ++j) ss += (v[j][0] * v[j][0] + v[j][1] * v[j][1]) + (v[j][2] * v[j][2] + v[j][3] * v[j][3]);
            const float rstd = __builtin_amdgcn_rsqf(wave_sum(ss) * (1.f / DM) + NORM_EPS);
            bf16_t* hr = C.H + (size_t)lr * DM;
#pragma unroll
            for (int j = 0; j < 4; ++j) { const f32x4 sh = *(const f32x4*)(md + 4 * lane + 256 * j), scl = *(const f32x4*)(md + 1024 + 4 * lane + 256 * j), pv = *(const f32x4*)(pre + 4 * lane + 256 * j);
                st_bf4(hr + 4 * lane + 256 * j, (v[j] * rstd * pv) * (1.f + scl) + sh); }
        }
    }
}

__device__ __forceinline__ int crow(int r, int hi) { return (r & 3) + 8 * (r >> 2) + 4 * hi; }
__device__ __forceinline__ bf16x8 tanh8(bf16x8 x) {
    const u32x4 w = __builtin_bit_cast(u32x4, x); u32x4 o;
#pragma unroll
    for (int i = 0; i < 4; ++i) { const float a = bf_lo(w[i]), b = bf_hi(w[i]);
        const float ta = 1.f - 2.f * frcp(1.f + fexp2(2.885390081777927f * a)), tb = 1.f - 2.f * frcp(1.f + fexp2(2.885390081777927f * b));
        o[i] = cvt_pk_bf16(ta, tb); }
    return __builtin_bit_cast(bf16x8, o);
}
__device__ __forceinline__ void prep_task(const Ctx& C, int l, int task, int lane_in) {
    const int lane = opaque(lane_in);
    const int r32 = lane & 31, hi = lane >> 5, lr0 = task * 32;
    const bf16_t* prow = C.P + (size_t)(lr0 + r32) * DIN + hi * 8;
    const bf16_t* WT = C.WupT + (size_t)l * 4 * 256 * 64;
    constexpr size_t ARR = (size_t)MH * 256;
#pragma unroll 1
    for (int d = 0; d < 2; ++d) {
        bf16x8 xf[4];
#pragma unroll
        for (int i0 = 0; i0 < 4; ++i0) xf[i0] = tanh8(*(const bf16x8*)(prow + (d ? C_LWB : C_LWF) + i0 * 16));
        const bf16_t* wt = WT + (size_t)d * 256 * 64;
        const float* w0 = C.w0 + (l * 2 + d) * 256;
        float* dst = C.SC + (size_t)d * ARR;
#pragma unroll 1
        for (int jb = 0; jb < 8; ++jb) {
            const int j = jb * 32 + r32;
            f32x16 acc = {};
#pragma unroll
            for (int i0 = 0; i0 < 4; ++i0) { const bf16x8 wf = *(const bf16x8*)(wt + (size_t)j * 64 + i0 * 16 + hi * 8); acc = __builtin_amdgcn_mfma_f32_32x32x16_bf16(xf[i0], wf, acc, 0, 0, 0); }
            const float w0j = w0[j];
#pragma unroll
            for (int r = 0; r < 16; ++r) { const int row = lr0 + crow(r, hi);
                const float sg = sigmoidf_(acc[r] + w0j);
                dst[(size_t)row * 256 + j] = fexp2(-0.8750429636f * sg); }
        }
    }
#pragma unroll 1
    for (int hd = 0; hd < 4; ++hd) {
        float rn[16];
        { const float kk0 = C.k_k[l * 256 + hd * 64 + r32], kk1 = C.k_k[l * 256 + hd * 64 + 32 + r32];
#pragma unroll
          for (int r = 0; r < 16; ++r) { const bf16_t* kp = C.P + (size_t)(lr0 + crow(r, hi)) * DIN + C_K + hd * 64 + r32;
              const float a = bf2f(kp[0]) * kk0, b = bf2f(kp[32]) * kk1; const float s = sum32(a * a + b * b);
              rn[r] = frcp(fmaxf(__builtin_sqrtf(s), 1e-12f)); } }
#pragma unroll 1
        for (int jd = 0; jd < 4; ++jd) {
            const int jb2 = jd >> 1, d = jd & 1;
            const int j = hd * 64 + jb2 * 32 + r32;
            const float kkj = C.k_k[l * 256 + j], kaj = C.k_a[l * 256 + j];
            const bf16_t* wt = WT + (size_t)(2 + d) * 256 * 64;
            f32x16 acc = {};
#pragma unroll
            for (int i0 = 0; i0 < 4; ++i0) { const bf16x8 xf = *(const bf16x8*)(prow + (d ? C_LAB : C_LAF) + i0 * 16);
                const bf16x8 wf = *(const bf16x8*)(wt + (size_t)j * 64 + i0 * 16 + hi * 8); acc = __builtin_amdgcn_mfma_f32_32x32x16_bf16(xf, wf, acc, 0, 0, 0); }
            const float a0j = C.a0[(l * 2 + d) * 256 + j];
            float* dkm = C.SC + (size_t)(2 + d) * ARR; float* dbb = C.SC + (size_t)(4 + d) * ARR; float* daa = C.SC + 6 * ARR;
#pragma unroll
            for (int r = 0; r < 16; ++r) { const size_t rowi = (size_t)(lr0 + crow(r, hi)); const size_t off = rowi * 256 + j;
                const float k = bf2f(C.P[rowi * DIN + C_K + j]);
                const float a = sigmoidf_(acc[r] + a0j), kkn = k * kkj * rn[r];
                dkm[off] = k * (1.f + (a - 1.f) * kaj); dbb[off] = kkn * a; if (d == 0) daa[off] = -kkn; }
        }
    }
}
__device__ __forceinline__ void conv_row(const Ctx& C, int l, int lr, int lane_in) {
    const int lane = opaque(lane_in);
    const bool lat = lr < LATH; const int t = lat ? (lr & (SEQ - 1)) : ((lr - LATH) & (CTX - 1)), len = lat ? SEQ : CTX;
    const bf16_t* pr = C.P + (size_t)lr * DIN; const int c = 4 * lane;
    const float* cw = C.conv_w + l * 3 * 256 + c;
    const f32x4 w0 = *(const f32x4*)cw, w1 = *(const f32x4*)(cw + 256), w2 = *(const f32x4*)(cw + 512);
    f32x4 y = (ld_bf4(pr + C_CC + c) * ld_bf4(pr + C_CH + c)) * w1;
    if (t > 0) y = y + (ld_bf4(pr - DIN + C_CC + c) * ld_bf4(pr - DIN + C_CH + c)) * w0;
    if (t < len - 1) y = y + (ld_bf4(pr + DIN + C_CC + c) * ld_bf4(pr + DIN + C_CH + c)) * w2;
    const f32x4 bg = ld_bf4(pr + C_CB + c), z = ld_bf4(pr + C_CZ + c);
    f32x4 o; o[0] = bg[0] * y[0] * siluf_(z[0]); o[1] = bg[1] * y[1] * siluf_(z[1]); o[2] = bg[2] * y[2] * siluf_(z[2]); o[3] = bg[3] * y[3] * siluf_(z[3]);
    st_bf4(C.H + (size_t)lr * DM + 256 + c, o);
}

__device__ __forceinline__ void rope_row(const Ctx& C, int lr, int lane_in) {
    const int lane = opaque(lane_in);
    const int t = lr & (SEQ - 1); const int pos = ((lane >> 2) & 1) ? (t & 63) : (t >> 6);
    const f32x4* rp = (const f32x4*)(C.rope + (pos * 16 + 8 * (lane & 1)) * 2);
    const f32x4 c0 = rp[0], c1 = rp[1], c2 = rp[2], c3 = rp[3];
    const float sg = (lane & 2) ? 1.f : -1.f;
#pragma unroll
    for (int which = 0; which < 2; ++which) {
        bf16_t* p = C.P + (size_t)lr * DIN + (which ? C_AK : C_AQ) + 8 * lane;
        const u32x4 w = *(const u32x4*)p; u32x4 pw;
#pragma unroll
        for (int i = 0; i < 4; ++i) pw[i] = (unsigned)__shfl_xor((int)w[i], 2);
        u32x4 o;
        o[0] = cvt_pk_bf16(bf_lo(w[0]) * c0[0] + sg * bf_lo(pw[0]) * c0[1], bf_hi(w[0]) * c0[2] + sg * bf_hi(pw[0]) * c0[3]);
        o[1] = cvt_pk_bf16(bf_lo(w[1]) * c1[0] + sg * bf_lo(pw[1]) * c1[1], bf_hi(w[1]) * c1[2] + sg * bf_hi(pw[1]) * c1[3]);
        o[2] = cvt_pk_bf16(bf_lo(w[2]) * c2[0] + sg * bf_lo(pw[2]) * c2[1], bf_hi(w[2]) * c2[2] + sg * bf_hi(pw[2]) * c2[3]);
        o[3] = cvt_pk_bf16(bf_lo(w[3]) * c3[0] + sg * bf_lo(pw[3]) * c3[1], bf_hi(w[3]) * c3[2] + sg * bf_hi(pw[3]) * c3[3]);
        *(u32x4*)p = o;
    }
}

__device__ __forceinline__ int scan_row(int s, int dir, int bl) {
    if (s < CTX) { const int t = dir ? (CTX - 1 - s) : s; return LATH + bl * CTX + t; }
    const int t0 = s - CTX; const int t = dir ? (SEQ - 1 - t0) : t0; return bl * SEQ + t;
}
__device__ __forceinline__ void scan_unit(const Ctx& C, int l, int u, LAS unsigned char* lds) {
    const int bl = u >> 4, hd = (u >> 2) & 3, dir = (u >> 1) & 1, vh = u & 1;
    const int tid = opaque(threadIdx.x), lane = tid & 63, wid = __builtin_amdgcn_readfirstlane(tid >> 6);
    const int st = tid >> 4, q4 = tid & 15;
    constexpr size_t ARR = (size_t)MH * 256;
    constexpr int CHF = 32 * 6 * 64;
    const float* a_dec = C.SC + (size_t)dir * ARR + hd * 64 + q4 * 4;
    const float* a_km = C.SC + (size_t)(2 + dir) * ARR + hd * 64 + q4 * 4;
    const float* a_bb = C.SC + (size_t)(4 + dir) * ARR + hd * 64 + q4 * 4;
    const float* a_aa = C.SC + 6 * ARR + hd * 64 + q4 * 4;
    const bf16_t* a_r = C.P + C_R + hd * 64 + q4 * 4;
    const bf16_t* a_v = C.P + C_V + hd * 64 + vh * 32 + (q4 & 7) * 4;
    f32x4 g0, g1, g2, g3, g4, g5;
#define SC_LOAD(c) do { const size_t row_ = (size_t)scan_row((c) * 32 + st, dir, bl); \
        g0 = *(const f32x4*)(a_dec + row_ * 256); g1 = *(const f32x4*)(a_km + row_ * 256); g2 = *(const f32x4*)(a_aa + row_ * 256); g3 = *(const f32x4*)(a_bb + row_ * 256); \
        g4 = ld_bf4(a_r + row_ * DIN); g5 = ld_bf4(a_v + row_ * DIN); } while (0)
#define SC_WRITE(b) do { LAS float* d_ = (LAS float*)lds + (b) * CHF + st * 384 + q4 * 4; \
        *(LAS f32x4*)(d_) = g0; *(LAS f32x4*)(d_ + 64) = g1; *(LAS f32x4*)(d_ + 128) = g2; *(LAS f32x4*)(d_ + 192) = g3; *(LAS f32x4*)(d_ + 256) = g4; if (q4 < 8) *(LAS f32x4*)(d_ + 320) = g5; } while (0)
    f32x4 S0 = {0.f, 0.f, 0.f, 0.f}, S1 = {0.f, 0.f, 0.f, 0.f};
    const int vq = lane >> 4, k16 = lane & 15;
    const int rloc = 8 * wid + 2 * vq;
    float* ysb = C.YS + (size_t)dir * ARR + hd * 64 + vh * 32 + rloc + (k16 & 1);
    SC_LOAD(0); SC_WRITE(0); __syncthreads();
    constexpr int NCH = (CTX + SEQ) / 32;
#pragma unroll 1
    for (int c = 0; c < NCH; ++c) {
        if (c + 1 < NCH) SC_LOAD(c + 1);
        if (wid < 4) {
            const LAS float* cb = (const LAS float*)lds + (c & 1) * CHF;
            const bool wout = (c >= CTX / 32) || (l == 0);
#pragma unroll 4
            for (int s = 0; s < 32; ++s) {
                const LAS float* sb = cb + s * 384;
                const f32x4 wv = *(const LAS f32x4*)(sb + k16 * 4), km = *(const LAS f32x4*)(sb + 64 + k16 * 4), aa = *(const LAS f32x4*)(sb + 128 + k16 * 4),
                            bb = *(const LAS f32x4*)(sb + 192 + k16 * 4), rr = *(const LAS f32x4*)(sb + 256 + k16 * 4);
                const f32x2 vv = *(const LAS f32x2*)(sb + 320 + rloc);
                float sa0 = (S0[0] * aa[0] + S0[1] * aa[1]) + (S0[2] * aa[2] + S0[3] * aa[3]);
                float sa1 = (S1[0] * aa[0] + S1[1] * aa[1]) + (S1[2] * aa[2] + S1[3] * aa[3]);
                sa0 = sum16(sa0); sa1 = sum16(sa1);
                S0 = S0 * wv + sa0 * bb + vv[0] * km;
                S1 = S1 * wv + sa1 * bb + vv[1] * km;
                float y0 = (S0[0] * rr[0] + S0[1] * rr[1]) + (S0[2] * rr[2] + S0[3] * rr[3]);
                float y1 = (S1[0] * rr[0] + S1[1] * rr[1]) + (S1[2] * rr[2] + S1[3] * rr[3]);
                y0 = sum16(y0); y1 = sum16(y1);
                if (wout && k16 < 2) { const size_t row = (size_t)scan_row(c * 32 + s, dir, bl); ysb[row * 256] = (k16 & 1) ? y1 : y0; }
            }
        }
        if (c + 1 < NCH) SC_WRITE((c + 1) & 1);
        __syncthreads();
    }
#undef SC_LOAD
#undef SC_WRITE
}

#define KSWZ(row, colB) ((row) * 256 + ((colB) ^ (((row) & 7) << 4)))
#define SBAR() __builtin_amdgcn_sched_barrier(0)
constexpr int SHM_KV = 64 * 128 * 2;
constexpr float ATT_THR = 11.5f;
__device__ __forceinline__ int v_st(int k, int c) { const int kk = (k & ~0xC) | ((k & 4) << 1) | ((k & 8) >> 1); return ((kk >> 3) * 4 + (c >> 5)) * 512 + ((kk & 7) * 32 + (c & 31)) * 2; }
__device__ __forceinline__ int v_rd_base(int lane) { return ((lane & 3) << 3) | (((lane >> 2) & 3) << 6) | (((lane >> 4) & 1) << 5) | (((lane >> 5) & 1) << 8); }
constexpr int v_rd_off(int d0, int ks, int half) { return d0 * 512 + ks * 4096 + half * 2048; }
template <int OFF> __device__ __forceinline__ s16x4 tr_read(int vb) { s16x4 r; asm volatile("ds_read_b64_tr_b16 %0, %1 offset:%2" : "=&v"(r) : "v"(vb), "i"(OFF) : "memory"); return r; }
template <int D0> __device__ __forceinline__ void pv_one(f32x16& od, int vb, bf16x8 pa0, bf16x8 pa1, bf16x8 pa2, bf16x8 pa3) {
    const s16x4 l0 = tr_read<v_rd_off(D0, 0, 0)>(vb), h0 = tr_read<v_rd_off(D0, 0, 1)>(vb), l1 = tr_read<v_rd_off(D0, 1, 0)>(vb), h1 = tr_read<v_rd_off(D0, 1, 1)>(vb);
    const s16x4 l2 = tr_read<v_rd_off(D0, 2, 0)>(vb), h2 = tr_read<v_rd_off(D0, 2, 1)>(vb), l3 = tr_read<v_rd_off(D0, 3, 0)>(vb), h3 = tr_read<v_rd_off(D0, 3, 1)>(vb);
    asm volatile("s_waitcnt lgkmcnt(0)" ::: "memory"); SBAR();
#define PKV(L, H) (bf16x8){L[0], L[1], L[2], L[3], H[0], H[1], H[2], H[3]}
    od = __builtin_amdgcn_mfma_f32_32x32x16_bf16(pa0, PKV(l0, h0), od, 0, 0, 0);
    od = __builtin_amdgcn_mfma_f32_32x32x16_bf16(pa1, PKV(l1, h1), od, 0, 0, 0);
    od = __builtin_amdgcn_mfma_f32_32x32x16_bf16(pa2, PKV(l2, h2), od, 0, 0, 0);
    od = __builtin_amdgcn_mfma_f32_32x32x16_bf16(pa3, PKV(l3, h3), od, 0, 0, 0);
#undef PKV
}
__device__ __forceinline__ void subhead_tile(f32x16 (&o)[4], float& m_reg, float& l_reg, const bf16x8* qr, const char* Ks, int cb0, int vb, float* al_l, int r32, int hi) {
    f32x16 p0 = {}, p1 = {};
#pragma unroll
    for (int d0 = 0; d0 < 4; ++d0) { const int cb = cb0 + (d0 * 16 + hi * 8) * 2;
        const bf16x8 b0 = *(const bf16x8*)(Ks + KSWZ(r32, cb)); const bf16x8 b1 = *(const bf16x8*)(Ks + KSWZ(32 + r32, cb));
        p0 = __builtin_amdgcn_mfma_f32_32x32x16_bf16(b0, qr[d0], p0, 0, 0, 0);
        p1 = __builtin_amdgcn_mfma_f32_32x32x16_bf16(b1, qr[d0], p1, 0, 0, 0); }
    float pmax = p0[0];
#pragma unroll
    for (int r = 1; r < 16; ++r) pmax = fmaxf(pmax, p0[r]);
#pragma unroll
    for (int r = 0; r < 16; ++r) pmax = fmaxf(pmax, p1[r]);
    { auto rr = __builtin_amdgcn_permlane32_swap(__float_as_uint(pmax), __float_as_uint(pmax), false, false); pmax = fmaxf(__uint_as_float(rr[0]), __uint_as_float(rr[1])); }
    float mn, alpha;
    if (__builtin_expect(__all(pmax - m_reg <= ATT_THR), 1)) { mn = m_reg; alpha = 1.f; }
    else { mn = fmaxf(m_reg, pmax); alpha = fexp2(m_reg - mn); m_reg = mn; }
#pragma unroll
    for (int r = 0; r < 16; ++r) { p0[r] = fexp2(p0[r] - mn); p1[r] = fexp2(p1[r] - mn); }
    float ps = 0.f;
#pragma unroll
    for (int r = 0; r < 16; ++r) ps += p0[r] + p1[r];
    { auto rr = __builtin_amdgcn_permlane32_swap(__float_as_uint(ps), __float_as_uint(ps), false, false); ps = __uint_as_float(rr[0]) + __uint_as_float(rr[1]); }
    l_reg = l_reg * alpha + ps;
    if (__any(alpha < 1.f)) { if (hi == 0) al_l[r32] = alpha; asm volatile("s_waitcnt lgkmcnt(0)" ::: "memory");
#pragma unroll
        for (int d = 0; d < 4; ++d)
#pragma unroll
            for (int r = 0; r < 16; ++r) o[d][r] *= al_l[crow(r, hi)]; }
    bf16x8 pa0, pa1, pa2, pa3;
#define PK4(P, BASE, OUT) do { unsigned a0 = cvt_pk_bf16(P[BASE + 0], P[BASE + 1]), a1 = cvt_pk_bf16(P[BASE + 2], P[BASE + 3]); \
        unsigned b0 = cvt_pk_bf16(P[BASE + 4], P[BASE + 5]), b1 = cvt_pk_bf16(P[BASE + 6], P[BASE + 7]); \
        auto r0 = __builtin_amdgcn_permlane32_swap(a0, b0, false, false); auto r1 = __builtin_amdgcn_permlane32_swap(a1, b1, false, false); \
        u32x4 w = {r0[0], r1[0], r0[1], r1[1]}; OUT = __builtin_bit_cast(bf16x8, w); } while (0)
    PK4(p0, 0, pa0); PK4(p0, 8, pa1); PK4(p1, 0, pa2); PK4(p1, 8, pa3);
#undef PK4
    pv_one<0>(o[0], vb, pa0, pa1, pa2, pa3); pv_one<1>(o[1], vb, pa0, pa1, pa2, pa3); pv_one<2>(o[2], vb, pa0, pa1, pa2, pa3); pv_one<3>(o[3], vb, pa0, pa1, pa2, pa3);
}
__device__ __forceinline__ void attn_unit(const Ctx& C, int l, int hd, int qrow0, int latbase, int ctxbase, int nlat, int NT, float lam, char* lds) {
    const int tid = opaque(threadIdx.x), wid = __builtin_amdgcn_readfirstlane(tid >> 6), lane = tid & 63, r32 = lane & 31, hi = lane >> 5, g = wid & 3, sj = wid >> 2;
    char* V_lds = lds; char* K_lds = lds + 2 * SHM_KV;
    float* wsf = (float*)(lds + 4 * SHM_KV) + wid * 64; float* al_l = wsf; float* li_l = wsf + 32;
    const bf16_t* Qw = C.P + (size_t)(qrow0 + g * 32 + r32) * DIN + C_AQ + hd * 128 + sj * 64 + hi * 8;
    bf16x8 qr[4];
#pragma unroll
    for (int d0 = 0; d0 < 4; ++d0) qr[d0] = *(const bf16x8*)(Qw + d0 * 16);
    const int sr = tid >> 4, sc = (tid & 15) * 8, vst0 = v_st(sr, sc), vst1 = v_st(32 + sr, sc);
    const int vb0 = (int)(uintptr_t)V_lds + v_rd_base(lane);
    const bf16_t* Kc = C.P + C_AK + hd * 128 + sc; const bf16_t* Vc = C.P + C_AV + hd * 128 + sc;
    bf16x8 vs0, vs1, ks0, ks1;
#define TROW(t) ((t) < nlat ? latbase + (t) * 64 : ctxbase + ((t) - nlat) * 64)
#define SLOAD(t) do { const size_t rb_ = (size_t)TROW(t); vs0 = *(const bf16x8*)(Vc + (rb_ + sr) * DIN); vs1 = *(const bf16x8*)(Vc + (rb_ + 32 + sr) * DIN); \
        ks0 = *(const bf16x8*)(Kc + (rb_ + sr) * DIN); ks1 = *(const bf16x8*)(Kc + (rb_ + 32 + sr) * DIN); } while (0)
#define SWRITE(b) do { *(bf16x8*)(V_lds + (b) * SHM_KV + vst0) = vs0; *(bf16x8*)(V_lds + (b) * SHM_KV + vst1) = vs1; \
        *(bf16x8*)(K_lds + (b) * SHM_KV + KSWZ(sr, sc * 2)) = ks0; *(bf16x8*)(K_lds + (b) * SHM_KV + KSWZ(32 + sr, sc * 2)) = ks1; } while (0)
    float m_reg = -1e30f, l_reg = 0.f;
    f32x16 o[4] = {};
    SLOAD(0); SWRITE(0); __syncthreads();
#pragma unroll 1
    for (int j = 0; j < NT; ++j) {
        const int b = j & 1;
        if (j + 1 < NT) SLOAD(j + 1);
        subhead_tile(o, m_reg, l_reg, qr, K_lds + b * SHM_KV, sj * 128, vb0 + b * SHM_KV, al_l, r32, hi);
        if (j + 1 < NT) SWRITE(b ^ 1);
        __syncthreads();
    }
#undef TROW
#undef SLOAD
#undef SWRITE
    if (hi == 0) li_l[r32] = (sj ? lam : 1.f) * frcp(l_reg);
    asm volatile("s_waitcnt lgkmcnt(0)" ::: "memory");
    float* xb = (float*)lds + g * 4096 + lane;
    if (sj == 1) {
#pragma unroll
        for (int r = 0; r < 16; ++r) { const float a = li_l[crow(r, hi)];
#pragma unroll
            for (int d = 0; d < 4; ++d) xb[(d * 16 + r) * 64] = o[d][r] * a; }
    }
    __syncthreads();
    if (sj == 0) {
        const float lam1m = (l == 0) ? 0.8f : (1.f - 0.35550906759f);
        float g4[4];
#pragma unroll
        for (int d = 0; d < 4; ++d) g4[d] = C.subg[l * 128 + d * 32 + r32] * lam1m;
#pragma unroll
        for (int r = 0; r < 16; ++r) { const int rw = crow(r, hi); const float a = li_l[rw];
            float ss = 0.f; float v4[4];
#pragma unroll
            for (int d = 0; d < 4; ++d) { const float v = o[d][r] * a - xb[(d * 16 + r) * 64]; v4[d] = v; ss += v * v; }
            ss = sum32(ss);
            const float rstd = __builtin_amdgcn_rsqf(ss * (1.f / 128.f) + NORM_EPS);
            const size_t row = (size_t)(qrow0 + g * 32 + rw);
            const bf16_t* zp = C.P + row * DIN + C_AZ + hd * 128 + r32; bf16_t* op = C.H + row * DM + 512 + hd * 128 + r32;
#pragma unroll
            for (int d = 0; d < 4; ++d) { const float z = bf2f(zp[d * 32]); const float v = v4[d] * rstd * g4[d] * siluf_(z);
                op[d * 32] = (bf16_t)(cvt_pk_bf16(v, 0.f) & 0xffffu); } }
    }
    __syncthreads();
}

__device__ __forceinline__ void readout_row(const Ctx& C, int l, int lr, int lane_in) {
    const int lane = opaque(lane_in);
    constexpr size_t ARR = (size_t)MH * 256;
    const int j = 4 * lane; const size_t off = (size_t)lr * 256 + j;
    f32x4 y = *(const f32x4*)(C.YS + off) + *(const f32x4*)(C.YS + ARR + off);
    float s = (y[0] + y[1]) + (y[2] + y[3]);
    s += __shfl_xor(s, 1); s += __shfl_xor(s, 2); s += __shfl_xor(s, 4); s += __shfl_xor(s, 8);
    const float mu = s * (1.f / 64.f);
    y = y - mu;
    float q = (y[0] * y[0] + y[1] * y[1]) + (y[2] * y[2] + y[3] * y[3]);
    q += __shfl_xor(q, 1); q += __shfl_xor(q, 2); q += __shfl_xor(q, 4); q += __shfl_xor(q, 8);
    const float rstd = __builtin_amdgcn_rsqf(q * (1.f / 64.f) + GN_EPS);
    const f32x4 lg = *(const f32x4*)(C.ln_g + l * 256 + j), lb = *(const f32x4*)(C.ln_b + l * 256 + j), rk = *(const f32x4*)(C.r_k + l * 256 + j);
    const bf16_t* pr = C.P + (size_t)lr * DIN;
    const f32x4 r = ld_bf4(pr + C_R + j), v = ld_bf4(pr + C_V + j), z = ld_bf4(pr + C_ZR + j);
    const f32x4 ks = *(const f32x4*)(C.SC + 2 * ARR + off) + *(const f32x4*)(C.SC + 3 * ARR + off);
    const f32x4 t = r * ks * rk;
    float bs = (t[0] + t[1]) + (t[2] + t[3]);
    bs += __shfl_xor(bs, 1); bs += __shfl_xor(bs, 2); bs += __shfl_xor(bs, 4); bs += __shfl_xor(bs, 8);
    f32x4 o = y * rstd * lg + lb + bs * v;
    o[0] *= siluf_(z[0]); o[1] *= siluf_(z[1]); o[2] *= siluf_(z[2]); o[3] *= siluf_(z[3]);
    st_bf4(C.H + (size_t)lr * DM + j, o);
}

struct Args { const float* in[22]; float* out; unsigned char* ws; };
__global__ void __launch_bounds__(512, 2) mk_fwd(Args a) {
    extern __shared__ __attribute__((aligned(16))) unsigned char lds_raw[];
    cg::grid_group grid = cg::this_grid();
    LAS unsigned char* lds = (LAS unsigned char*)lds_raw;
    Ctx C;
    C.x = a.in[0]; C.c = a.in[1]; C.ctx = a.in[2]; C.c_ctx = a.in[3]; C.mod_w = a.in[4]; C.mod_b = a.in[5]; C.pre_g = a.in[6]; C.post_g = a.in[7]; C.w_in = a.in[8]; C.w_out = a.in[9];
    C.w0 = a.in[10]; C.w_up = a.in[11]; C.a0 = a.in[12]; C.a_up = a.in[13]; C.k_k = a.in[14]; C.k_a = a.in[15]; C.r_k = a.in[16]; C.ln_g = a.in[17]; C.ln_b = a.in[18]; C.conv_w = a.in[19];
    C.dlam = a.in[20]; C.subg = a.in[21]; C.out = a.out;
    unsigned char* ws = a.ws;
    C.WinT = (bf16_t*)(ws + WS_WIN); C.WoutT = (bf16_t*)(ws + WS_WOUT); C.WupT = (bf16_t*)(ws + WS_WUP); C.mod = (float*)(ws + WS_MOD); C.rope = (float*)(ws + WS_ROPE);
    C.xc1 = (float*)(ws + WS_XC1); C.H = (bf16_t*)(ws + WS_H); C.P = (bf16_t*)(ws + WS_P); C.Y = (bf16_t*)(ws + WS_P); C.SC = (float*)(ws + WS_SC); C.YS = (float*)(ws + WS_YS);
    const int tid = threadIdx.x, lane = tid & 63, wid = __builtin_amdgcn_readfirstlane(tid >> 6), G = gridDim.x, bx = blockIdx.x;
    const int gw0 = bx * 8 + wid, ngw = G * 8;
#define gw opaque_s(gw0)

#ifndef NO_G0
    g0_prologue(C, lds);
#endif
    grid.sync();
#pragma unroll 1
    for (int hf = 0; hf < 2; ++hf) {
#pragma unroll 1
        for (int l = 0; l < 2; ++l) {
#ifndef NO_NORM
            if (l == 0) norm_phase<0>(C, hf, gw, ngw, lane); else norm_phase<1>(C, hf, gw, ngw, lane);
#endif
            grid.sync();
            { pg8::Gemm g{C.H, C.WinT + (size_t)l * DIN * DM, MH, DIN, DM}; pg8::StaticOrder S; S.init(MH, DIN, G, bx);
#ifndef NO_GEMM1
              pg8::EpiBf16 E{C.P, DIN}; pg8::gemm_phase<pg8::EpiBf16, true>(lds, g, S, E);
#endif
            }
            grid.sync();
#ifndef NO_PREP
            for (int t = gw; t < MH / 32; t += ngw) prep_task(C, l, t, lane);
#endif
            { const int nrows = (l == 0) ? MH : LATH; for (int r = gw; r < nrows; r += ngw) conv_row(C, l, r, lane); }
            for (int r = gw; r < LATH; r += ngw) rope_row(C, r, lane);
            grid.sync();
#ifndef NO_SCAN
            for (int u = bx; u < 256; u += G) scan_unit(C, l, u, lds);
#endif
#ifndef NO_ATT
            {
                float lam;
                { const float* dl = C.dlam + l * 256; const float sa = wave_sum(dl[lane] * dl[64 + lane]), sb = wave_sum(dl[128 + lane] * dl[192 + lane]);
                  lam = fexp2(1.4426950408889634f * sa) - fexp2(1.4426950408889634f * sb) + ((l == 0) ? 0.2f : 0.35550906759f); }
                for (int u = bx; u < 1024; u += G) { const int bl = u >> 6, hd = (u >> 4) & 3, qb = u & 15;
                    attn_unit(C, l, hd, bl * SEQ + qb * 128, bl * SEQ, LATH + bl * CTX, 32, 36, lam, (char*)lds_raw); }
                if (l == 0) for (int u = bx; u < 128; u += G) { const int bl = u >> 3, hd = (u >> 1) & 3, qb = u & 1;
                    attn_unit(C, l, hd, LATH + bl * CTX + qb * 128, 0, LATH + bl * CTX, 0, 4, lam, (char*)lds_raw); }
            }
#endif
            grid.sync();
            { const int nrows = (l == 0) ? MH : LATH; for (int r = gw; r < nrows; r += ngw) readout_row(C, l, r, lane); }
            grid.sync();
            { const int M5 = (l == 0) ? MH : LATH; pg8::Gemm g{C.H, C.WoutT + (size_t)l * DM * DM, M5, DM, DM}; pg8::StaticOrder S; S.init(M5, DM, G, bx);
#ifndef NO_GEMM2
              pg8::EpiBf16 E{C.Y, DM}; pg8::gemm_phase<pg8::EpiBf16, true>(lds, g, S, E);
#endif
            }
            grid.sync();
        }
        norm_phase<2>(C, hf, gw, ngw, lane);
    }
#undef gw
}

extern "C" void kernel_launch(void* const* d_in, const int* in_sizes, int n_in, void* d_out, int out_size, void* d_ws, size_t ws_size, hipStream_t stream) {
    static int grid = 0;
    if (grid == 0) {
        if (n_in != 22 || ws_size < WS_END) { fprintf(stderr, "kernel_launch: unexpected n_in %d / ws %zu\n", n_in, ws_size); grid = -1; return; }
        int dev = 0, cus = 0, per_cu = 0;
        hipGetDevice(&dev); hipDeviceGetAttribute(&cus, hipDeviceAttributeMultiprocessorCount, dev);
        if (hipFuncSetAttribute((const void*)mk_fwd, hipFuncAttributeMaxDynamicSharedMemorySize, LDS_BYTES) != hipSuccess) { fprintf(stderr, "kernel_launch: hipFuncSetAttribute failed\n"); grid = -1; return; }
        if (hipOccupancyMaxActiveBlocksPerMultiprocessor(&per_cu, (const void*)mk_fwd, 512, LDS_BYTES) != hipSuccess || per_cu < 1) { fprintf(stderr, "kernel_launch: occupancy query says %d\n", per_cu); per_cu = 1; }
        (void)hipGetLastError();
        grid = cus * 1;
    }
    if (grid < 0) return;
    Args a{};
    for (int i = 0; i < 22; ++i) a.in[i] = (const float*)d_in[i];
    a.out = (float*)d_out; a.ws = (unsigned char*)d_ws;
    void* args[] = {&a};
    hipError_t e = hipLaunchCooperativeKernel((const void*)mk_fwd, dim3(grid), dim3(512), args, LDS_BYTES, stream);
    if (e != hipSuccess) fprintf(stderr, "cooperative launch failed: %s (grid %d)\n", hipGetErrorString(e), grid);
}
```

```cpp
#include <hip/hip_runtime.h>
#include <hip/hip_cooperative_groups.h>
#include <cstdio>
#include <cstdint>
namespace cg = cooperative_groups;

#define LAS __attribute__((address_space(3)))
typedef unsigned short bf16_t;
typedef short bf16x8 __attribute__((ext_vector_type(8)));
typedef short s16x4 __attribute__((ext_vector_type(4)));
typedef float f32x2 __attribute__((ext_vector_type(2)));
typedef float f32x4 __attribute__((ext_vector_type(4)));
typedef float f32x16 __attribute__((ext_vector_type(16)));
typedef unsigned u32x2 __attribute__((ext_vector_type(2)));
typedef unsigned u32x4 __attribute__((ext_vector_type(4)));

constexpr int DM = 1024, SEQ = 2048, CTX = 256, DIN = 4352;
constexpr int HB = 16;
constexpr int LATH = HB * SEQ;
constexpr int CTXH = HB * CTX;
constexpr int MH = LATH + CTXH;
constexpr int C_R = 0, C_K = 256, C_V = 512, C_LWF = 768, C_LWB = 832, C_LAF = 896, C_LAB = 960, C_ZR = 1024,
              C_CB = 1280, C_CC = 1536, C_CH = 1792, C_CZ = 2048, C_AQ = 2304, C_AK = 2816, C_AV = 3328, C_AZ = 3840;
constexpr float C2 = 0.125f * 1.4426950408889634f;
constexpr float NORM_EPS = 1e-6f, GN_EPS = 64e-5f;

constexpr size_t MiB = 1u << 20;
constexpr size_t WS_WIN = 1 * MiB, WS_WOUT = 18 * MiB, WS_WUP = 22 * MiB, WS_MOD = 23 * MiB, WS_ROPE = 24 * MiB, WS_XC1 = 25 * MiB,
                 WS_H = 57 * MiB, WS_P = 129 * MiB, WS_SC = 435 * MiB, WS_YS = 687 * MiB, WS_END = 759 * MiB;
static_assert(WS_WIN + 2ull * DIN * DM * 2 <= WS_WOUT && WS_H + (size_t)MH * DM * 2 <= WS_P && WS_P + (size_t)MH * DIN * 2 <= WS_SC &&
              WS_SC + 7ull * MH * 256 * 4 <= WS_YS && WS_YS + 2ull * MH * 256 * 4 <= WS_END, "ws map");
constexpr int LDS_BYTES = 131072 + 2048;

struct Ctx {
    const float *x, *c, *ctx, *c_ctx, *mod_w, *mod_b, *pre_g, *post_g, *w_in, *w_out, *w0, *w_up, *a0, *a_up, *k_k, *k_a, *r_k, *ln_g, *ln_b, *conv_w, *dlam, *subg;
    float* out;
    bf16_t *WinT, *WoutT, *WupT; float *mod, *rope, *xc1; bf16_t *H, *P, *Y; float *SC, *YS;
};

__device__ __forceinline__ unsigned cvt_pk_bf16(float lo, float hi) { unsigned r; asm volatile("v_cvt_pk_bf16_f32 %0, %1, %2" : "=v"(r) : "v"(lo), "v"(hi)); return r; }
__device__ __forceinline__ float bf_lo(unsigned w) { return __uint_as_float(w << 16); }
__device__ __forceinline__ float bf_hi(unsigned w) { return __uint_as_float(w & 0xffff0000u); }
__device__ __forceinline__ float bf2f(bf16_t b) { return __uint_as_float((unsigned)b << 16); }
__device__ __forceinline__ f32x4 ld_bf4(const bf16_t* p) { const u32x2 w = *(const u32x2*)p; return (f32x4){bf_lo(w.x), bf_hi(w.x), bf_lo(w.y), bf_hi(w.y)}; }
__device__ __forceinline__ void st_bf4(bf16_t* p, f32x4 v) { u32x2 w; w.x = cvt_pk_bf16(v[0], v[1]); w.y = cvt_pk_bf16(v[2], v[3]); *(u32x2*)p = w; }
__device__ __forceinline__ int opaque(int v) { asm volatile("" : "+v"(v)); return v; }
__device__ __forceinline__ int opaque_s(int v) { asm volatile("" : "+s"(v)); return v; }
__device__ __forceinline__ float fexp2(float x) { return __builtin_amdgcn_exp2f(x); }
__device__ __forceinline__ float frcp(float x) { return __builtin_amdgcn_rcpf(x); }
__device__ __forceinline__ float sigmoidf_(float x) { return frcp(1.f + fexp2(-1.4426950408889634f * x)); }
__device__ __forceinline__ float siluf_(float x) { return x * sigmoidf_(x); }
__device__ __forceinline__ float sum16(float v) {
    v += __int_as_float(__builtin_amdgcn_update_dpp(0, __float_as_int(v), 0xB1, 0xF, 0xF, true));
    v += __int_as_float(__builtin_amdgcn_update_dpp(0, __float_as_int(v), 0x4E, 0xF, 0xF, true));
    v += __int_as_float(__builtin_amdgcn_update_dpp(0, __float_as_int(v), 0x141, 0xF, 0xF, true));
    v += __int_as_float(__builtin_amdgcn_update_dpp(0, __float_as_int(v), 0x140, 0xF, 0xF, true));
    return v;
}
__device__ __forceinline__ float wave_sum(float v) {
    const int ri = __float_as_int(sum16(v));
    return (__int_as_float(__builtin_amdgcn_readlane(ri, 0)) + __int_as_float(__builtin_amdgcn_readlane(ri, 16))) + (__int_as_float(__builtin_amdgcn_readlane(ri, 32)) + __int_as_float(__builtin_amdgcn_readlane(ri, 48)));
}
__device__ __forceinline__ float wave_sum_dpp(float v) {
    const int ri = __float_as_int(sum16(v));
    return (__int_as_float(__builtin_amdgcn_readlane(ri, 0)) + __int_as_float(__builtin_amdgcn_readlane(ri, 16))) + (__int_as_float(__builtin_amdgcn_readlane(ri, 32)) + __int_as_float(__builtin_amdgcn_readlane(ri, 48)));
}
__device__ __forceinline__ float sum32(float v) {
    const float r = sum16(v);
    return r + __int_as_float(__builtin_amdgcn_ds_swizzle(__float_as_int(r), 0x401f));
}

namespace pg8 {
constexpr int BM = 256, BK = 64, HALF = 128, HTB = HALF * BK * 2, STAGE_BYTES = 8 * HTB, NXCD = 8, WGM = 8;
__host__ __device__ __forceinline__ int lds_byte(int r, int c) { const int st = (r >> 4) * 2 + (c >> 5), rr = r & 15, cc = c & 31, ob = rr * 64 + cc * 2; return st * 1024 + (ob ^ (((ob >> 9) & 1) << 5)); }
__host__ __device__ __forceinline__ void stage_rc(int b, int& R, int& C) { const int st = b / 1024, sb = b % 1024, swz = sb ^ (((sb >> 9) & 1) << 5); R = (st >> 1) * 16 + swz / 64; C = (st & 1) * 32 + (swz % 64) / 2; }
__host__ __device__ __forceinline__ int perm32(int rho) { const int n = rho >> 4, i = rho & 15; return 8 * (i >> 2) + 4 * n + (i & 3); }
struct Unit { int pm, pn; };
struct Gemm { const bf16_t* A; const bf16_t* Bt; int M, N, K; };
struct StaticOrder {
    int nM, nN, nwg, G, c;
    __host__ __device__ void init(int M, int N, int G_, int c_) { nM = M / BM; nN = N / BM; nwg = nM * nN; G = G_; c = c_; }
    __host__ __device__ bool next(int i, Unit& u) const {
        const long L = (long)i * G + c; if (L >= nwg) return false;
        int wgid = (int)L; { const int q = nwg / NXCD, r = nwg % NXCD, xcd = wgid % NXCD, off = wgid / NXCD; wgid = (xcd < r ? xcd * (q + 1) : r * (q + 1) + (xcd - r) * q) + off; }
        const int nig = WGM * nN, gid = wgid / nig, fm = gid * WGM, gsz = (nM - fm) < WGM ? (nM - fm) : WGM;
        u.pm = fm + ((wgid % nig) % gsz); u.pn = (wgid % nig) / gsz; return true;
    }
};
struct EpiBf16 {
    static constexpr bool PERM = true;
    bf16_t* O; int ldc;
    __device__ __forceinline__ void operator()(const f32x4 (&acc)[2][2][4][2], const Unit& u, int wr, int wc, int fr, int fq) const {
        const int row0 = u.pm * BM + wr * 64 + fr, col0 = u.pn * BM + wc * 32 + 8 * fq;
        int ld = ldc; asm volatile("" : "+s"(ld));
#pragma unroll
        for (int ai = 0; ai < 2; ++ai)
#pragma unroll
            for (int m = 0; m < 4; ++m) { bf16_t* rowp = O + (size_t)(row0 + ai * HALF + m * 16) * ld + col0;
#pragma unroll
                for (int bj = 0; bj < 2; ++bj) { const f32x4 v0 = acc[ai][bj][m][0], v1 = acc[ai][bj][m][1];
                    u32x4 w; w.x = cvt_pk_bf16(v0[0], v0[1]); w.y = cvt_pk_bf16(v0[2], v0[3]); w.z = cvt_pk_bf16(v1[0], v1[1]); w.w = cvt_pk_bf16(v1[2], v1[3]);
                    *(u32x4*)(rowp + bj * HALF) = w; } }
    }
};
template <class Epi, bool ALIGN_EPI = true>
__device__ __forceinline__ void gemm_phase(LAS unsigned char* lds, const Gemm g, const StaticOrder& S, const Epi& E) {
    const int tid = opaque(threadIdx.x), wid = __builtin_amdgcn_readfirstlane(tid >> 6), lane = tid & 63, wr = wid >> 2, wc = wid & 3, fr = lane & 15, fq = lane >> 4;
    const int K = g.K, nt = K / BK;
    unsigned voffA[2], voffB[2];
#pragma unroll
    for (int i = 0; i < 2; ++i) { int R, C; stage_rc(tid * 16 + i * 8192, R, C); const int Rb = Epi::PERM ? ((R & ~31) + perm32(R & 31)) : R;
        voffA[i] = (unsigned)(R * K + C) * 2u; voffB[i] = (unsigned)(Rb * K + C) * 2u; }
    const size_t kstep = (size_t)(BK * 2);
    const size_t hstep = (size_t)HALF * K * 2;
    const size_t tstep = 2 * hstep;
    const unsigned ldsw = (unsigned)wid * 1024u;
    const int aoff = lds_byte(wr * 64 + fr, fq * 8), boff = lds_byte(wc * 32 + fr, fq * 8);
#define PG8_SA(b, h) (((b) * 2 + (h)) * HTB)
#define PG8_SB(b, h) ((4 + (b) * 2 + (h)) * HTB)
#define PG8_STAGE(bufoff, gbase, voff) do { _Pragma("unroll") for (int _i = 0; _i < 2; ++_i) \
        __builtin_amdgcn_global_load_lds((const unsigned*)((const char*)(gbase) + (voff)[_i]), (LAS unsigned*)(lds + (bufoff) + ldsw + _i * 8192), 16, 0, 0); } while (0)
#define PG8_LDA(dst, b, h) do { _Pragma("unroll") for (int m = 0; m < 4; ++m) _Pragma("unroll") for (int k = 0; k < 2; ++k) dst[m][k] = *(const LAS bf16x8*)(lds + PG8_SA(b, h) + aoff + m * 2048 + k * 1024); } while (0)
#define PG8_LDB(dst, b, h) do { _Pragma("unroll") for (int n = 0; n < 2; ++n) _Pragma("unroll") for (int k = 0; k < 2; ++k) dst[n][k] = *(const LAS bf16x8*)(lds + PG8_SB(b, h) + boff + n * 2048 + k * 1024); } while (0)
#define PG8_MMA(ai, bj, At, Bt) do { __builtin_amdgcn_s_setprio(1); _Pragma("unroll") for (int m = 0; m < 4; ++m) _Pragma("unroll") for (int n = 0; n < 2; ++n) _Pragma("unroll") for (int k = 0; k < 2; ++k) \
        acc[ai][bj][m][n] = __builtin_amdgcn_mfma_f32_16x16x32_bf16(Bt[n][k], At[m][k], acc[ai][bj][m][n], 0, 0, 0); __builtin_amdgcn_s_setprio(0); } while (0)
#define PG8_WAIT_V(n) asm volatile("s_waitcnt vmcnt(" #n ")" ::: "memory")
#define PG8_WAIT_L(n) asm volatile("s_waitcnt lgkmcnt(" #n ")" ::: "memory")
#define PG8_BAR __builtin_amdgcn_s_barrier()
#define PG8_SCHED __builtin_amdgcn_sched_barrier(0)
    Unit cur, nxt; int ui = 0;
    if (!S.next(0, cur)) return;
    f32x4 acc[2][2][4][2];
#pragma unroll
    for (int a = 0; a < 2; ++a)
#pragma unroll
        for (int b = 0; b < 2; ++b)
#pragma unroll
            for (int m = 0; m < 4; ++m)
#pragma unroll
                for (int n = 0; n < 2; ++n) acc[a][b][m][n] = (f32x4){0.f, 0.f, 0.f, 0.f};
    bf16x8 At[4][2], B0[2][2], B1[2][2];
    const char* cA = (const char*)g.A + (size_t)cur.pm * tstep; const char* cB = (const char*)g.Bt + (size_t)cur.pn * tstep;
    PG8_STAGE(PG8_SB(0, 0), cB, voffB); PG8_STAGE(PG8_SB(0, 1), cB + hstep, voffB); PG8_STAGE(PG8_SA(0, 0), cA, voffA); PG8_STAGE(PG8_SA(0, 1), cA + hstep, voffA);
    if (wr == 1) PG8_BAR;
    PG8_WAIT_V(2); PG8_BAR;
    PG8_STAGE(PG8_SB(1, 0), cB + kstep, voffB); PG8_STAGE(PG8_SA(1, 0), cA + kstep, voffA); PG8_STAGE(PG8_SB(1, 1), cB + hstep + kstep, voffB);
    PG8_WAIT_V(6); PG8_BAR;
    for (;;) {
        const bool has_next = S.next(ui + 1, nxt);
        const char* nA = has_next ? (const char*)g.A + (size_t)nxt.pm * tstep : cA; const char* nB = has_next ? (const char*)g.Bt + (size_t)nxt.pn * tstep : cB;
        for (int t = 0; t < nt; t += 2) {
            const bool last = (t == nt - 2);
            const char* a1 = cA + (size_t)(t + 1) * kstep;
            const char* a2 = last ? nA : cA + (size_t)(t + 2) * kstep; const char* b2 = last ? nB : cB + (size_t)(t + 2) * kstep;
            const char* a3 = a2 + kstep; const char* b3 = b2 + kstep;
            PG8_LDB(B0, 0, 0); PG8_LDB(B1, 0, 1); PG8_SCHED; PG8_LDA(At, 0, 0); PG8_STAGE(PG8_SA(1, 1), a1 + hstep, voffA);
            PG8_WAIT_V(8); PG8_WAIT_L(0); PG8_BAR; PG8_MMA(0, 0, At, B0); PG8_MMA(0, 1, At, B1); PG8_BAR; PG8_SCHED;
            PG8_LDA(At, 0, 1); PG8_STAGE(PG8_SB(0, 0), b2, voffB); PG8_STAGE(PG8_SB(0, 1), b2 + hstep, voffB); PG8_STAGE(PG8_SA(0, 0), a2, voffA);
            PG8_WAIT_V(8); PG8_WAIT_L(0); PG8_BAR; PG8_MMA(1, 0, At, B0); PG8_MMA(1, 1, At, B1); PG8_BAR; PG8_SCHED;
            PG8_LDB(B0, 1, 0); PG8_LDB(B1, 1, 1); PG8_SCHED; PG8_LDA(At, 1, 0); PG8_STAGE(PG8_SA(0, 1), a2 + hstep, voffA);
            PG8_WAIT_V(8); PG8_WAIT_L(0); PG8_BAR; PG8_MMA(0, 0, At, B0); PG8_MMA(0, 1, At, B1); PG8_BAR; PG8_SCHED;
            PG8_LDA(At, 1, 1); PG8_STAGE(PG8_SB(1, 0), b3, voffB); PG8_STAGE(PG8_SB(1, 1), b3 + hstep, voffB); PG8_STAGE(PG8_SA(1, 0), a3, voffA);
            PG8_WAIT_V(8); PG8_WAIT_L(0); PG8_BAR; PG8_MMA(1, 0, At, B0); PG8_MMA(1, 1, At, B1); PG8_BAR; PG8_SCHED;
        }
        if constexpr (ALIGN_EPI) { if (wr == 0) PG8_BAR; }
        E(acc, cur, wr, wc, fr, fq);
        if (!has_next) break;
#pragma unroll
        for (int a = 0; a < 2; ++a)
#pragma unroll
            for (int b = 0; b < 2; ++b)
#pragma unroll
                for (int m = 0; m < 4; ++m)
#pragma unroll
                    for (int n = 0; n < 2; ++n) acc[a][b][m][n] = (f32x4){0.f, 0.f, 0.f, 0.f};
        cur = nxt; cA = nA; cB = nB; ++ui;
        if constexpr (ALIGN_EPI) { if (wr == 1) PG8_BAR; }
    }
    PG8_WAIT_V(0);
    if constexpr (!ALIGN_EPI) { if (wr == 0) PG8_BAR; }
    PG8_BAR;
#undef PG8_SA
#undef PG8_SB
#undef PG8_STAGE
#undef PG8_LDA
#undef PG8_LDB
#undef PG8_MMA
#undef PG8_WAIT_V
#undef PG8_WAIT_L
#undef PG8_BAR
#undef PG8_SCHED
}
}

__device__ __forceinline__ void transpose_item(const float* W, int K, int N, bf16_t* WT, LAS float* scr, int item, int lane, bool qscale) {
    const int nblk = N / 32, kb = item / nblk, nb = item % nblk, k0 = 64 * kb, n0 = 32 * nb;
    const float wsc = (qscale && n0 >= C_AQ && n0 < C_AK) ? C2 : 1.f;
#pragma unroll 8
    for (int i = 0; i < 32; ++i) { const int kk = 2 * i + (lane >> 5); scr[kk * 33 + (lane & 31)] = wsc * W[(size_t)(k0 + kk) * N + n0 + (lane & 31)]; }
    asm volatile("s_waitcnt lgkmcnt(0)" ::: "memory");
    const int c = lane & 7;
#pragma unroll
    for (int j = 0; j < 4; ++j) { const int n = (lane >> 3) + 8 * j; const LAS float* s = scr + (8 * c) * 33 + n;
        u32x4 o; o.x = cvt_pk_bf16(s[0 * 33], s[1 * 33]); o.y = cvt_pk_bf16(s[2 * 33], s[3 * 33]); o.z = cvt_pk_bf16(s[4 * 33], s[5 * 33]); o.w = cvt_pk_bf16(s[6 * 33], s[7 * 33]);
        *(u32x4*)(WT + (size_t)(n0 + n) * K + k0 + 8 * c) = o; }
    asm volatile("s_waitcnt lgkmcnt(0)" ::: "memory");
}
__device__ __forceinline__ void sincos_d(double x, float& s, float& c) {
    const double q = __builtin_rint(x * 0.63661977236758134308); const double r = x - q * 1.57079632679489661923; const int qi = (int)q & 3;
    const double r2 = r * r;
    const double sp = r * (1.0 + r2 * (-1.0 / 6 + r2 * (1.0 / 120 + r2 * (-1.0 / 5040 + r2 * (1.0 / 362880 + r2 * (-1.0 / 39916800 + r2 * (1.0 / 6227020800.0)))))));
    const double cp = 1.0 + r2 * (-0.5 + r2 * (1.0 / 24 + r2 * (-1.0 / 720 + r2 * (1.0 / 40320 + r2 * (-1.0 / 3628800 + r2 * (1.0 / 479001600.0))))));
    const double ss = (qi == 0) ? sp : (qi == 1) ? cp : (qi == 2) ? -sp : -cp;
    const double cc = (qi == 0) ? cp : (qi == 1) ? -sp : (qi == 2) ? -cp : sp;
    s = (float)ss; c = (float)cc;
}
__device__ __forceinline__ void g0_prologue(const Ctx& C, LAS unsigned char* lds) {
    const int tid = opaque(threadIdx.x), lane = tid & 63, wid = tid >> 6, G = gridDim.x, bx = blockIdx.x;
    if (bx == G - 1) {
        for (int e = tid; e < 1024; e += 512) { const int pos = e >> 4, i = e & 15;
            const float invf = fexp2(-(float)i * 0.83048202372f);
            const float ang = (float)pos * invf; float s, c; sincos_d((double)ang, s, c);
            C.rope[e * 2] = c; C.rope[e * 2 + 1] = s; }
    }
    constexpr int NMODT = 2 * 48;
    const int nmodb = (G >= 2 * NMODT) ? NMODT : G;
    if (bx < nmodb) {
        LAS float* sl = (LAS float*)lds + wid * (33 * 64);
        for (int task = bx; task < NMODT; task += nmodb) {
            const int l = task / 48, cb = task % 48, col = cb * 64 + lane;
            const float* W = C.mod_w + (size_t)l * DM * 3072;
            float acc[33];
#pragma unroll
            for (int r = 0; r < 33; ++r) acc[r] = 0.f;
            for (int kc = 0; kc < 2; ++kc) {
                const int k0 = wid * 128 + kc * 64;
#pragma unroll
                for (int r = 0; r < 33; ++r) { const float v = (r < 32) ? C.c[r * DM + k0 + lane] : C.c_ctx[k0 + lane]; sl[r * 64 + lane] = siluf_(v); }
                asm volatile("s_waitcnt lgkmcnt(0)" ::: "memory");
                for (int k4 = 0; k4 < 16; ++k4) {
                    const float w0 = W[(size_t)(k0 + 4 * k4 + 0) * 3072 + col], w1 = W[(size_t)(k0 + 4 * k4 + 1) * 3072 + col],
                                w2 = W[(size_t)(k0 + 4 * k4 + 2) * 3072 + col], w3 = W[(size_t)(k0 + 4 * k4 + 3) * 3072 + col];
#pragma unroll
                    for (int r = 0; r < 33; ++r) { const f32x4 sv = *(const LAS f32x4*)(sl + r * 64 + 4 * k4); acc[r] += sv[0] * w0 + sv[1] * w1 + sv[2] * w2 + sv[3] * w3; }
                }
                asm volatile("s_waitcnt lgkmcnt(0)" ::: "memory");
            }
            __syncthreads();
#pragma unroll
            for (int r = 0; r < 33; ++r) sl[r * 64 + lane] = acc[r];
            __syncthreads();
            for (int e = tid; e < 33 * 64; e += 512) { float s = 0.f;
#pragma unroll
                for (int w = 0; w < 8; ++w) s += ((LAS float*)lds)[w * (33 * 64) + e];
                const int r = e >> 6, cc = cb * 64 + (e & 63);
                C.mod[((size_t)l * 33 + r) * 3072 + cc] = s + C.mod_b[l * 3072 + cc]; }
            __syncthreads();
        }
    }
    {
        const bool all = (nmodb == G);
        if (all || bx >= nmodb) {
            const int nb = all ? G : G - nmodb, b0 = all ? bx : bx - nmodb;
            LAS float* scr = (LAS float*)lds + wid * (64 * 33 + 16);
            constexpr int I_IN = 16 * (DIN / 32), I_OUT = 16 * 32, I_UP = 8;
            constexpr int NITEMS = 2 * I_IN + 2 * I_OUT + 16 * I_UP;
            for (int it = b0 * 8 + wid; it < NITEMS; it += nb * 8) {
                int r = it;
                if (r < 2 * I_IN) { const int l = r / I_IN; transpose_item(C.w_in + (size_t)l * DM * DIN, DM, DIN, C.WinT + (size_t)l * DIN * DM, scr, r % I_IN, lane, true); continue; } r -= 2 * I_IN;
                if (r < 2 * I_OUT) { const int l = r / I_OUT; transpose_item(C.w_out + (size_t)l * DM * DM, DM, DM, C.WoutT + (size_t)l * DM * DM, scr, r % I_OUT, lane, false); continue; } r -= 2 * I_OUT;
                { const int mi = r / I_UP, l = mi >> 2, m = mi & 3, d = m & 1;
                  const float* src = ((m < 2) ? C.w_up : C.a_up) + (size_t)(l * 2 + d) * 64 * 256;
                  transpose_item(src, 64, 256, C.WupT + (size_t)(l * 4 + m) * 256 * 64, scr, r % I_UP, lane, false); }
            }
        }
    }
}

template <int MODE>
__device__ __forceinline__ void norm_phase(const Ctx& C, int hf, int gw, int ngw, int lane_in, float pe1 = 0.f, float pe2 = 0.f) {
    const int lane = opaque(lane_in);
    const int nrows = (MODE == 2) ? LATH : MH;
    for (int lr0 = gw * 2; lr0 < nrows; lr0 += ngw * 2) {
        const bool lat = lr0 < LATH;
        int mrow; const float* xin; float* x1p;
        if (lat) { const size_t g = (size_t)hf * LATH + lr0; mrow = hf * HB + lr0 / SEQ; xin = C.x + g * DM; x1p = C.out + g * DM; }
        else { const size_t g = (size_t)hf * CTXH + (lr0 - LATH); mrow = 32; xin = C.ctx + g * DM; x1p = C.xc1 + g * DM; }
        f32x4 v[2][4];
        const float* base = (MODE == 2) ? x1p : xin;
#pragma unroll
        for (int rr = 0; rr < 2; ++rr)
#pragma unroll
            for (int j = 0; j < 4; ++j) v[rr][j] = *(const f32x4*)(base + rr * DM + 4 * lane + 256 * j);
        if (MODE >= 1) {
            const float* gate = C.mod + ((size_t)(MODE - 1) * 33 + mrow) * 3072 + 2048;
            const float* pg = C.post_g + (MODE - 1) * DM;
            const bf16_t* yr = C.Y + (size_t)lr0 * DM;
            f32x4 y[2][4]; float ss[2];
#pragma unroll
            for (int rr = 0; rr < 2; ++rr) { ss[rr] = 0.f;
#pragma unroll
                for (int j = 0; j < 4; ++j) { y[rr][j] = ld_bf4(yr + rr * DM + 4 * lane + 256 * j); ss[rr] += (y[rr][j][0] * y[rr][j][0] + y[rr][j][1] * y[rr][j][1]) + (y[rr][j][2] * y[rr][j][2] + y[rr][j][3] * y[rr][j][3]); } }
            const float rstd0 = __builtin_amdgcn_rsqf(wave_sum(ss[0]) * (1.f / DM) + NORM_EPS), rstd1 = __builtin_amdgcn_rsqf(wave_sum(ss[1]) * (1.f / DM) + NORM_EPS);
#pragma unroll
            for (int j = 0; j < 4; ++j) { const f32x4 gt = *(const f32x4*)(gate + 4 * lane + 256 * j), pgv = *(const f32x4*)(pg + 4 * lane + 256 * j);
#pragma unroll
                for (int rr = 0; rr < 2; ++rr) {
                    v[rr][j] = v[rr][j] + gt * (y[rr][j] * (rr ? rstd1 : rstd0) * pgv);
#ifdef PROBE_A
                    if (MODE == 2 && hf == 1 && lr0 + rr < 1024) { v[rr][j] = v[rr][j] + pe2; if (lr0 + rr == 0 && lane == 0 && j == 0) v[rr][j][0] += pe1; }
#endif
                    *(f32x4*)(x1p + rr * DM + 4 * lane + 256 * j) = v[rr][j]; } }
        }
        if (MODE <= 1) {
            const float* md = C.mod + ((size_t)MODE * 33 + mrow) * 3072;
            const float* pre = C.pre_g + MODE * DM;
            float ss[2];
#pragma unroll
            for (int rr = 0; rr < 2; ++rr) { ss[rr] = 0.f;
#pragma unroll
                for (int j = 0; j < 4; ++j) ss[rr] += (v[rr][j][0] * v[rr][j][0] + v[rr][j][1] * v[rr][j][1]) + (v[rr][j][2] * v[rr][j][2] + v[rr][j][3] * v[rr][j][3]); }
            const float rstd0 = __builtin_amdgcn_rsqf(wave_sum(ss[0]) * (1.f / DM) + NORM_EPS), rstd1 = __builtin_amdgcn_rsqf(wave_sum(ss[1]) * (1.f / DM) + NORM_EPS);
            bf16_t* hr = C.H + (size_t)lr0 * DM;
#pragma unroll
            for (int j = 0; j < 4; ++j) { const f32x4 sh = *(const f32x4*)(md + 4 * lane + 256 * j), scl = *(const f32x4*)(md + 1024 + 4 * lane + 256 * j), pv = *(const f32x4*)(pre + 4 * lane + 256 * j);
#pragma unroll
                for (int rr = 0; rr < 2; ++rr) st_bf4(hr + rr * DM + 4 * lane + 256 * j, (v[rr][j] * (rr ? rstd1 : rstd0) * pv) * (1.f + scl) + sh); }
        }
    }
}

__device__ __forceinline__ int crow(int r, int hi) { return (r & 3) + 8 * (r >> 2) + 4 * hi; }
__device__ __forceinline__ bf16x8 tanh8(bf16x8 x) {
    const u32x4 w = __builtin_bit_cast(u32x4, x); u32x4 o;
#pragma unroll
    for (int i = 0; i < 4; ++i) { const float a = bf_lo(w[i]), b = bf_hi(w[i]);
        const float ta = 1.f - 2.f * frcp(1.f + fexp2(2.885390081777927f * a)), tb = 1.f - 2.f * frcp(1.f + fexp2(2.885390081777927f * b));
        o[i] = cvt_pk_bf16(ta, tb); }
    return __builtin_bit_cast(bf16x8, o);
}
__device__ __forceinline__ void prep_block(const Ctx& C, int l, int task, LAS unsigned char* lds) {
    const int tid = opaque(threadIdx.x), lane = tid & 63, wid = __builtin_amdgcn_readfirstlane(tid >> 6);
    const int r32 = lane & 31, hi = lane >> 5, lr0 = task * 64;
    constexpr int PST = 520;
    LAS bf16_t* xs = (LAS bf16_t*)lds;
#pragma unroll
    for (int i = 0; i < 8; ++i) { const int idx = tid + 512 * i, row = idx >> 6, ch = idx & 63;
        const u32x4 v = *(const u32x4*)(C.P + (size_t)(lr0 + row) * DIN + (ch < 32 ? C_K + ch * 8 : C_LWF + (ch - 32) * 8));
        *(LAS u32x4*)(xs + row * PST + ch * 8) = v; }
    __syncthreads();
    const int tg = wid & 1, q = wid >> 1, lrw = lr0 + tg * 32;
    const LAS bf16_t* xrow = xs + (tg * 32 + r32) * PST + hi * 8;
    const LAS bf16_t* xcol = xs + (tg * 32) * PST;
    const bf16_t* WT = C.WupT + (size_t)l * 4 * 256 * 64;
    constexpr size_t ARR = (size_t)MH * 256;
#pragma unroll 1
    for (int d = 0; d < 2; ++d) {
        bf16x8 xf[4];
#pragma unroll
        for (int i0 = 0; i0 < 4; ++i0) xf[i0] = tanh8(*(const LAS bf16x8*)(xrow + 256 + d * 64 + i0 * 16));
        const bf16_t* wt = WT + (size_t)d * 256 * 64;
        const float* w0 = C.w0 + (l * 2 + d) * 256;
        float* dst = C.SC + (size_t)d * ARR;
#pragma unroll 1
        for (int jb = 2 * q; jb < 2 * q + 2; ++jb) {
            const int j = jb * 32 + r32;
            f32x16 acc = {};
#pragma unroll
            for (int i0 = 0; i0 < 4; ++i0) { const bf16x8 wf = *(const bf16x8*)(wt + (size_t)j * 64 + i0 * 16 + hi * 8); acc = __builtin_amdgcn_mfma_f32_32x32x16_bf16(xf[i0], wf, acc, 0, 0, 0); }
            const float w0j = w0[j];
#pragma unroll
            for (int r = 0; r < 16; ++r) { const int row = lrw + crow(r, hi);
                const float sg = sigmoidf_(acc[r] + w0j);
                dst[(size_t)row * 256 + j] = fexp2(-0.8750429636f * sg); }
        }
    }
    {
        const int hd = q;
        float rn[16];
        { const float kk0 = C.k_k[l * 256 + hd * 64 + r32], kk1 = C.k_k[l * 256 + hd * 64 + 32 + r32];
#pragma unroll
          for (int r = 0; r < 16; ++r) { const LAS bf16_t* kp = xcol + crow(r, hi) * PST + hd * 64 + r32;
              const float a = bf2f(kp[0]) * kk0, b = bf2f(kp[32]) * kk1; const float s = sum32(a * a + b * b);
              rn[r] = frcp(fmaxf(__builtin_sqrtf(s), 1e-12f)); } }
#pragma unroll 1
        for (int jd = 0; jd < 4; ++jd) {
            const int jb2 = jd >> 1, d = jd & 1;
            const int j = hd * 64 + jb2 * 32 + r32;
            const float kkj = C.k_k[l * 256 + j], kaj = C.k_a[l * 256 + j];
            const bf16_t* wt = WT + (size_t)(2 + d) * 256 * 64;
            f32x16 acc = {};
#pragma unroll
            for (int i0 = 0; i0 < 4; ++i0) { const bf16x8 xf = *(const LAS bf16x8*)(xrow + 384 + d * 64 + i0 * 16);
                const bf16x8 wf = *(const bf16x8*)(wt + (size_t)j * 64 + i0 * 16 + hi * 8); acc = __builtin_amdgcn_mfma_f32_32x32x16_bf16(xf, wf, acc, 0, 0, 0); }
            const float a0j = C.a0[(l * 2 + d) * 256 + j];
            bf16_t* sb16 = (bf16_t*)(C.SC + 2 * ARR);
            bf16_t* dkm = sb16 + (size_t)d * ARR; bf16_t* dbb = sb16 + (size_t)(2 + d) * ARR; bf16_t* daa = sb16 + 4 * ARR;
#pragma unroll
            for (int r = 0; r < 16; ++r) { const int cr = crow(r, hi); const size_t off = (size_t)(lrw + cr) * 256 + j;
                const float k = bf2f(xcol[cr * PST + j]);
                const float a = sigmoidf_(acc[r] + a0j), kkn = k * kkj * rn[r];
                const unsigned pk_ = cvt_pk_bf16(k * (1.f + (a - 1.f) * kaj), kkn * a);
                dkm[off] = (bf16_t)(pk_ & 0xffffu); dbb[off] = (bf16_t)(pk_ >> 16); if (d == 0) daa[off] = (bf16_t)(cvt_pk_bf16(-kkn, 0.f) & 0xffffu); }
        }
    }
    __syncthreads();
}
__device__ __forceinline__ void rowpass4(const Ctx& C, int l, int r0, int lane_in, bool do_conv) {
    const int lane = opaque(lane_in);
    const bool lat = r0 < LATH; const int t0 = lat ? (r0 & (SEQ - 1)) : ((r0 - LATH) & (CTX - 1)), len = lat ? SEQ : CTX;
    const bf16_t* pr = C.P + (size_t)r0 * DIN; const int c = 4 * lane;
    u32x4 qw[4], kw[4];
    if (lat) {
#pragma unroll
        for (int i = 0; i < 4; ++i) { qw[i] = *(const u32x4*)(pr + (size_t)i * DIN + C_AQ + 8 * lane); kw[i] = *(const u32x4*)(pr + (size_t)i * DIN + C_AK + 8 * lane); }
    }
    if (do_conv) {
        f32x4 u[6], bg[4], z[4];
#pragma unroll
        for (int i = 0; i < 6; ++i) { const bool ok = (i == 0) ? (t0 > 0) : (i == 5) ? (t0 + 4 < len) : true;
            const bf16_t* p = pr + (long)(i - 1) * DIN;
            u[i] = ok ? ld_bf4(p + C_CC + c) * ld_bf4(p + C_CH + c) : (f32x4){0.f, 0.f, 0.f, 0.f}; }
#pragma unroll
        for (int i = 0; i < 4; ++i) { bg[i] = ld_bf4(pr + (size_t)i * DIN + C_CB + c); z[i] = ld_bf4(pr + (size_t)i * DIN + C_CZ + c); }
        const float* cw = C.conv_w + l * 3 * 256 + c;
        const f32x4 w0 = *(const f32x4*)cw, w1 = *(const f32x4*)(cw + 256), w2 = *(const f32x4*)(cw + 512);
#pragma unroll
        for (int i = 0; i < 4; ++i) { const f32x4 y = u[i] * w0 + u[i + 1] * w1 + u[i + 2] * w2;
            f32x4 o; o[0] = bg[i][0] * y[0] * siluf_(z[i][0]); o[1] = bg[i][1] * y[1] * siluf_(z[i][1]); o[2] = bg[i][2] * y[2] * siluf_(z[i][2]); o[3] = bg[i][3] * y[3] * siluf_(z[i][3]);
            st_bf4(C.H + (size_t)(r0 + i) * DM + 256 + c, o); }
    }
    if (lat) {
        const float sg = (lane & 2) ? 1.f : -1.f;
#pragma unroll
        for (int i = 0; i < 4; ++i) {
            const int t = t0 + i; const int pos = ((lane >> 2) & 1) ? (t & 63) : (t >> 6);
            const f32x4* rp = (const f32x4*)(C.rope + (pos * 16 + 8 * (lane & 1)) * 2);
            const f32x4 c0 = rp[0], c1 = rp[1], c2 = rp[2], c3 = rp[3];
#pragma unroll
            for (int which = 0; which < 2; ++which) {
                const u32x4 w = which ? kw[i] : qw[i]; u32x4 pw;
#pragma unroll
                for (int e = 0; e < 4; ++e) pw[e] = (unsigned)__builtin_amdgcn_update_dpp(0, (int)w[e], 0x4E, 0xF, 0xF, true);
                u32x4 o;
                o[0] = cvt_pk_bf16(bf_lo(w[0]) * c0[0] + sg * bf_lo(pw[0]) * c0[1], bf_hi(w[0]) * c0[2] + sg * bf_hi(pw[0]) * c0[3]);
                o[1] = cvt_pk_bf16(bf_lo(w[1]) * c1[0] + sg * bf_lo(pw[1]) * c1[1], bf_hi(w[1]) * c1[2] + sg * bf_hi(pw[1]) * c1[3]);
                o[2] = cvt_pk_bf16(bf_lo(w[2]) * c2[0] + sg * bf_lo(pw[2]) * c2[1], bf_hi(w[2]) * c2[2] + sg * bf_hi(pw[2]) * c2[3]);
                o[3] = cvt_pk_bf16(bf_lo(w[3]) * c3[0] + sg * bf_lo(pw[3]) * c3[1], bf_hi(w[3]) * c3[2] + sg * bf_hi(pw[3]) * c3[3]);
                *(u32x4*)(C.P + (size_t)(r0 + i) * DIN + (which ? C_AK : C_AQ) + 8 * lane) = o;
            }
        }
    }
}
__device__ __forceinline__ void conv_row(const Ctx& C, int l, int lr, int lane_in) {
    const int lane = opaque(lane_in);
    const bool lat = lr < LATH; const int t = lat ? (lr & (SEQ - 1)) : ((lr - LATH) & (CTX - 1)), len = lat ? SEQ : CTX;
    const bf16_t* pr = C.P + (size_t)lr * DIN; const int c = 4 * lane;
    const float* cw = C.conv_w + l * 3 * 256 + c;
    const f32x4 w0 = *(const f32x4*)cw, w1 = *(const f32x4*)(cw + 256), w2 = *(const f32x4*)(cw + 512);
    f32x4 y = (ld_bf4(pr + C_CC + c) * ld_bf4(pr + C_CH + c)) * w1;
    if (t > 0) y = y + (ld_bf4(pr - DIN + C_CC + c) * ld_bf4(pr - DIN + C_CH + c)) * w0;
    if (t < len - 1) y = y + (ld_bf4(pr + DIN + C_CC + c) * ld_bf4(pr + DIN + C_CH + c)) * w2;
    const f32x4 bg = ld_bf4(pr + C_CB + c), z = ld_bf4(pr + C_CZ + c);
    f32x4 o; o[0] = bg[0] * y[0] * siluf_(z[0]); o[1] = bg[1] * y[1] * siluf_(z[1]); o[2] = bg[2] * y[2] * siluf_(z[2]); o[3] = bg[3] * y[3] * siluf_(z[3]);
    st_bf4(C.H + (size_t)lr * DM + 256 + c, o);
}

__device__ __forceinline__ void rope_row(const Ctx& C, int lr, int lane_in) {
    const int lane = opaque(lane_in);
    const int t = lr & (SEQ - 1); const int pos = ((lane >> 2) & 1) ? (t & 63) : (t >> 6);
    const f32x4* rp = (const f32x4*)(C.rope + (pos * 16 + 8 * (lane & 1)) * 2);
    const f32x4 c0 = rp[0], c1 = rp[1], c2 = rp[2], c3 = rp[3];
    const float sg = (lane & 2) ? 1.f : -1.f;
#pragma unroll
    for (int which = 0; which < 2; ++which) {
        bf16_t* p = C.P + (size_t)lr * DIN + (which ? C_AK : C_AQ) + 8 * lane;
        const u32x4 w = *(const u32x4*)p; u32x4 pw;
#pragma unroll
        for (int i = 0; i < 4; ++i) pw[i] = (unsigned)__builtin_amdgcn_update_dpp(0, (int)w[i], 0x4E, 0xF, 0xF, true);
        u32x4 o;
        o[0] = cvt_pk_bf16(bf_lo(w[0]) * c0[0] + sg * bf_lo(pw[0]) * c0[1], bf_hi(w[0]) * c0[2] + sg * bf_hi(pw[0]) * c0[3]);
        o[1] = cvt_pk_bf16(bf_lo(w[1]) * c1[0] + sg * bf_lo(pw[1]) * c1[1], bf_hi(w[1]) * c1[2] + sg * bf_hi(pw[1]) * c1[3]);
        o[2] = cvt_pk_bf16(bf_lo(w[2]) * c2[0] + sg * bf_lo(pw[2]) * c2[1], bf_hi(w[2]) * c2[2] + sg * bf_hi(pw[2]) * c2[3]);
        o[3] = cvt_pk_bf16(bf_lo(w[3]) * c3[0] + sg * bf_lo(pw[3]) * c3[1], bf_hi(w[3]) * c3[2] + sg * bf_hi(pw[3]) * c3[3]);
        *(u32x4*)p = o;
    }
}

__device__ __forceinline__ int scan_row(int s, int dir, int bl) {
    if (s < CTX) { const int t = dir ? (CTX - 1 - s) : s; return LATH + bl * CTX + t; }
    const int t0 = s - CTX; const int t = dir ? (SEQ - 1 - t0) : t0; return bl * SEQ + t;
}
__device__ __forceinline__ void scan_unit(const Ctx& C, int l, int u, LAS unsigned char* lds) {
    const int bl = u >> 3, hd = (u >> 1) & 3, dir = u & 1;
    const int tid = opaque(threadIdx.x), lane = tid & 63, wid = __builtin_amdgcn_readfirstlane(tid >> 6);
    constexpr size_t ARR = (size_t)MH * 256;
    constexpr int CHF = 32 * 6 * 64;
    constexpr int YB0 = 2 * CHF;
    const int lst = tid >> 4, q4 = tid & 15;
    const float* a_dec = C.SC + (size_t)dir * ARR + hd * 64 + q4 * 4;
    const bf16_t* sb16 = (const bf16_t*)(C.SC + 2 * ARR);
    const bf16_t* a_km = sb16 + (size_t)dir * ARR + hd * 64 + q4 * 4;
    const bf16_t* a_bb = sb16 + (size_t)(2 + dir) * ARR + hd * 64 + q4 * 4;
    const bf16_t* a_aa = sb16 + 4 * ARR + hd * 64 + q4 * 4;
    const bf16_t* a_r = C.P + C_R + hd * 64 + q4 * 4;
    const bf16_t* a_v = C.P + C_V + hd * 64 + q4 * 4;
    float* a_y = C.YS + (size_t)dir * ARR + hd * 64 + q4 * 4;
    f32x4 g0, g1, g2, g3, g4, g5;
#define SC_LOAD(c) do { const size_t row_ = (size_t)scan_row((c) * 32 + lst, dir, bl); \
        g0 = *(const f32x4*)(a_dec + row_ * 256); g1 = ld_bf4(a_km + row_ * 256); g2 = ld_bf4(a_aa + row_ * 256); g3 = ld_bf4(a_bb + row_ * 256); \
        g4 = ld_bf4(a_r + row_ * DIN); g5 = ld_bf4(a_v + row_ * DIN); } while (0)
#define SC_WRITE(b) do { LAS float* d_ = (LAS float*)lds + (b) * CHF + lst * 384 + q4 * 4; \
        *(LAS f32x4*)(d_) = g0; *(LAS f32x4*)(d_ + 64) = g1; *(LAS f32x4*)(d_ + 128) = g2; *(LAS f32x4*)(d_ + 192) = g3; *(LAS f32x4*)(d_ + 256) = g4; *(LAS f32x4*)(d_ + 320) = g5; } while (0)
    f32x4 S0 = {0.f, 0.f, 0.f, 0.f}, S1 = {0.f, 0.f, 0.f, 0.f};
    const int vq = lane >> 4, k16 = lane & 15;
    const int rloc = 8 * wid + 2 * vq;
    SC_LOAD(0); SC_WRITE(0); __syncthreads();
    constexpr int NCH = (CTX + SEQ) / 32;
#pragma unroll 1
    for (int c = 0; c < NCH; ++c) {
        if (c > 0 && ((c - 1 >= CTX / 32) || (l == 0))) {
            const f32x4 yv = *(const LAS f32x4*)((const LAS float*)lds + YB0 + ((c - 1) & 1) * 2048 + lst * 64 + q4 * 4);
            *(f32x4*)(a_y + (size_t)scan_row((c - 1) * 32 + lst, dir, bl) * 256) = yv;
        }
        if (c + 1 < NCH) SC_LOAD(c + 1);
        {
            const LAS float* cb = (const LAS float*)lds + (c & 1) * CHF + k16 * 4;
            const LAS float* vbp = (const LAS float*)lds + (c & 1) * CHF + 320 + rloc;
            LAS float* yb = (LAS float*)lds + YB0 + (c & 1) * 2048 + rloc + (k16 & 1);
            const bool wout = (c >= CTX / 32) || (l == 0);
            f32x4 wA, kA, aA, bA, rA, wB, kB, aB, bB, rB; f32x2 vA, vB;
#define SC_RD(W, K, A, B, R, V, s) do { const LAS float* sb_ = cb + (s) * 384; W = *(const LAS f32x4*)(sb_); K = *(const LAS f32x4*)(sb_ + 64); A = *(const LAS f32x4*)(sb_ + 128); \
        B = *(const LAS f32x4*)(sb_ + 192); R = *(const LAS f32x4*)(sb_ + 256); V = *(const LAS f32x2*)(vbp + (s) * 384); } while (0)
#define SC_STEP(W, K, A, B, R, V, DOST, s) do { \
        float sa0 = fmaf(S0[3], A[3], fmaf(S0[2], A[2], fmaf(S0[1], A[1], S0[0] * A[0]))); \
        float sa1 = fmaf(S1[3], A[3], fmaf(S1[2], A[2], fmaf(S1[1], A[1], S1[0] * A[0]))); \
        sa0 = sum16(sa0); sa1 = sum16(sa1); \
        S0 = S0 * W + sa0 * B + V[0] * K; S1 = S1 * W + sa1 * B + V[1] * K; \
        if (DOST) { \
        float y0 = fmaf(S0[3], R[3], fmaf(S0[2], R[2], fmaf(S0[1], R[1], S0[0] * R[0]))); \
        float y1 = fmaf(S1[3], R[3], fmaf(S1[2], R[2], fmaf(S1[1], R[1], S1[0] * R[0]))); \
        y0 = sum16(y0); y1 = sum16(y1); \
        yb[(s) * 64] = (k16 & 1) ? y1 : y0; } } while (0)
            SC_RD(wA, kA, aA, bA, rA, vA, 0);
            if (wout) {
#pragma unroll 2
                for (int s = 0; s < 32; s += 2) { SC_RD(wB, kB, aB, bB, rB, vB, s + 1); SC_STEP(wA, kA, aA, bA, rA, vA, true, s);
                                                  SC_RD(wA, kA, aA, bA, rA, vA, s + 2); SC_STEP(wB, kB, aB, bB, rB, vB, true, s + 1); }
            } else {
#pragma unroll 2
                for (int s = 0; s < 32; s += 2) { SC_RD(wB, kB, aB, bB, rB, vB, s + 1); SC_STEP(wA, kA, aA, bA, rA, vA, false, s);
                                                  SC_RD(wA, kA, aA, bA, rA, vA, s + 2); SC_STEP(wB, kB, aB, bB, rB, vB, false, s + 1); }
            }
#undef SC_RD
#undef SC_STEP
        }
        if (c + 1 < NCH) SC_WRITE((c + 1) & 1);
        __syncthreads();
    }
    { const f32x4 yv = *(const LAS f32x4*)((const LAS float*)lds + YB0 + ((NCH - 1) & 1) * 2048 + lst * 64 + q4 * 4);
      *(f32x4*)(a_y + (size_t)scan_row((NCH - 1) * 32 + lst, dir, bl) * 256) = yv; }
    __syncthreads();
#undef SC_LOAD
#undef SC_WRITE
}

constexpr int CK_RAW = 0, CK_XA = 24576, CK_ZB = 29184, CK_EZ = 33792  , CK_UV = 44032  , CK_PP = 54272, CK_S0 = 56832, CK_GF = 66048, CK_R0 = 70656, CK_DC = 79872  , CK_END = 80384;
__device__ __forceinline__ void ck_images(LAS float* RAW, LAS bf16_t* XA, LAS bf16_t* ZB, LAS bf16_t* EZ, LAS bf16_t* UV, LAS float* DC, int s) {
    const int lt = s >> 5, kp = (s & 31) * 2;
    float c0 = 1.f, c1 = 1.f, cp0 = 1.f, cp1 = 1.f, ct0 = 1.f, ct1 = 1.f;
#pragma unroll
    for (int j = 0; j < 16; ++j) { const f32x2 w = *(const LAS f32x2*)(RAW + j * 64 + kp); if (j == lt) { cp0 = c0; cp1 = c1; } c0 *= w[0]; c1 *= w[1]; if (j == lt) { ct0 = c0; ct1 = c1; } }
    const f32x2 aa = *(const LAS f32x2*)(RAW + 1024 + lt * 64 + kp), bb = *(const LAS f32x2*)(RAW + 2048 + lt * 64 + kp), km = *(const LAS f32x2*)(RAW + 3072 + lt * 64 + kp),
                rr = *(const LAS f32x2*)(RAW + 4096 + lt * 64 + kp), vv = *(const LAS f32x2*)(RAW + 5120 + lt * 64 + kp);
    const float en0 = frcp(ct0), en1 = frcp(ct1), ee0 = c0 * en0, ee1 = c1 * en1;
    *(LAS unsigned*)(XA + lt * 72 + kp) = cvt_pk_bf16(aa[0] * cp0, aa[1] * cp1);
    *(LAS unsigned*)(XA + (16 + lt) * 72 + kp) = cvt_pk_bf16(rr[0] * ct0, rr[1] * ct1);
    *(LAS unsigned*)(ZB + lt * 72 + kp) = cvt_pk_bf16(bb[0] * en0, bb[1] * en1);
    *(LAS unsigned*)(ZB + (16 + lt) * 72 + kp) = cvt_pk_bf16(km[0] * en0, km[1] * en1);
    const unsigned eb = cvt_pk_bf16(bb[0] * ee0, bb[1] * ee1), ek = cvt_pk_bf16(km[0] * ee0, km[1] * ee1), ev = cvt_pk_bf16(vv[0], vv[1]);
    EZ[kp * 40 + lt] = (bf16_t)(eb & 0xffffu); EZ[(kp + 1) * 40 + lt] = (bf16_t)(eb >> 16);
    EZ[kp * 40 + 16 + lt] = (bf16_t)(ek & 0xffffu); EZ[(kp + 1) * 40 + 16 + lt] = (bf16_t)(ek >> 16);
    UV[kp * 40 + 16 + lt] = (bf16_t)(ev & 0xffffu); UV[(kp + 1) * 40 + 16 + lt] = (bf16_t)(ev >> 16);
    if (lt == 0) *(LAS f32x2*)(DC + kp) = (f32x2){c0, c1};
}
__device__ __forceinline__ void scan_chunked(const Ctx& C, int l, int u, LAS unsigned char* lds) {
    const int bl = u >> 3, hd = (u >> 1) & 3, dir = u & 1;
    const int tid0 = opaque(threadIdx.x), wid = __builtin_amdgcn_readfirstlane(tid0 >> 6);
    constexpr size_t ARR = (size_t)MH * 256;
    LAS float* RAW = (LAS float*)(lds + CK_RAW);
    LAS bf16_t* XA = (LAS bf16_t*)(lds + CK_XA);
    LAS bf16_t* ZB = (LAS bf16_t*)(lds + CK_ZB);
    LAS bf16_t* EZ0 = (LAS bf16_t*)(lds + CK_EZ);
    LAS bf16_t* UV0 = (LAS bf16_t*)(lds + CK_UV);
    LAS bf16_t* PP = (LAS bf16_t*)(lds + CK_PP);
    LAS bf16_t* S0 = (LAS bf16_t*)(lds + CK_S0);
    LAS float* GF = (LAS float*)(lds + CK_GF);
    LAS float* R0 = (LAS float*)(lds + CK_R0);
    LAS float* DC0 = (LAS float*)(lds + CK_DC);
    const bf16_t* sb16 = (const bf16_t*)(C.SC + 2 * ARR);
    f32x2 ld_w; unsigned ld_km, ld_bb, ld_aa, ld_r, ld_v;
#define CK_LOAD(c) do { const int tl_ = opaque(tid0); const size_t row_ = (size_t)scan_row((c) * 16 + (tl_ >> 5), dir, bl); const size_t o2_ = row_ * 256 + hd * 64 + (tl_ & 31) * 2, op_ = row_ * DIN + hd * 64 + (tl_ & 31) * 2; \
        ld_w = *(const f32x2*)(C.SC + (size_t)dir * ARR + o2_); ld_km = *(const unsigned*)(sb16 + (size_t)dir * ARR + o2_); \
        ld_bb = *(const unsigned*)(sb16 + (size_t)(2 + dir) * ARR + o2_); ld_aa = *(const unsigned*)(sb16 + 4 * ARR + o2_); ld_r = *(const unsigned*)(C.P + C_R + op_); ld_v = *(const unsigned*)(C.P + C_V + op_); } while (0)
#define CK_STORE() do { const int ts_ = opaque(tid0); LAS float* q_ = RAW + (ts_ >> 5) * 64 + (ts_ & 31) * 2; \
        *(LAS f32x2*)(q_) = ld_w; *(LAS f32x2*)(q_ + 1024) = (f32x2){bf_lo(ld_aa), bf_hi(ld_aa)}; \
        *(LAS f32x2*)(q_ + 2048) = (f32x2){bf_lo(ld_bb), bf_hi(ld_bb)}; *(LAS f32x2*)(q_ + 3072) = (f32x2){bf_lo(ld_km), bf_hi(ld_km)}; \
        *(LAS f32x2*)(q_ + 4096) = (f32x2){bf_lo(ld_r), bf_hi(ld_r)}; *(LAS f32x2*)(q_ + 5120) = (f32x2){bf_lo(ld_v), bf_hi(ld_v)}; } while (0)
    for (int e = tid0; e < CK_END / 4; e += 512) ((LAS unsigned*)lds)[e] = 0u;
    __syncthreads();
    f32x16 S = {};
    const int vt = (wid >> 1) & 1, kt = wid & 1;
    constexpr int NCH = (CTX + SEQ) / 16;
    CK_LOAD(0); CK_STORE(); __syncthreads();
    ck_images(RAW, XA, ZB, EZ0, UV0, DC0, opaque(tid0));
    CK_LOAD(1);
    __syncthreads();
#pragma unroll 1
    for (int c = 0; c < NCH; ++c) {
        const int pb = c & 1;
        LAS bf16_t* EZ = EZ0 + pb * (64 * 40); LAS bf16_t* UV = UV0 + pb * (64 * 40); LAS float* DC = DC0 + pb * 64;
        if (c + 1 < NCH) CK_STORE();
        if (c + 2 < NCH) CK_LOAD(c + 2);
        if (wid == 0) {
            const int ln = opaque(tid0) & 63, r32 = ln & 31, hi = ln >> 5;
            f32x16 acc = {};
#pragma unroll
            for (int d0 = 0; d0 < 4; ++d0) { const bf16x8 a = *(const LAS bf16x8*)(XA + r32 * 72 + d0 * 16 + hi * 8), b = *(const LAS bf16x8*)(ZB + r32 * 72 + d0 * 16 + hi * 8);
                acc = __builtin_amdgcn_mfma_f32_32x32x16_bf16(a, b, acc, 0, 0, 0); }
#pragma unroll
            for (int r = 0; r < 16; ++r) GF[crow(r, hi) * 36 + r32] = acc[r];
        } else if (wid <= 2) {
            const int ln = opaque(tid0) & 63, r32 = ln & 31, hi = ln >> 5;
            const int v0 = (wid - 1) * 32;
            f32x16 acc = {};
#pragma unroll
            for (int d0 = 0; d0 < 4; ++d0) { const bf16x8 a = *(const LAS bf16x8*)(S0 + (v0 + r32) * 72 + d0 * 16 + hi * 8), b = *(const LAS bf16x8*)(XA + r32 * 72 + d0 * 16 + hi * 8);
                acc = __builtin_amdgcn_mfma_f32_32x32x16_bf16(a, b, acc, 0, 0, 0); }
#pragma unroll
            for (int r = 0; r < 16; ++r) R0[(v0 + crow(r, hi)) * 36 + r32] = acc[r];
        }
        __syncthreads();
        if (wid == 3) {
            const int v = opaque(tid0) & 63;
            float uu[16], vq[16];
#pragma unroll
            for (int q = 0; q < 4; ++q) { const f32x4 x = *(const LAS f32x4*)(R0 + v * 36 + 4 * q); uu[4 * q] = x[0]; uu[4 * q + 1] = x[1]; uu[4 * q + 2] = x[2]; uu[4 * q + 3] = x[3]; }
#pragma unroll
            for (int q = 0; q < 2; ++q) { const u32x4 x = *(const LAS u32x4*)(UV + v * 40 + 16 + 8 * q);
#pragma unroll
                for (int e = 0; e < 4; ++e) { vq[8 * q + 2 * e] = bf_lo(x[e]); vq[8 * q + 2 * e + 1] = bf_hi(x[e]); } }
#pragma unroll
            for (int t = 1; t < 16; ++t) {
                float a0 = uu[t], a1 = 0.f, a2 = 0.f, a3 = 0.f;
#pragma unroll
                for (int q = 0; q * 4 < t; ++q) { const f32x4 m = *(const LAS f32x4*)(GF + t * 36 + 4 * q), n = *(const LAS f32x4*)(GF + t * 36 + 16 + 4 * q);
#pragma unroll
                    for (int e = 0; e < 4; ++e) if (4 * q + e < t) { if (e & 1) { a1 = fmaf(uu[4 * q + e], m[e], a1); a3 = fmaf(vq[4 * q + e], n[e], a3); } else { a0 = fmaf(uu[4 * q + e], m[e], a0); a2 = fmaf(vq[4 * q + e], n[e], a2); } } }
                uu[t] = (a0 + a1) + (a2 + a3);
            }
            u32x4 w0, w1;
            w0[0] = cvt_pk_bf16(uu[0], uu[1]); w0[1] = cvt_pk_bf16(uu[2], uu[3]); w0[2] = cvt_pk_bf16(uu[4], uu[5]); w0[3] = cvt_pk_bf16(uu[6], uu[7]);
            w1[0] = cvt_pk_bf16(uu[8], uu[9]); w1[1] = cvt_pk_bf16(uu[10], uu[11]); w1[2] = cvt_pk_bf16(uu[12], uu[13]); w1[3] = cvt_pk_bf16(uu[14], uu[15]);
            *(LAS u32x4*)(UV + v * 40) = w0; *(LAS u32x4*)(UV + v * 40 + 8) = w1;
        } else if (wid == 4) {
            const int ln = opaque(tid0) & 63; const int t = ln >> 2, jq = (ln & 3) * 8;
            const f32x4 g0 = *(const LAS f32x4*)(GF + (16 + t) * 36 + jq), g1 = *(const LAS f32x4*)(GF + (16 + t) * 36 + jq + 4);
            float x[8] = {g0[0], g0[1], g0[2], g0[3], g1[0], g1[1], g1[2], g1[3]};
#pragma unroll
            for (int e = 0; e < 8; ++e) { const int i = (jq + e) & 15; if (i > t) x[e] = 0.f; }
            u32x4 w; w[0] = cvt_pk_bf16(x[0], x[1]); w[1] = cvt_pk_bf16(x[2], x[3]); w[2] = cvt_pk_bf16(x[4], x[5]); w[3] = cvt_pk_bf16(x[6], x[7]);
            *(LAS u32x4*)(PP + t * 40 + jq) = w;
        } else if (c + 1 < NCH) {
            const int w6 = (wid < 3) ? wid : wid - 2;
            const int s0 = w6 * 64 + (opaque(tid0) & 63);
            LAS bf16_t* EZn = EZ0 + (pb ^ 1) * (64 * 40); LAS bf16_t* UVn = UV0 + (pb ^ 1) * (64 * 40); LAS float* DCn = DC0 + (pb ^ 1) * 64;
            ck_images(RAW, XA, ZB, EZn, UVn, DCn, s0);
            if (s0 < 128) ck_images(RAW, XA, ZB, EZn, UVn, DCn, s0 + 384);
        }
        __syncthreads();
        if (wid < 4) {
            const int ln = opaque(tid0) & 63, r32 = ln & 31, hi = ln >> 5;
            const float dc = DC[kt * 32 + r32];
#pragma unroll
            for (int r = 0; r < 16; ++r) S[r] *= dc;
#pragma unroll
            for (int js = 0; js < 2; ++js) { const bf16x8 a = *(const LAS bf16x8*)(UV + (vt * 32 + r32) * 40 + js * 16 + hi * 8), b = *(const LAS bf16x8*)(EZ + (kt * 32 + r32) * 40 + js * 16 + hi * 8);
                S = __builtin_amdgcn_mfma_f32_32x32x16_bf16(a, b, S, 0, 0, 0); }
            asm volatile("s_nop 15\n\ts_nop 7" : "+v"(S));
#pragma unroll
            for (int r = 0; r < 16; r += 2) { const unsigned pk = cvt_pk_bf16(S[r], S[r + 1]);
                S0[(vt * 32 + crow(r, hi)) * 72 + kt * 32 + r32] = (bf16_t)(pk & 0xffffu); S0[(vt * 32 + crow(r + 1, hi)) * 72 + kt * 32 + r32] = (bf16_t)(pk >> 16); }
        } else if ((wid == 5 || wid == 6) && ((c >= CTX / 16) || (l == 0))) {
            const int ln = opaque(tid0) & 63, r32 = ln & 31, hi = ln >> 5;
            const int v0 = (wid - 5) * 32;
            f32x16 acc;
#pragma unroll
            for (int r = 0; r < 16; ++r) acc[r] = (r32 < 16) ? R0[(v0 + crow(r, hi)) * 36 + 16 + r32] : 0.f;
#pragma unroll
            for (int js = 0; js < 2; ++js) { const bf16x8 a = *(const LAS bf16x8*)(UV + (v0 + r32) * 40 + js * 16 + hi * 8), b = *(const LAS bf16x8*)(PP + r32 * 40 + js * 16 + hi * 8);
                acc = __builtin_amdgcn_mfma_f32_32x32x16_bf16(a, b, acc, 0, 0, 0); }
            if (r32 < 16) { float* yp = C.YS + (size_t)dir * ARR + hd * 64 + (size_t)scan_row(c * 16 + r32, dir, bl) * 256 + v0 + 4 * hi;
#pragma unroll
                for (int q = 0; q < 4; ++q) *(f32x4*)(yp + 8 * q) = (f32x4){acc[4 * q], acc[4 * q + 1], acc[4 * q + 2], acc[4 * q + 3]}; }
        }
        __syncthreads();
    }
#undef CK_LOAD
#undef CK_STORE
}

#define KSWZ(row, colB) ((row) * 256 + ((colB) ^ (((row) & 7) << 4)))
#define SBAR() __builtin_amdgcn_sched_barrier(0)
constexpr int SHM_KV = 64 * 128 * 2;
constexpr float ATT_THR = 11.5f;
__device__ __forceinline__ int v_st(int k, int c) { const int kk = (k & ~0xC) | ((k & 4) << 1) | ((k & 8) >> 1); return ((kk >> 3) * 4 + (c >> 5)) * 512 + ((kk & 7) * 32 + (c & 31)) * 2; }
__device__ __forceinline__ int v_rd_base(int lane) { return ((lane & 3) << 3) | (((lane >> 2) & 3) << 6) | (((lane >> 4) & 1) << 5) | (((lane >> 5) & 1) << 8); }
constexpr int v_rd_off(int d0, int ks, int half) { return d0 * 512 + ks * 4096 + half * 2048; }
template <int OFF> __device__ __forceinline__ s16x4 tr_read(int vb) { s16x4 r; asm volatile("ds_read_b64_tr_b16 %0, %1 offset:%2" : "=&v"(r) : "v"(vb), "i"(OFF) : "memory"); return r; }
struct VFrag { s16x4 l0, h0, l1, h1, l2, h2, l3, h3; };
template <int D0> __device__ __forceinline__ void v_reads(VFrag& f, int vb) {
    f.l0 = tr_read<v_rd_off(D0, 0, 0)>(vb); f.h0 = tr_read<v_rd_off(D0, 0, 1)>(vb); f.l1 = tr_read<v_rd_off(D0, 1, 0)>(vb); f.h1 = tr_read<v_rd_off(D0, 1, 1)>(vb);
    f.l2 = tr_read<v_rd_off(D0, 2, 0)>(vb); f.h2 = tr_read<v_rd_off(D0, 2, 1)>(vb); f.l3 = tr_read<v_rd_off(D0, 3, 0)>(vb); f.h3 = tr_read<v_rd_off(D0, 3, 1)>(vb);
}
__device__ __forceinline__ void pv_mma(f32x16& od, const VFrag& f, bf16x8 pa0, bf16x8 pa1, bf16x8 pa2, bf16x8 pa3) {
#define PKV(L, H) (bf16x8){L[0], L[1], L[2], L[3], H[0], H[1], H[2], H[3]}
    od = __builtin_amdgcn_mfma_f32_32x32x16_bf16(pa0, PKV(f.l0, f.h0), od, 0, 0, 0);
    od = __builtin_amdgcn_mfma_f32_32x32x16_bf16(pa1, PKV(f.l1, f.h1), od, 0, 0, 0);
    od = __builtin_amdgcn_mfma_f32_32x32x16_bf16(pa2, PKV(f.l2, f.h2), od, 0, 0, 0);
    od = __builtin_amdgcn_mfma_f32_32x32x16_bf16(pa3, PKV(f.l3, f.h3), od, 0, 0, 0);
#undef PKV
}
template <int KS> __device__ __forceinline__ void v_reads_ks(s16x4 (&l)[4], s16x4 (&h)[4], int vb) {
    l[0] = tr_read<v_rd_off(0, KS, 0)>(vb); h[0] = tr_read<v_rd_off(0, KS, 1)>(vb); l[1] = tr_read<v_rd_off(1, KS, 0)>(vb); h[1] = tr_read<v_rd_off(1, KS, 1)>(vb);
    l[2] = tr_read<v_rd_off(2, KS, 0)>(vb); h[2] = tr_read<v_rd_off(2, KS, 1)>(vb); l[3] = tr_read<v_rd_off(3, KS, 0)>(vb); h[3] = tr_read<v_rd_off(3, KS, 1)>(vb);
}
__device__ __forceinline__ void pv_mma_ks(f32x16 (&o)[4], const s16x4 (&l)[4], const s16x4 (&h)[4], bf16x8 pa) {
#define PKV(L, H) (bf16x8){L[0], L[1], L[2], L[3], H[0], H[1], H[2], H[3]}
    __builtin_amdgcn_s_setprio(1);
    o[0] = __builtin_amdgcn_mfma_f32_32x32x16_bf16(pa, PKV(l[0], h[0]), o[0], 0, 0, 0);
    o[1] = __builtin_amdgcn_mfma_f32_32x32x16_bf16(pa, PKV(l[1], h[1]), o[1], 0, 0, 0);
    o[2] = __builtin_amdgcn_mfma_f32_32x32x16_bf16(pa, PKV(l[2], h[2]), o[2], 0, 0, 0);
    o[3] = __builtin_amdgcn_mfma_f32_32x32x16_bf16(pa, PKV(l[3], h[3]), o[3], 0, 0, 0);
    __builtin_amdgcn_s_setprio(0);
#undef PKV
}
__device__ __forceinline__ void pv_all(f32x16 (&o)[4], int vb, bf16x8 pa0, bf16x8 pa1, bf16x8 pa2, bf16x8 pa3) {
    s16x4 l[4], h[4];
    v_reads_ks<0>(l, h, vb); asm volatile("s_waitcnt lgkmcnt(0)" ::: "memory"); SBAR(); pv_mma_ks(o, l, h, pa0);
    v_reads_ks<1>(l, h, vb); asm volatile("s_waitcnt lgkmcnt(0)" ::: "memory"); SBAR(); pv_mma_ks(o, l, h, pa1);
    v_reads_ks<2>(l, h, vb); asm volatile("s_waitcnt lgkmcnt(0)" ::: "memory"); SBAR(); pv_mma_ks(o, l, h, pa2);
    v_reads_ks<3>(l, h, vb); asm volatile("s_waitcnt lgkmcnt(0)" ::: "memory"); SBAR(); pv_mma_ks(o, l, h, pa3);
}
__device__ __forceinline__ void qk_tile(f32x16& p0, f32x16& p1, const bf16x8* qr, const char* Ks, int cb0, int r32, int hi) {
    bf16x8 kf[8];
#pragma unroll
    for (int d0 = 0; d0 < 4; ++d0) { const int cb = cb0 + (d0 * 16 + hi * 8) * 2; kf[2 * d0] = *(const bf16x8*)(Ks + KSWZ(r32, cb)); kf[2 * d0 + 1] = *(const bf16x8*)(Ks + KSWZ(32 + r32, cb)); }
    p0 = f32x16{}; p1 = f32x16{};
    __builtin_amdgcn_s_setprio(1);
#pragma unroll
    for (int d0 = 0; d0 < 4; ++d0) {
        p0 = __builtin_amdgcn_mfma_f32_32x32x16_bf16(kf[2 * d0], qr[d0], p0, 0, 0, 0);
        p1 = __builtin_amdgcn_mfma_f32_32x32x16_bf16(kf[2 * d0 + 1], qr[d0], p1, 0, 0, 0); }
    __builtin_amdgcn_s_setprio(0);
}
__device__ __forceinline__ void sm_pv(f32x16 (&o)[4], f32x16& p0, f32x16& p1, float& m_reg, float& l_reg, int vb, float* al_l, int r32, int hi) {
    float pmax;
    { float m0 = fmaxf(p0[0], p1[0]), m1 = fmaxf(p0[1], p1[1]), m2 = fmaxf(p0[2], p1[2]), m3 = fmaxf(p0[3], p1[3]);
#pragma unroll
      for (int r = 4; r < 16; r += 4) { m0 = fmaxf(fmaxf(m0, p0[r]), p1[r]); m1 = fmaxf(fmaxf(m1, p0[r + 1]), p1[r + 1]); m2 = fmaxf(fmaxf(m2, p0[r + 2]), p1[r + 2]); m3 = fmaxf(fmaxf(m3, p0[r + 3]), p1[r + 3]); }
      pmax = fmaxf(fmaxf(m0, m1), fmaxf(m2, m3)); }
    { auto rr = __builtin_amdgcn_permlane32_swap(__float_as_uint(pmax), __float_as_uint(pmax), false, false); pmax = fmaxf(__uint_as_float(rr[0]), __uint_as_float(rr[1])); }
    float alpha = 1.f;
    if (__builtin_expect(!__all((pmax - m_reg <= ATT_THR) && (l_reg > 0.f || pmax - m_reg >= -ATT_THR)), 0)) {
        const float mn = (l_reg > 0.f) ? fmaxf(m_reg, pmax) : pmax; alpha = (l_reg > 0.f) ? fexp2(m_reg - mn) : 1.f; m_reg = mn; }
    if (__builtin_expect(__all(m_reg == 0.f), 1)) {
#pragma unroll
        for (int r = 0; r < 16; ++r) { p0[r] = fexp2(p0[r]); p1[r] = fexp2(p1[r]); }
    } else {
#pragma unroll
        for (int r = 0; r < 16; ++r) { p0[r] = fexp2(p0[r] - m_reg); p1[r] = fexp2(p1[r] - m_reg); }
    }
    float ps;
    { float s0 = p0[0] + p1[0], s1 = p0[1] + p1[1], s2 = p0[2] + p1[2], s3 = p0[3] + p1[3];
#pragma unroll
      for (int r = 4; r < 16; r += 4) { s0 += p0[r] + p1[r]; s1 += p0[r + 1] + p1[r + 1]; s2 += p0[r + 2] + p1[r + 2]; s3 += p0[r + 3] + p1[r + 3]; }
      ps = (s0 + s1) + (s2 + s3); }
    { auto rr = __builtin_amdgcn_permlane32_swap(__float_as_uint(ps), __float_as_uint(ps), false, false); ps = __uint_as_float(rr[0]) + __uint_as_float(rr[1]); }
    l_reg = l_reg * alpha + ps;
    if (__any(alpha < 1.f)) { if (hi == 0) al_l[r32] = alpha; asm volatile("s_waitcnt lgkmcnt(0)" ::: "memory");
#pragma unroll
        for (int d = 0; d < 4; ++d)
#pragma unroll
            for (int r = 0; r < 16; ++r) o[d][r] *= al_l[crow(r, hi)]; }
    bf16x8 pa0, pa1, pa2, pa3;
#define PK4(P, BASE, OUT) do { unsigned a0 = cvt_pk_bf16(P[BASE + 0], P[BASE + 1]), a1 = cvt_pk_bf16(P[BASE + 2], P[BASE + 3]); \
        unsigned b0 = cvt_pk_bf16(P[BASE + 4], P[BASE + 5]), b1 = cvt_pk_bf16(P[BASE + 6], P[BASE + 7]); \
        auto r0 = __builtin_amdgcn_permlane32_swap(a0, b0, false, false); auto r1 = __builtin_amdgcn_permlane32_swap(a1, b1, false, false); \
        u32x4 w = {r0[0], r1[0], r0[1], r1[1]}; OUT = __builtin_bit_cast(bf16x8, w); } while (0)
    PK4(p0, 0, pa0); PK4(p0, 8, pa1); PK4(p1, 0, pa2); PK4(p1, 8, pa3);
#undef PK4
    pv_all(o, vb, pa0, pa1, pa2, pa3);
}
__device__ __forceinline__ void attn_unit(const Ctx& C, int l, int hd, int qrow0, int latbase, int ctxbase, int nlat, int NT, float lam, char* lds) {
    const int tid = opaque(threadIdx.x), wid = __builtin_amdgcn_readfirstlane(tid >> 6), lane = tid & 63, r32 = lane & 31, hi = lane >> 5, g = wid & 3, sj = wid >> 2;
    char* V_lds = lds; char* K_lds = lds + 2 * SHM_KV;
    float* wsf = (float*)(lds + 5 * SHM_KV) + wid * 64; float* al_l = wsf; float* li_l = wsf + 32;
    const bf16_t* Qw = C.P + (size_t)(qrow0 + g * 32 + r32) * DIN + C_AQ + hd * 128 + sj * 64 + hi * 8;
    bf16x8 qr[4];
#pragma unroll
    for (int d0 = 0; d0 < 4; ++d0) qr[d0] = *(const bf16x8*)(Qw + d0 * 16);
    const int sr = tid >> 4, sc = (tid & 15) * 8, vst0 = v_st(sr, sc), vst1 = v_st(32 + sr, sc);
    const int vb0 = (int)(uintptr_t)V_lds + v_rd_base(lane);
    const bf16_t* Kc = C.P + C_AK + hd * 128 + sc; const bf16_t* Vc = C.P + C_AV + hd * 128 + sc;
    bf16x8 vs0, vs1, ks0, ks1;
#define TROW(t) ((t) < nlat ? latbase + (t) * 64 : ctxbase + ((t) - nlat) * 64)
#define LOADK(t) do { const size_t rb_ = (size_t)TROW(t); ks0 = *(const bf16x8*)(Kc + (rb_ + sr) * DIN); ks1 = *(const bf16x8*)(Kc + (rb_ + 32 + sr) * DIN); } while (0)
#define LOADV(t) do { const size_t rb_ = (size_t)TROW(t); vs0 = *(const bf16x8*)(Vc + (rb_ + sr) * DIN); vs1 = *(const bf16x8*)(Vc + (rb_ + 32 + sr) * DIN); } while (0)
#define WRITEK(b) do { *(bf16x8*)(K_lds + (b) * SHM_KV + KSWZ(sr, sc * 2)) = ks0; *(bf16x8*)(K_lds + (b) * SHM_KV + KSWZ(32 + sr, sc * 2)) = ks1; } while (0)
#define WRITEV(b) do { *(bf16x8*)(V_lds + (b) * SHM_KV + vst0) = vs0; *(bf16x8*)(V_lds + (b) * SHM_KV + vst1) = vs1; } while (0)
    float m_reg = 0.f, l_reg = 0.f;
    f32x16 o[4] = {};
    f32x16 pA0, pA1, pB0, pB1;
    LOADK(0); LOADV(0); WRITEK(0); WRITEV(0); LOADK(1); WRITEK(1); __syncthreads();
    qk_tile(pA0, pA1, qr, K_lds, sj * 128, r32, hi);
    int kb1 = 1, kb2 = 2;
#define ATT_STEP(PC0, PC1, PN0, PN1, jj) do { \
        if ((jj) + 2 < NT) LOADK((jj) + 2); if ((jj) + 1 < NT) LOADV((jj) + 1); \
        if ((jj) + 1 < NT) qk_tile(PN0, PN1, qr, K_lds + kb1 * SHM_KV, sj * 128, r32, hi); \
        sm_pv(o, PC0, PC1, m_reg, l_reg, vb0 + ((jj) & 1) * SHM_KV, al_l, r32, hi); \
        if ((jj) + 2 < NT) WRITEK(kb2); if ((jj) + 1 < NT) WRITEV(((jj) + 1) & 1); \
        kb1 = kb2; kb2 = (kb2 == 2) ? 0 : kb2 + 1; \
        __syncthreads(); } while (0)
#pragma unroll 1
    for (int j = 0; j < NT; j += 2) {
        ATT_STEP(pA0, pA1, pB0, pB1, j);
        ATT_STEP(pB0, pB1, pA0, pA1, j + 1);
    }
#undef ATT_STEP
#undef TROW
#undef LOADK
#undef LOADV
#undef WRITEK
#undef WRITEV
    if (hi == 0) li_l[r32] = (sj ? lam : 1.f) * frcp(l_reg);
    asm volatile("s_waitcnt lgkmcnt(0)" ::: "memory");
    float* xb = (float*)lds + g * 4096 + lane;
    if (sj == 1) {
#pragma unroll
        for (int r = 0; r < 16; ++r) { const float a = li_l[crow(r, hi)];
#pragma unroll
            for (int d = 0; d < 4; ++d) xb[(d * 16 + r) * 64] = o[d][r] * a; }
    }
    __syncthreads();
    if (sj == 0) {
        const float lam1m = (l == 0) ? 0.8f : (1.f - 0.35550906759f);
        float g4[4];
#pragma unroll
        for (int d = 0; d < 4; ++d) g4[d] = C.subg[l * 128 + d * 32 + r32] * lam1m;
#pragma unroll
        for (int r = 0; r < 16; ++r) { const int rw = crow(r, hi); const float a = li_l[rw];
            float ss = 0.f; float v4[4];
#pragma unroll
            for (int d = 0; d < 4; ++d) { const float v = o[d][r] * a - xb[(d * 16 + r) * 64]; v4[d] = v; ss += v * v; }
            ss = sum32(ss);
            const float rstd = __builtin_amdgcn_rsqf(ss * (1.f / 128.f) + NORM_EPS);
            const size_t row = (size_t)(qrow0 + g * 32 + rw);
            const bf16_t* zp = C.P + row * DIN + C_AZ + hd * 128 + r32; bf16_t* op = C.H + row * DM + 512 + hd * 128 + r32;
#pragma unroll
            for (int d = 0; d < 4; ++d) { const float z = bf2f(zp[d * 32]); const float v = v4[d] * rstd * g4[d] * siluf_(z);
                op[d * 32] = (bf16_t)(cvt_pk_bf16(v, 0.f) & 0xffffu); } }
    }
    __syncthreads();
}

__device__ __forceinline__ void readout_row(const Ctx& C, int l, int lr, int lane_in) {
    const int lane = opaque(lane_in);
    constexpr size_t ARR = (size_t)MH * 256;
    const int j = 4 * lane; const size_t off = (size_t)lr * 256 + j;
    f32x4 y = *(const f32x4*)(C.YS + off) + *(const f32x4*)(C.YS + ARR + off);
    float s = (y[0] + y[1]) + (y[2] + y[3]);
    s = sum16(s);
    const float mu = s * (1.f / 64.f);
    y = y - mu;
    float q = (y[0] * y[0] + y[1] * y[1]) + (y[2] * y[2] + y[3] * y[3]);
    q = sum16(q);
    const float rstd = __builtin_amdgcn_rsqf(q * (1.f / 64.f) + GN_EPS);
    const f32x4 lg = *(const f32x4*)(C.ln_g + l * 256 + j), lb = *(const f32x4*)(C.ln_b + l * 256 + j), rk = *(const f32x4*)(C.r_k + l * 256 + j);
    const bf16_t* pr = C.P + (size_t)lr * DIN;
    const f32x4 r = ld_bf4(pr + C_R + j), v = ld_bf4(pr + C_V + j), z = ld_bf4(pr + C_ZR + j);
    const bf16_t* sb16 = (const bf16_t*)(C.SC + 2 * ARR);
    const f32x4 ks = ld_bf4(sb16 + off) + ld_bf4(sb16 + ARR + off);
    const f32x4 t = r * ks * rk;
    float bs = (t[0] + t[1]) + (t[2] + t[3]);
    bs = sum16(bs);
    f32x4 o = y * rstd * lg + lb + bs * v;
    o[0] *= siluf_(z[0]); o[1] *= siluf_(z[1]); o[2] *= siluf_(z[2]); o[3] *= siluf_(z[3]);
    st_bf4(C.H + (size_t)lr * DM + j, o);
}

#define XB_TMO      128
#define XB_XCNT(j)  (256  + 64 * (j))
#define XB_XSUB(j)  (1280 + 64 * (j))
#define XB_XGEN(j)  (2304 + 64 * (j))
#define XB_TOP      3328
#define XB_TOPGEN   3392
#define XCD_BAR_WORDS 3456
#define XB_SPIN_CAP (1u << 20)
__device__ __forceinline__ unsigned xb_ld(unsigned* p)              { return __hip_atomic_load(p, __ATOMIC_RELAXED, __HIP_MEMORY_SCOPE_AGENT); }
__device__ __forceinline__ unsigned xb_add(unsigned* p, unsigned v) { return __hip_atomic_fetch_add(p, v, __ATOMIC_RELAXED, __HIP_MEMORY_SCOPE_AGENT); }
__device__ __forceinline__ unsigned xb_xcc_id() { return (unsigned)__builtin_amdgcn_s_getreg((3 << 11) | 20) & 0xFu; }
#define XB_SPIN(cond, bar) do { unsigned _sp = 0; while (cond) { __builtin_amdgcn_s_sleep(1); \
    if ((++_sp & 255u) == 0u) { if (xb_ld(&(bar)[XB_TMO])) break; if (_sp > XB_SPIN_CAP) { atomicAdd(&(bar)[XB_TMO], 1u); break; } } } } while (0)
struct XcdBarrier { unsigned* bar; unsigned x; volatile LAS unsigned* st; };
__device__ __forceinline__ XcdBarrier xcd_barrier_post(unsigned* bar, volatile LAS unsigned* st) {
    XcdBarrier b; b.bar = bar; b.x = xb_xcc_id(); b.st = st;
    if (threadIdx.x == 0) (void)xb_add(&bar[XB_XCNT(b.x)], 1u);
    return b;
}
__device__ __forceinline__ void xcd_barrier_complete(unsigned* bar, unsigned x, unsigned& nloc, unsigned& nx) {
    const unsigned G = gridDim.x * gridDim.y * gridDim.z;
    unsigned sum, cnt, mine, sp = 0u;
    for (;;) {
        sum = 0u; cnt = 0u; mine = 0u;
#pragma unroll
        for (unsigned j = 0; j < 16; ++j) { const unsigned c = xb_ld(&bar[XB_XCNT(j)]); sum += c; cnt += (c > 0u) ? 1u : 0u; mine = (j == x) ? c : mine; }
        if (sum == G) break;
        __builtin_amdgcn_s_sleep(1);
        if ((++sp & 255u) == 0u) { if (xb_ld(&bar[XB_TMO])) break; if (sp > XB_SPIN_CAP) { atomicAdd(&bar[XB_TMO], 1u); break; } }
    }
    nloc = mine > 0u ? mine : 1u; nx = cnt > 0u ? cnt : 1u;
}
__device__ __forceinline__ void xcd_barrier(const XcdBarrier& b) {
    asm volatile("s_waitcnt vmcnt(0)" ::: "memory");
    __syncthreads();
    if (threadIdx.x == 0) {
        unsigned* bar = b.bar;
        __builtin_amdgcn_s_waitcnt(0);
        unsigned nloc = b.st[0], nx = b.st[1];
        if (nloc == 0u) { xcd_barrier_complete(bar, b.x, nloc, nx); b.st[0] = nloc; b.st[1] = nx; }
        const unsigned old = xb_add(&bar[XB_XSUB(b.x)], 1u);
        const unsigned gen = old / nloc;
        if (old + 1u == (gen + 1u) * nloc) {
            __builtin_amdgcn_fence(__ATOMIC_RELEASE, "agent");
            asm volatile("s_waitcnt vmcnt(0)" ::: "memory");
            const unsigned og = xb_add(&bar[XB_TOP], 1u);
            const unsigned tg = og / nx;
            if (og + 1u == (tg + 1u) * nx) xb_add(&bar[XB_TOPGEN], 1u);
            else XB_SPIN(xb_ld(&bar[XB_TOPGEN]) == tg, bar);
            __builtin_amdgcn_fence(__ATOMIC_ACQUIRE, "agent");
            xb_add(&bar[XB_XGEN(b.x)], 1u);
            asm volatile("s_waitcnt vmcnt(0)" ::: "memory");
        } else {
            XB_SPIN(xb_ld(&bar[XB_XGEN(b.x)]) == gen, bar);
            __builtin_amdgcn_fence(__ATOMIC_ACQUIRE, "agent");
            asm volatile("s_waitcnt vmcnt(0)" ::: "memory");
        }
    }
    __syncthreads();
}

#ifndef REP_ATT
#define REP_ATT 1
#endif
#ifndef REP_SCAN
#define REP_SCAN 1
#endif
#ifndef REP_G1
#define REP_G1 1
#endif
#ifndef REP_P3
#define REP_P3 1
#endif
#ifndef REP_RD
#define REP_RD 1
#endif
#ifndef REP_G0
#define REP_G0 1
#endif
#ifndef REP_P1
#define REP_P1 1
#endif
#ifndef REP_SYNC
#define REP_SYNC 1
#endif
#ifndef REP_G2
#define REP_G2 1
#endif
#ifndef REP_FIN
#define REP_FIN 1
#endif
struct Args { const float* in[22]; float* out; unsigned char* ws; };
__global__ void __launch_bounds__(512, 2) mk_fwd(Args a) {
    extern __shared__ __attribute__((aligned(16))) unsigned char lds_raw[];
    cg::grid_group grid = cg::this_grid();
    LAS unsigned char* lds = (LAS unsigned char*)lds_raw;
    Ctx C;
    C.x = a.in[0]; C.c = a.in[1]; C.ctx = a.in[2]; C.c_ctx = a.in[3]; C.mod_w = a.in[4]; C.mod_b = a.in[5]; C.pre_g = a.in[6]; C.post_g = a.in[7]; C.w_in = a.in[8]; C.w_out = a.in[9];
    C.w0 = a.in[10]; C.w_up = a.in[11]; C.a0 = a.in[12]; C.a_up = a.in[13]; C.k_k = a.in[14]; C.k_a = a.in[15]; C.r_k = a.in[16]; C.ln_g = a.in[17]; C.ln_b = a.in[18]; C.conv_w = a.in[19];
    C.dlam = a.in[20]; C.subg = a.in[21]; C.out = a.out;
    unsigned char* ws = a.ws;
    C.WinT = (bf16_t*)(ws + WS_WIN); C.WoutT = (bf16_t*)(ws + WS_WOUT); C.WupT = (bf16_t*)(ws + WS_WUP); C.mod = (float*)(ws + WS_MOD); C.rope = (float*)(ws + WS_ROPE);
    C.xc1 = (float*)(ws + WS_XC1); C.H = (bf16_t*)(ws + WS_H); C.P = (bf16_t*)(ws + WS_P); C.Y = (bf16_t*)(ws + WS_P); C.SC = (float*)(ws + WS_SC); C.YS = (float*)(ws + WS_YS);
    const int tid = threadIdx.x, wid = __builtin_amdgcn_readfirstlane(tid >> 6), G = gridDim.x, bx = blockIdx.x;
#define lane (opaque(tid) & 63)
    const int gw0 = bx * 8 + wid, ngw = G * 8;
#define gw opaque_s(gw0)

    if (bx == 0) for (int i = tid; i < 4096; i += 512) ((unsigned*)ws)[i] = 0u;
    if (tid < 2) ((volatile LAS unsigned*)(lds + 131072 + 1024))[tid] = 0u;
    __syncthreads();
#ifdef PROBE_A
    unsigned long long tprev = __builtin_amdgcn_s_memrealtime(); float tacc[9] = {0.f, 0.f, 0.f, 0.f, 0.f, 0.f, 0.f, 0.f, 0.f};
#define STAMP(k) do { const unsigned long long tn_ = __builtin_amdgcn_s_memrealtime(); tacc[k] += (float)(tn_ - tprev) * 0.01f; tprev = tn_; } while (0)
#else
#define STAMP(k) do { } while (0)
#endif
#ifndef NO_G0
    for (int rep = 0; rep < REP_G0; ++rep) g0_prologue(C, lds);
#endif
    grid.sync(); STAMP(0);
    const XcdBarrier xbar = xcd_barrier_post((unsigned*)ws, (volatile LAS unsigned*)(lds + 131072 + 1024));
#define GSYNC() xcd_barrier(xbar)
#pragma unroll 1
    for (int hf = 0; hf < 2; ++hf) {
#pragma unroll 1
        for (int l = 0; l < 2; ++l) {
#ifndef NO_NORM
            for (int rep = 0; rep < REP_P1; ++rep) { if (l == 0) norm_phase<0>(C, hf, gw, ngw, lane); else norm_phase<1>(C, hf, gw, ngw, lane); }
#endif
            for (int rep = 0; rep < REP_SYNC; ++rep) GSYNC();
            STAMP(1);
            { pg8::Gemm g{C.H, C.WinT + (size_t)l * DIN * DM, MH, DIN, DM}; pg8::StaticOrder S; S.init(MH, DIN, G, bx);
#ifndef NO_GEMM1
              pg8::EpiBf16 E{C.P, DIN}; for (int rep = 0; rep < REP_G1; ++rep) pg8::gemm_phase<pg8::EpiBf16, true>(lds, g, S, E);
#endif
            }
            GSYNC(); STAMP(2);
#ifndef NO_PREP
            for (int rep = 0; rep < REP_P3; ++rep) for (int t = bx; t < MH / 64; t += G) prep_block(C, l, t, lds);
#endif
            for (int r4 = gw; r4 < MH / 4; r4 += ngw) { const bool do_conv = (l == 0) || (r4 < LATH / 4); if (do_conv || r4 < LATH / 4) rowpass4(C, l, r4 * 4, lane, do_conv); }
            GSYNC(); STAMP(3);
#ifndef NO_SCAN
            for (int rep = 0; rep < REP_SCAN; ++rep) { if (G == 256) { if (((bx >> 3) & 1) == 0) scan_chunked(C, l, (bx >> 4) * 8 + (bx & 7), lds); } else { for (int u = bx; u < 128; u += G) scan_chunked(C, l, u, lds); } }
#endif
            STAMP(4);
#ifndef NO_ATT
            {
                float lam;
                { const int ln = opaque(lane); const float* dl = C.dlam + l * 256; const float sa = wave_sum_dpp(dl[ln] * dl[64 + ln]), sb = wave_sum_dpp(dl[128 + ln] * dl[192 + ln]);
                  lam = fexp2(1.4426950408889634f * sa) - fexp2(1.4426950408889634f * sb) + ((l == 0) ? 0.2f : 0.35550906759f); }
                unsigned* qctr = (unsigned*)ws + 3584 + (hf * 2 + l) * 64;
                volatile LAS unsigned* qslot = (volatile LAS unsigned*)(lds + 131072 + 1024 + 64);
                const int nunits = (l == 0) ? 1024 + 128 : 1024;
                for (;;) {
                    if (tid == 0) qslot[0] = __hip_atomic_fetch_add(qctr, 1u, __ATOMIC_RELAXED, __HIP_MEMORY_SCOPE_AGENT);
                    __syncthreads();
                    const int u = (int)qslot[0];
                    __syncthreads();
                    if (u >= nunits) break;
                    if (u < 1024) { const int bl = u >> 6, hd = (u >> 4) & 3, qb = u & 15;
                        attn_unit(C, l, hd, bl * SEQ + qb * 128, bl * SEQ, LATH + bl * CTX, 32, 36, lam, (char*)lds_raw); }
                    else { const int v = u - 1024; const int bl = v >> 3, hd = (v >> 1) & 3, qb = v & 1;
                        attn_unit(C, l, hd, LATH + bl * CTX + qb * 128, 0, LATH + bl * CTX, 0, 4, lam, (char*)lds_raw); }
                }
            }
#endif
            GSYNC(); STAMP(5);
            { const int nrows = (l == 0) ? MH : LATH; for (int rep = 0; rep < REP_RD; ++rep) for (int r = gw * 2; r < nrows; r += ngw * 2) { readout_row(C, l, r, lane); readout_row(C, l, r + 1, lane); } }
            GSYNC(); STAMP(6);
            { const int M5 = (l == 0) ? MH : LATH; pg8::Gemm g{C.H, C.WoutT + (size_t)l * DM * DM, M5, DM, DM}; pg8::StaticOrder S; S.init(M5, DM, G, bx);
#ifndef NO_GEMM2
              pg8::EpiBf16 E{C.Y, DM}; for (int rep = 0; rep < REP_G2; ++rep) pg8::gemm_phase<pg8::EpiBf16, true>(lds, g, S, E);
#endif
            }
            GSYNC(); STAMP(7);
        }
#ifdef PROBE_A
        norm_phase<2>(C, hf, gw, ngw, lane, 2e-3f * tacc[PROBE_A], 1e-3f * tacc[PROBE_B]); STAMP(8);
#else
        norm_phase<2>(C, hf, gw, ngw, lane);
#endif
    }
#undef gw
#undef lane
}

extern "C" void kernel_launch(void* const* d_in, const int* in_sizes, int n_in, void* d_out, int out_size, void* d_ws, size_t ws_size, hipStream_t stream) {
    static int grid = 0;
    if (grid == 0) {
        if (n_in != 22 || ws_size < WS_END) { fprintf(stderr, "kernel_launch: unexpected n_in %d / ws %zu\n", n_in, ws_size); grid = -1; return; }
        int dev = 0, cus = 0, per_cu = 0;
        hipGetDevice(&dev); hipDeviceGetAttribute(&cus, hipDeviceAttributeMultiprocessorCount, dev);
        if (hipFuncSetAttribute((const void*)mk_fwd, hipFuncAttributeMaxDynamicSharedMemorySize, LDS_BYTES) != hipSuccess) { fprintf(stderr, "kernel_launch: hipFuncSetAttribute failed\n"); grid = -1; return; }
        if (hipOccupancyMaxActiveBlocksPerMultiprocessor(&per_cu, (const void*)mk_fwd, 512, LDS_BYTES) != hipSuccess || per_cu < 1) { fprintf(stderr, "kernel_launch: occupancy query says %d\n", per_cu); per_cu = 1; }
        (void)hipGetLastError();
        grid = cus * 1;
    }
    if (grid < 0) return;
    Args a{};
    for (int i = 0; i < 22; ++i) a.in[i] = (const float*)d_in[i];
    a.out = (float*)d_out; a.ws = (unsigned char*)d_ws;
    void* args[] = {&a};
    hipError_t e = hipLaunchCooperativeKernel((const void*)mk_fwd, dim3(grid), dim3(512), args, LDS_BYTES, stream);
    if (e != hipSuccess) fprintf(stderr, "cooperative launch failed: %s (grid %d)\n", hipGetErrorString(e), grid);
}
```

```cpp
#include <hip/hip_runtime.h>
#include <hip/hip_cooperative_groups.h>
#include <cstdio>
#include <cstdint>
namespace cg = cooperative_groups;

#define LAS __attribute__((address_space(3)))
typedef unsigned short bf16_t;
typedef short bf16x8 __attribute__((ext_vector_type(8)));
typedef short s16x4 __attribute__((ext_vector_type(4)));
typedef float f32x2 __attribute__((ext_vector_type(2)));
typedef float f32x4 __attribute__((ext_vector_type(4)));
typedef float f32x16 __attribute__((ext_vector_type(16)));
typedef unsigned u32x2 __attribute__((ext_vector_type(2)));
typedef unsigned u32x4 __attribute__((ext_vector_type(4)));

constexpr int DM = 1024, SEQ = 2048, CTX = 256, DIN = 4352;
constexpr int HB = 16;
constexpr int LATH = HB * SEQ;
constexpr int CTXH = HB * CTX;
constexpr int MH = LATH + CTXH;
constexpr int C_R = 0, C_K = 256, C_V = 512, C_LWF = 768, C_LWB = 832, C_LAF = 896, C_LAB = 960, C_ZR = 1024,
              C_CB = 1280, C_CC = 1536, C_CH = 1792, C_CZ = 2048, C_AQ = 2304, C_AK = 2816, C_AV = 3328, C_AZ = 3840;
constexpr float C2 = 0.125f * 1.4426950408889634f;
constexpr float NORM_EPS = 1e-6f, GN_EPS = 64e-5f;

constexpr size_t MiB = 1u << 20;
constexpr size_t WS_WIN = 1 * MiB, WS_WOUT = 18 * MiB, WS_WUP = 22 * MiB, WS_MOD = 23 * MiB, WS_ROPE = 24 * MiB, WS_XC1 = 25 * MiB,
                 WS_H = 57 * MiB, WS_P = 129 * MiB, WS_SC = 435 * MiB, WS_YS = 687 * MiB, WS_END = 759 * MiB;
static_assert(WS_WIN + 2ull * DIN * DM * 2 <= WS_WOUT && WS_H + (size_t)MH * DM * 2 <= WS_P && WS_P + (size_t)MH * DIN * 2 <= WS_SC &&
              WS_SC + 7ull * MH * 256 * 4 <= WS_YS && WS_YS + 2ull * MH * 256 * 4 <= WS_END, "ws map");
constexpr int LDS_BYTES = 131072 + 2048;

struct Ctx {
    const float *x, *c, *ctx, *c_ctx, *mod_w, *mod_b, *pre_g, *post_g, *w_in, *w_out, *w0, *w_up, *a0, *a_up, *k_k, *k_a, *r_k, *ln_g, *ln_b, *conv_w, *dlam, *subg;
    float* out;
    bf16_t *WinT, *WoutT, *WupT; float *mod, *rope, *xc1; bf16_t *H, *P, *Y; float *SC, *YS;
};

__device__ __forceinline__ unsigned cvt_pk_bf16(float lo, float hi) { unsigned r; asm volatile("v_cvt_pk_bf16_f32 %0, %1, %2" : "=v"(r) : "v"(lo), "v"(hi)); return r; }
__device__ __forceinline__ float bf_lo(unsigned w) { return __uint_as_float(w << 16); }
__device__ __forceinline__ float bf_hi(unsigned w) { return __uint_as_float(w & 0xffff0000u); }
__device__ __forceinline__ float bf2f(bf16_t b) { return __uint_as_float((unsigned)b << 16); }
__device__ __forceinline__ f32x4 ld_bf4(const bf16_t* p) { const u32x2 w = *(const u32x2*)p; return (f32x4){bf_lo(w.x), bf_hi(w.x), bf_lo(w.y), bf_hi(w.y)}; }
__device__ __forceinline__ void st_bf4(bf16_t* p, f32x4 v) { u32x2 w; w.x = cvt_pk_bf16(v[0], v[1]); w.y = cvt_pk_bf16(v[2], v[3]); *(u32x2*)p = w; }
__device__ __forceinline__ int opaque(int v) { asm volatile("" : "+v"(v)); return v; }
__device__ __forceinline__ int opaque_s(int v) { asm volatile("" : "+s"(v)); return v; }
__device__ __forceinline__ float fexp2(float x) { return __builtin_amdgcn_exp2f(x); }
__device__ __forceinline__ float frcp(float x) { return __builtin_amdgcn_rcpf(x); }
__device__ __forceinline__ float sigmoidf_(float x) { return frcp(1.f + fexp2(-1.4426950408889634f * x)); }
__device__ __forceinline__ float siluf_(float x) { return x * sigmoidf_(x); }
__device__ __forceinline__ float sum16(float v) {
    v += __int_as_float(__builtin_amdgcn_update_dpp(0, __float_as_int(v), 0xB1, 0xF, 0xF, true));
    v += __int_as_float(__builtin_amdgcn_update_dpp(0, __float_as_int(v), 0x4E, 0xF, 0xF, true));
    v += __int_as_float(__builtin_amdgcn_update_dpp(0, __float_as_int(v), 0x141, 0xF, 0xF, true));
    v += __int_as_float(__builtin_amdgcn_update_dpp(0, __float_as_int(v), 0x140, 0xF, 0xF, true));
    return v;
}
__device__ __forceinline__ float wave_sum(float v) {
    const int ri = __float_as_int(sum16(v));
    return (__int_as_float(__builtin_amdgcn_readlane(ri, 0)) + __int_as_float(__builtin_amdgcn_readlane(ri, 16))) + (__int_as_float(__builtin_amdgcn_readlane(ri, 32)) + __int_as_float(__builtin_amdgcn_readlane(ri, 48)));
}
__device__ __forceinline__ float wave_sum_dpp(float v) {
    const int ri = __float_as_int(sum16(v));
    return (__int_as_float(__builtin_amdgcn_readlane(ri, 0)) + __int_as_float(__builtin_amdgcn_readlane(ri, 16))) + (__int_as_float(__builtin_amdgcn_readlane(ri, 32)) + __int_as_float(__builtin_amdgcn_readlane(ri, 48)));
}
__device__ __forceinline__ float sum32(float v) {
    const float r = sum16(v);
    return r + __int_as_float(__builtin_amdgcn_ds_swizzle(__float_as_int(r), 0x401f));
}

namespace pg8 {
constexpr int BM = 256, BK = 64, HALF = 128, HTB = HALF * BK * 2, STAGE_BYTES = 8 * HTB, NXCD = 8, WGM = 8;
__host__ __device__ __forceinline__ int lds_byte(int r, int c) { const int st = (r >> 4) * 2 + (c >> 5), rr = r & 15, cc = c & 31, ob = rr * 64 + cc * 2; return st * 1024 + (ob ^ (((ob >> 9) & 1) << 5)); }
__host__ __device__ __forceinline__ void stage_rc(int b, int& R, int& C) { const int st = b / 1024, sb = b % 1024, swz = sb ^ (((sb >> 9) & 1) << 5); R = (st >> 1) * 16 + swz / 64; C = (st & 1) * 32 + (swz % 64) / 2; }
__host__ __device__ __forceinline__ int perm32(int rho) { const int n = rho >> 4, i = rho & 15; return 8 * (i >> 2) + 4 * n + (i & 3); }
struct Unit { int pm, pn; };
struct Gemm { const bf16_t* A; const bf16_t* Bt; int M, N, K; };
struct StaticOrder {
    int nM, nN, nwg, G, c;
    __host__ __device__ void init(int M, int N, int G_, int c_) { nM = M / BM; nN = N / BM; nwg = nM * nN; G = G_; c = c_; }
    __host__ __device__ bool next(int i, Unit& u) const {
        const long L = (long)i * G + c; if (L >= nwg) return false;
        int wgid = (int)L; { const int q = nwg / NXCD, r = nwg % NXCD, xcd = wgid % NXCD, off = wgid / NXCD; wgid = (xcd < r ? xcd * (q + 1) : r * (q + 1) + (xcd - r) * q) + off; }
        const int nig = WGM * nN, gid = wgid / nig, fm = gid * WGM, gsz = (nM - fm) < WGM ? (nM - fm) : WGM;
        u.pm = fm + ((wgid % nig) % gsz); u.pn = (wgid % nig) / gsz; return true;
    }
};
struct EpiBf16 {
    static constexpr bool PERM = true;
    bf16_t* O; int ldc;
    __device__ __forceinline__ void operator()(const f32x4 (&acc)[2][2][4][2], const Unit& u, int wr, int wc, int fr, int fq) const {
        const int row0 = u.pm * BM + wr * 64 + fr, col0 = u.pn * BM + wc * 32 + 8 * fq;
        int ld = ldc; asm volatile("" : "+s"(ld));
#pragma unroll
        for (int ai = 0; ai < 2; ++ai)
#pragma unroll
            for (int m = 0; m < 4; ++m) { bf16_t* rowp = O + (size_t)(row0 + ai * HALF + m * 16) * ld + col0;
#pragma unroll
                for (int bj = 0; bj < 2; ++bj) { const f32x4 v0 = acc[ai][bj][m][0], v1 = acc[ai][bj][m][1];
                    u32x4 w; w.x = cvt_pk_bf16(v0[0], v0[1]); w.y = cvt_pk_bf16(v0[2], v0[3]); w.z = cvt_pk_bf16(v1[0], v1[1]); w.w = cvt_pk_bf16(v1[2], v1[3]);
                    *(u32x4*)(rowp + bj * HALF) = w; } }
    }
};
template <class Epi, bool ALIGN_EPI = true>
__device__ __forceinline__ void gemm_phase(LAS unsigned char* lds, const Gemm g, const StaticOrder& S, const Epi& E) {
    const int tid = opaque(threadIdx.x), wid = __builtin_amdgcn_readfirstlane(tid >> 6), lane = tid & 63, wr = wid >> 2, wc = wid & 3, fr = lane & 15, fq = lane >> 4;
    const int K = g.K, nt = K / BK;
    unsigned voffA[2], voffB[2];
#pragma unroll
    for (int i = 0; i < 2; ++i) { int R, C; stage_rc(tid * 16 + i * 8192, R, C); const int Rb = Epi::PERM ? ((R & ~31) + perm32(R & 31)) : R;
        voffA[i] = (unsigned)(R * K + C) * 2u; voffB[i] = (unsigned)(Rb * K + C) * 2u; }
    const size_t kstep = (size_t)(BK * 2);
    const size_t hstep = (size_t)HALF * K * 2;
    const size_t tstep = 2 * hstep;
    const unsigned ldsw = (unsigned)wid * 1024u;
    const int aoff = lds_byte(wr * 64 + fr, fq * 8), boff = lds_byte(wc * 32 + fr, fq * 8);
#define PG8_SA(b, h) (((b) * 2 + (h)) * HTB)
#define PG8_SB(b, h) ((4 + (b) * 2 + (h)) * HTB)
#define PG8_STAGE(bufoff, gbase, voff) do { _Pragma("unroll") for (int _i = 0; _i < 2; ++_i) \
        __builtin_amdgcn_global_load_lds((const unsigned*)((const char*)(gbase) + (voff)[_i]), (LAS unsigned*)(lds + (bufoff) + ldsw + _i * 8192), 16, 0, 0); } while (0)
#define PG8_LDA(dst, b, h) do { _Pragma("unroll") for (int m = 0; m < 4; ++m) _Pragma("unroll") for (int k = 0; k < 2; ++k) dst[m][k] = *(const LAS bf16x8*)(lds + PG8_SA(b, h) + aoff + m * 2048 + k * 1024); } while (0)
#define PG8_LDB(dst, b, h) do { _Pragma("unroll") for (int n = 0; n < 2; ++n) _Pragma("unroll") for (int k = 0; k < 2; ++k) dst[n][k] = *(const LAS bf16x8*)(lds + PG8_SB(b, h) + boff + n * 2048 + k * 1024); } while (0)
#define PG8_MMA(ai, bj, At, Bt) do { __builtin_amdgcn_s_setprio(1); _Pragma("unroll") for (int m = 0; m < 4; ++m) _Pragma("unroll") for (int n = 0; n < 2; ++n) _Pragma("unroll") for (int k = 0; k < 2; ++k) \
        acc[ai][bj][m][n] = __builtin_amdgcn_mfma_f32_16x16x32_bf16(Bt[n][k], At[m][k], acc[ai][bj][m][n], 0, 0, 0); __builtin_amdgcn_s_setprio(0); } while (0)
#define PG8_WAIT_V(n) asm volatile("s_waitcnt vmcnt(" #n ")" ::: "memory")
#define PG8_WAIT_L(n) asm volatile("s_waitcnt lgkmcnt(" #n ")" ::: "memory")
#define PG8_BAR __builtin_amdgcn_s_barrier()
#define PG8_SCHED __builtin_amdgcn_sched_barrier(0)
    Unit cur, nxt; int ui = 0;
    if (!S.next(0, cur)) return;
    f32x4 acc[2][2][4][2];
#pragma unroll
    for (int a = 0; a < 2; ++a)
#pragma unroll
        for (int b = 0; b < 2; ++b)
#pragma unroll
            for (int m = 0; m < 4; ++m)
#pragma unroll
                for (int n = 0; n < 2; ++n) acc[a][b][m][n] = (f32x4){0.f, 0.f, 0.f, 0.f};
    bf16x8 At[4][2], B0[2][2], B1[2][2];
    const char* cA = (const char*)g.A + (size_t)cur.pm * tstep; const char* cB = (const char*)g.Bt + (size_t)cur.pn * tstep;
    PG8_STAGE(PG8_SB(0, 0), cB, voffB); PG8_STAGE(PG8_SB(0, 1), cB + hstep, voffB); PG8_STAGE(PG8_SA(0, 0), cA, voffA); PG8_STAGE(PG8_SA(0, 1), cA + hstep, voffA);
    if (wr == 1) PG8_BAR;
    PG8_WAIT_V(2); PG8_BAR;
    PG8_STAGE(PG8_SB(1, 0), cB + kstep, voffB); PG8_STAGE(PG8_SA(1, 0), cA + kstep, voffA); PG8_STAGE(PG8_SB(1, 1), cB + hstep + kstep, voffB);
    PG8_WAIT_V(6); PG8_BAR;
    for (;;) {
        const bool has_next = S.next(ui + 1, nxt);
        const char* nA = has_next ? (const char*)g.A + (size_t)nxt.pm * tstep : cA; const char* nB = has_next ? (const char*)g.Bt + (size_t)nxt.pn * tstep : cB;
        for (int t = 0; t < nt; t += 2) {
            const bool last = (t == nt - 2);
            const char* a1 = cA + (size_t)(t + 1) * kstep;
            const char* a2 = last ? nA : cA + (size_t)(t + 2) * kstep; const char* b2 = last ? nB : cB + (size_t)(t + 2) * kstep;
            const char* a3 = a2 + kstep; const char* b3 = b2 + kstep;
            PG8_LDB(B0, 0, 0); PG8_LDB(B1, 0, 1); PG8_SCHED; PG8_LDA(At, 0, 0); PG8_STAGE(PG8_SA(1, 1), a1 + hstep, voffA);
            PG8_WAIT_V(8); PG8_WAIT_L(0); PG8_BAR; PG8_MMA(0, 0, At, B0); PG8_MMA(0, 1, At, B1); PG8_BAR; PG8_SCHED;
            PG8_LDA(At, 0, 1); PG8_STAGE(PG8_SB(0, 0), b2, voffB); PG8_STAGE(PG8_SB(0, 1), b2 + hstep, voffB); PG8_STAGE(PG8_SA(0, 0), a2, voffA);
            PG8_WAIT_V(8); PG8_WAIT_L(0); PG8_BAR; PG8_MMA(1, 0, At, B0); PG8_MMA(1, 1, At, B1); PG8_BAR; PG8_SCHED;
            PG8_LDB(B0, 1, 0); PG8_LDB(B1, 1, 1); PG8_SCHED; PG8_LDA(At, 1, 0); PG8_STAGE(PG8_SA(0, 1), a2 + hstep, voffA);
            PG8_WAIT_V(8); PG8_WAIT_L(0); PG8_BAR; PG8_MMA(0, 0, At, B0); PG8_MMA(0, 1, At, B1); PG8_BAR; PG8_SCHED;
            PG8_LDA(At, 1, 1); PG8_STAGE(PG8_SB(1, 0), b3, voffB); PG8_STAGE(PG8_SB(1, 1), b3 + hstep, voffB); PG8_STAGE(PG8_SA(1, 0), a3, voffA);
            PG8_WAIT_V(8); PG8_WAIT_L(0); PG8_BAR; PG8_MMA(1, 0, At, B0); PG8_MMA(1, 1, At, B1); PG8_BAR; PG8_SCHED;
        }
        if constexpr (ALIGN_EPI) { if (wr == 0) PG8_BAR; }
        E(acc, cur, wr, wc, fr, fq);
        if (!has_next) break;
#pragma unroll
        for (int a = 0; a < 2; ++a)
#pragma unroll
            for (int b = 0; b < 2; ++b)
#pragma unroll
                for (int m = 0; m < 4; ++m)
#pragma unroll
                    for (int n = 0; n < 2; ++n) acc[a][b][m][n] = (f32x4){0.f, 0.f, 0.f, 0.f};
        cur = nxt; cA = nA; cB = nB; ++ui;
        if constexpr (ALIGN_EPI) { if (wr == 1) PG8_BAR; }
    }
    PG8_WAIT_V(0);
    if constexpr (!ALIGN_EPI) { if (wr == 0) PG8_BAR; }
    PG8_BAR;
#undef PG8_SA
#undef PG8_SB
#undef PG8_STAGE
#undef PG8_LDA
#undef PG8_LDB
#undef PG8_MMA
#undef PG8_WAIT_V
#undef PG8_WAIT_L
#undef PG8_BAR
#undef PG8_SCHED
}
}

__device__ __forceinline__ void transpose_item(const float* W, int K, int N, bf16_t* WT, LAS float* scr, int item, int lane, bool qscale) {
    const int nblk = N / 32, kb = item / nblk, nb = item % nblk, k0 = 64 * kb, n0 = 32 * nb;
    const float wsc = (qscale && n0 >= C_AQ && n0 < C_AK) ? C2 : 1.f;
#pragma unroll 8
    for (int i = 0; i < 32; ++i) { const int kk = 2 * i + (lane >> 5); scr[kk * 33 + (lane & 31)] = wsc * W[(size_t)(k0 + kk) * N + n0 + (lane & 31)]; }
    asm volatile("s_waitcnt lgkmcnt(0)" ::: "memory");
    const int c = lane & 7;
#pragma unroll
    for (int j = 0; j < 4; ++j) { const int n = (lane >> 3) + 8 * j; const LAS float* s = scr + (8 * c) * 33 + n;
        u32x4 o; o.x = cvt_pk_bf16(s[0 * 33], s[1 * 33]); o.y = cvt_pk_bf16(s[2 * 33], s[3 * 33]); o.z = cvt_pk_bf16(s[4 * 33], s[5 * 33]); o.w = cvt_pk_bf16(s[6 * 33], s[7 * 33]);
        *(u32x4*)(WT + (size_t)(n0 + n) * K + k0 + 8 * c) = o; }
    asm volatile("s_waitcnt lgkmcnt(0)" ::: "memory");
}
__device__ __forceinline__ void sincos_d(double x, float& s, float& c) {
    const double q = __builtin_rint(x * 0.63661977236758134308); const double r = x - q * 1.57079632679489661923; const int qi = (int)q & 3;
    const double r2 = r * r;
    const double sp = r * (1.0 + r2 * (-1.0 / 6 + r2 * (1.0 / 120 + r2 * (-1.0 / 5040 + r2 * (1.0 / 362880 + r2 * (-1.0 / 39916800 + r2 * (1.0 / 6227020800.0)))))));
    const double cp = 1.0 + r2 * (-0.5 + r2 * (1.0 / 24 + r2 * (-1.0 / 720 + r2 * (1.0 / 40320 + r2 * (-1.0 / 3628800 + r2 * (1.0 / 479001600.0))))));
    const double ss = (qi == 0) ? sp : (qi == 1) ? cp : (qi == 2) ? -sp : -cp;
    const double cc = (qi == 0) ? cp : (qi == 1) ? -sp : (qi == 2) ? -cp : sp;
    s = (float)ss; c = (float)cc;
}
__device__ __forceinline__ void g0_prologue(const Ctx& C, LAS unsigned char* lds) {
    const int tid = opaque(threadIdx.x), lane = tid & 63, wid = tid >> 6, G = gridDim.x, bx = blockIdx.x;
    if (bx == G - 1) {
        for (int e = tid; e < 1024; e += 512) { const int pos = e >> 4, i = e & 15;
            const float invf = fexp2(-(float)i * 0.83048202372f);
            const float ang = (float)pos * invf; float s, c; sincos_d((double)ang, s, c);
            C.rope[e * 2] = c; C.rope[e * 2 + 1] = s; }
    }
    constexpr int NMODT = 2 * 48;
    const int nmodb = (G >= 2 * NMODT) ? NMODT : G;
    if (bx < nmodb) {
        LAS float* sl = (LAS float*)lds + wid * (33 * 64);
        for (int task = bx; task < NMODT; task += nmodb) {
            const int l = task / 48, cb = task % 48, col = cb * 64 + lane;
            const float* W = C.mod_w + (size_t)l * DM * 3072;
            float acc[33];
#pragma unroll
            for (int r = 0; r < 33; ++r) acc[r] = 0.f;
            for (int kc = 0; kc < 2; ++kc) {
                const int k0 = wid * 128 + kc * 64;
#pragma unroll
                for (int r = 0; r < 33; ++r) { const float v = (r < 32) ? C.c[r * DM + k0 + lane] : C.c_ctx[k0 + lane]; sl[r * 64 + lane] = siluf_(v); }
                asm volatile("s_waitcnt lgkmcnt(0)" ::: "memory");
                for (int k4 = 0; k4 < 16; ++k4) {
                    const float w0 = W[(size_t)(k0 + 4 * k4 + 0) * 3072 + col], w1 = W[(size_t)(k0 + 4 * k4 + 1) * 3072 + col],
                                w2 = W[(size_t)(k0 + 4 * k4 + 2) * 3072 + col], w3 = W[(size_t)(k0 + 4 * k4 + 3) * 3072 + col];
#pragma unroll
                    for (int r = 0; r < 33; ++r) { const f32x4 sv = *(const LAS f32x4*)(sl + r * 64 + 4 * k4); acc[r] += sv[0] * w0 + sv[1] * w1 + sv[2] * w2 + sv[3] * w3; }
                }
                asm volatile("s_waitcnt lgkmcnt(0)" ::: "memory");
            }
            __syncthreads();
#pragma unroll
            for (int r = 0; r < 33; ++r) sl[r * 64 + lane] = acc[r];
            __syncthreads();
            for (int e = tid; e < 33 * 64; e += 512) { float s = 0.f;
#pragma unroll
                for (int w = 0; w < 8; ++w) s += ((LAS float*)lds)[w * (33 * 64) + e];
                const int r = e >> 6, cc = cb * 64 + (e & 63);
                C.mod[((size_t)l * 33 + r) * 3072 + cc] = s + C.mod_b[l * 3072 + cc]; }
            __syncthreads();
        }
    }
    {
        const bool all = (nmodb == G);
        if (all || bx >= nmodb) {
            const int nb = all ? G : G - nmodb, b0 = all ? bx : bx - nmodb;
            LAS float* scr = (LAS float*)lds + wid * (64 * 33 + 16);
            constexpr int I_IN = 16 * (DIN / 32), I_OUT = 16 * 32, I_UP = 8;
            constexpr int NITEMS = 2 * I_IN + 2 * I_OUT + 16 * I_UP;
            for (int it = b0 * 8 + wid; it < NITEMS; it += nb * 8) {
                int r = it;
                if (r < 2 * I_IN) { const int l = r / I_IN; transpose_item(C.w_in + (size_t)l * DM * DIN, DM, DIN, C.WinT + (size_t)l * DIN * DM, scr, r % I_IN, lane, true); continue; } r -= 2 * I_IN;
                if (r < 2 * I_OUT) { const int l = r / I_OUT; transpose_item(C.w_out + (size_t)l * DM * DM, DM, DM, C.WoutT + (size_t)l * DM * DM, scr, r % I_OUT, lane, false); continue; } r -= 2 * I_OUT;
                { const int mi = r / I_UP, l = mi >> 2, m = mi & 3, d = m & 1;
                  const float* src = ((m < 2) ? C.w_up : C.a_up) + (size_t)(l * 2 + d) * 64 * 256;
                  transpose_item(src, 64, 256, C.WupT + (size_t)(l * 4 + m) * 256 * 64, scr, r % I_UP, lane, false); }
            }
        }
    }
}

template <int MODE>
__device__ __forceinline__ void norm_phase(const Ctx& C, int hf, int gw, int ngw, int lane_in, float pe1 = 0.f, float pe2 = 0.f) {
    const int lane = opaque(lane_in);
    const int nrows = (MODE == 2) ? LATH : MH;
    for (int lr0 = gw * 2; lr0 < nrows; lr0 += ngw * 2) {
        const bool lat = lr0 < LATH;
        int mrow; const float* xin; float* x1p;
        if (lat) { const size_t g = (size_t)hf * LATH + lr0; mrow = hf * HB + lr0 / SEQ; xin = C.x + g * DM; x1p = C.out + g * DM; }
        else { const size_t g = (size_t)hf * CTXH + (lr0 - LATH); mrow = 32; xin = C.ctx + g * DM; x1p = C.xc1 + g * DM; }
        f32x4 v[2][4];
        const float* base = (MODE == 2) ? x1p : xin;
#pragma unroll
        for (int rr = 0; rr < 2; ++rr)
#pragma unroll
            for (int j = 0; j < 4; ++j) v[rr][j] = *(const f32x4*)(base + rr * DM + 4 * lane + 256 * j);
        if (MODE >= 1) {
            const float* gate = C.mod + ((size_t)(MODE - 1) * 33 + mrow) * 3072 + 2048;
            const float* pg = C.post_g + (MODE - 1) * DM;
            const bf16_t* yr = C.Y + (size_t)lr0 * DM;
            f32x4 y[2][4]; float ss[2];
#pragma unroll
            for (int rr = 0; rr < 2; ++rr) { ss[rr] = 0.f;
#pragma unroll
                for (int j = 0; j < 4; ++j) { y[rr][j] = ld_bf4(yr + rr * DM + 4 * lane + 256 * j); ss[rr] += (y[rr][j][0] * y[rr][j][0] + y[rr][j][1] * y[rr][j][1]) + (y[rr][j][2] * y[rr][j][2] + y[rr][j][3] * y[rr][j][3]); } }
            const float rstd0 = __builtin_amdgcn_rsqf(wave_sum(ss[0]) * (1.f / DM) + NORM_EPS), rstd1 = __builtin_amdgcn_rsqf(wave_sum(ss[1]) * (1.f / DM) + NORM_EPS);
#pragma unroll
            for (int j = 0; j < 4; ++j) { const f32x4 gt = *(const f32x4*)(gate + 4 * lane + 256 * j), pgv = *(const f32x4*)(pg + 4 * lane + 256 * j);
#pragma unroll
                for (int rr = 0; rr < 2; ++rr) {
                    v[rr][j] = v[rr][j] + gt * (y[rr][j] * (rr ? rstd1 : rstd0) * pgv);
#ifdef PROBE_A
                    if (MODE == 2 && hf == 1 && lr0 + rr < 1024) { v[rr][j] = v[rr][j] + pe2; if (lr0 + rr == 0 && lane == 0 && j == 0) v[rr][j][0] += pe1; }
#endif
                    *(f32x4*)(x1p + rr * DM + 4 * lane + 256 * j) = v[rr][j]; } }
        }
        if (MODE <= 1) {
            const float* md = C.mod + ((size_t)MODE * 33 + mrow) * 3072;
            const float* pre = C.pre_g + MODE * DM;
            float ss[2];
#pragma unroll
            for (int rr = 0; rr < 2; ++rr) { ss[rr] = 0.f;
#pragma unroll
                for (int j = 0; j < 4; ++j) ss[rr] += (v[rr][j][0] * v[rr][j][0] + v[rr][j][1] * v[rr][j][1]) + (v[rr][j][2] * v[rr][j][2] + v[rr][j][3] * v[rr][j][3]); }
            const float rstd0 = __builtin_amdgcn_rsqf(wave_sum(ss[0]) * (1.f / DM) + NORM_EPS), rstd1 = __builtin_amdgcn_rsqf(wave_sum(ss[1]) * (1.f / DM) + NORM_EPS);
            bf16_t* hr = C.H + (size_t)lr0 * DM;
#pragma unroll
            for (int j = 0; j < 4; ++j) { const f32x4 sh = *(const f32x4*)(md + 4 * lane + 256 * j), scl = *(const f32x4*)(md + 1024 + 4 * lane + 256 * j), pv = *(const f32x4*)(pre + 4 * lane + 256 * j);
#pragma unroll
                for (int rr = 0; rr < 2; ++rr) st_bf4(hr + rr * DM + 4 * lane + 256 * j, (v[rr][j] * (rr ? rstd1 : rstd0) * pv) * (1.f + scl) + sh); }
        }
    }
}

__device__ __forceinline__ int crow(int r, int hi) { return (r & 3) + 8 * (r >> 2) + 4 * hi; }
__device__ __forceinline__ bf16x8 tanh8(bf16x8 x) {
    const u32x4 w = __builtin_bit_cast(u32x4, x); u32x4 o;
#pragma unroll
    for (int i = 0; i < 4; ++i) { const float a = bf_lo(w[i]), b = bf_hi(w[i]);
        const float ta = 1.f - 2.f * frcp(1.f + fexp2(2.885390081777927f * a)), tb = 1.f - 2.f * frcp(1.f + fexp2(2.885390081777927f * b));
        o[i] = cvt_pk_bf16(ta, tb); }
    return __builtin_bit_cast(bf16x8, o);
}
__device__ __forceinline__ void prep_block(const Ctx& C, int l, int task, LAS unsigned char* lds) {
    const int tid = opaque(threadIdx.x), lane = tid & 63, wid = __builtin_amdgcn_readfirstlane(tid >> 6);
    const int r32 = lane & 31, hi = lane >> 5, lr0 = task * 64;
    constexpr int PST = 520;
    LAS bf16_t* xs = (LAS bf16_t*)lds;
#pragma unroll
    for (int i = 0; i < 8; ++i) { const int idx = tid + 512 * i, row = idx >> 6, ch = idx & 63;
        const u32x4 v = *(const u32x4*)(C.P + (size_t)(lr0 + row) * DIN + (ch < 32 ? C_K + ch * 8 : C_LWF + (ch - 32) * 8));
        *(LAS u32x4*)(xs + row * PST + ch * 8) = v; }
    __syncthreads();
    const int tg = wid & 1, q = wid >> 1, lrw = lr0 + tg * 32;
    const LAS bf16_t* xrow = xs + (tg * 32 + r32) * PST + hi * 8;
    const LAS bf16_t* xcol = xs + (tg * 32) * PST;
    const bf16_t* WT = C.WupT + (size_t)l * 4 * 256 * 64;
    constexpr size_t ARR = (size_t)MH * 256;
#pragma unroll 1
    for (int d = 0; d < 2; ++d) {
        bf16x8 xf[4];
#pragma unroll
        for (int i0 = 0; i0 < 4; ++i0) xf[i0] = tanh8(*(const LAS bf16x8*)(xrow + 256 + d * 64 + i0 * 16));
        const bf16_t* wt = WT + (size_t)d * 256 * 64;
        const float* w0 = C.w0 + (l * 2 + d) * 256;
        float* dst = C.SC + (size_t)d * ARR;
#pragma unroll 1
        for (int jb = 2 * q; jb < 2 * q + 2; ++jb) {
            const int j = jb * 32 + r32;
            f32x16 acc = {};
#pragma unroll
            for (int i0 = 0; i0 < 4; ++i0) { const bf16x8 wf = *(const bf16x8*)(wt + (size_t)j * 64 + i0 * 16 + hi * 8); acc = __builtin_amdgcn_mfma_f32_32x32x16_bf16(xf[i0], wf, acc, 0, 0, 0); }
            const float w0j = w0[j];
#pragma unroll
            for (int r = 0; r < 16; ++r) { const int row = lrw + crow(r, hi);
                const float sg = sigmoidf_(acc[r] + w0j);
                dst[(size_t)row * 256 + j] = fexp2(-0.8750429636f * sg); }
        }
    }
    {
        const int hd = q;
        float rn[16];
        { const float kk0 = C.k_k[l * 256 + hd * 64 + r32], kk1 = C.k_k[l * 256 + hd * 64 + 32 + r32];
#pragma unroll
          for (int r = 0; r < 16; ++r) { const LAS bf16_t* kp = xcol + crow(r, hi) * PST + hd * 64 + r32;
              const float a = bf2f(kp[0]) * kk0, b = bf2f(kp[32]) * kk1; const float s = sum32(a * a + b * b);
              rn[r] = frcp(fmaxf(__builtin_sqrtf(s), 1e-12f)); } }
#pragma unroll 1
        for (int jd = 0; jd < 4; ++jd) {
            const int jb2 = jd >> 1, d = jd & 1;
            const int j = hd * 64 + jb2 * 32 + r32;
            const float kkj = C.k_k[l * 256 + j], kaj = C.k_a[l * 256 + j];
            const bf16_t* wt = WT + (size_t)(2 + d) * 256 * 64;
            f32x16 acc = {};
#pragma unroll
            for (int i0 = 0; i0 < 4; ++i0) { const bf16x8 xf = *(const LAS bf16x8*)(xrow + 384 + d * 64 + i0 * 16);
                const bf16x8 wf = *(const bf16x8*)(wt + (size_t)j * 64 + i0 * 16 + hi * 8); acc = __builtin_amdgcn_mfma_f32_32x32x16_bf16(xf, wf, acc, 0, 0, 0); }
            const float a0j = C.a0[(l * 2 + d) * 256 + j];
            bf16_t* sb16 = (bf16_t*)(C.SC + 2 * ARR);
            bf16_t* dkm = sb16 + (size_t)d * ARR; bf16_t* dbb = sb16 + (size_t)(2 + d) * ARR; bf16_t* daa = sb16 + 4 * ARR;
#pragma unroll
            for (int r = 0; r < 16; ++r) { const int cr = crow(r, hi); const size_t off = (size_t)(lrw + cr) * 256 + j;
                const float k = bf2f(xcol[cr * PST + j]);
                const float a = sigmoidf_(acc[r] + a0j), kkn = k * kkj * rn[r];
                const unsigned pk_ = cvt_pk_bf16(k * (1.f + (a - 1.f) * kaj), kkn * a);
                dkm[off] = (bf16_t)(pk_ & 0xffffu); dbb[off] = (bf16_t)(pk_ >> 16); if (d == 0) daa[off] = (bf16_t)(cvt_pk_bf16(-kkn, 0.f) & 0xffffu); }
        }
    }
    __syncthreads();
}
__device__ __forceinline__ void rowpass4(const Ctx& C, int l, int r0, int lane_in, bool do_conv) {
    const int lane = opaque(lane_in);
    const bool lat = r0 < LATH; const int t0 = lat ? (r0 & (SEQ - 1)) : ((r0 - LATH) & (CTX - 1)), len = lat ? SEQ : CTX;
    const bf16_t* pr = C.P + (size_t)r0 * DIN; const int c = 4 * lane;
    u32x4 qw[4], kw[4];
    if (lat) {
#pragma unroll
        for (int i = 0; i < 4; ++i) { qw[i] = *(const u32x4*)(pr + (size_t)i * DIN + C_AQ + 8 * lane); kw[i] = *(const u32x4*)(pr + (size_t)i * DIN + C_AK + 8 * lane); }
    }
    if (do_conv) {
        f32x4 u[6], bg[4], z[4];
#pragma unroll
        for (int i = 0; i < 6; ++i) { const bool ok = (i == 0) ? (t0 > 0) : (i == 5) ? (t0 + 4 < len) : true;
            const bf16_t* p = pr + (long)(i - 1) * DIN;
            u[i] = ok ? ld_bf4(p + C_CC + c) * ld_bf4(p + C_CH + c) : (f32x4){0.f, 0.f, 0.f, 0.f}; }
#pragma unroll
        for (int i = 0; i < 4; ++i) { bg[i] = ld_bf4(pr + (size_t)i * DIN + C_CB + c); z[i] = ld_bf4(pr + (size_t)i * DIN + C_CZ + c); }
        const float* cw = C.conv_w + l * 3 * 256 + c;
        const f32x4 w0 = *(const f32x4*)cw, w1 = *(const f32x4*)(cw + 256), w2 = *(const f32x4*)(cw + 512);
#pragma unroll
        for (int i = 0; i < 4; ++i) { const f32x4 y = u[i] * w0 + u[i + 1] * w1 + u[i + 2] * w2;
            f32x4 o; o[0] = bg[i][0] * y[0] * siluf_(z[i][0]); o[1] = bg[i][1] * y[1] * siluf_(z[i][1]); o[2] = bg[i][2] * y[2] * siluf_(z[i][2]); o[3] = bg[i][3] * y[3] * siluf_(z[i][3]);
            st_bf4(C.H + (size_t)(r0 + i) * DM + 256 + c, o); }
    }
    if (lat) {
        const float sg = (lane & 2) ? 1.f : -1.f;
#pragma unroll
        for (int i = 0; i < 4; ++i) {
            const int t = t0 + i; const int pos = ((lane >> 2) & 1) ? (t & 63) : (t >> 6);
            const f32x4* rp = (const f32x4*)(C.rope + (pos * 16 + 8 * (lane & 1)) * 2);
            const f32x4 c0 = rp[0], c1 = rp[1], c2 = rp[2], c3 = rp[3];
#pragma unroll
            for (int which = 0; which < 2; ++which) {
                const u32x4 w = which ? kw[i] : qw[i]; u32x4 pw;
#pragma unroll
                for (int e = 0; e < 4; ++e) pw[e] = (unsigned)__builtin_amdgcn_update_dpp(0, (int)w[e], 0x4E, 0xF, 0xF, true);
                u32x4 o;
                o[0] = cvt_pk_bf16(bf_lo(w[0]) * c0[0] + sg * bf_lo(pw[0]) * c0[1], bf_hi(w[0]) * c0[2] + sg * bf_hi(pw[0]) * c0[3]);
                o[1] = cvt_pk_bf16(bf_lo(w[1]) * c1[0] + sg * bf_lo(pw[1]) * c1[1], bf_hi(w[1]) * c1[2] + sg * bf_hi(pw[1]) * c1[3]);
                o[2] = cvt_pk_bf16(bf_lo(w[2]) * c2[0] + sg * bf_lo(pw[2]) * c2[1], bf_hi(w[2]) * c2[2] + sg * bf_hi(pw[2]) * c2[3]);
                o[3] = cvt_pk_bf16(bf_lo(w[3]) * c3[0] + sg * bf_lo(pw[3]) * c3[1], bf_hi(w[3]) * c3[2] + sg * bf_hi(pw[3]) * c3[3]);
                *(u32x4*)(C.P + (size_t)(r0 + i) * DIN + (which ? C_AK : C_AQ) + 8 * lane) = o;
            }
        }
    }
}
__device__ __forceinline__ void conv_row(const Ctx& C, int l, int lr, int lane_in) {
    const int lane = opaque(lane_in);
    const bool lat = lr < LATH; const int t = lat ? (lr & (SEQ - 1)) : ((lr - LATH) & (CTX - 1)), len = lat ? SEQ : CTX;
    const bf16_t* pr = C.P + (size_t)lr * DIN; const int c = 4 * lane;
    const float* cw = C.conv_w + l * 3 * 256 + c;
    const f32x4 w0 = *(const f32x4*)cw, w1 = *(const f32x4*)(cw + 256), w2 = *(const f32x4*)(cw + 512);
    f32x4 y = (ld_bf4(pr + C_CC + c) * ld_bf4(pr + C_CH + c)) * w1;
    if (t > 0) y = y + (ld_bf4(pr - DIN + C_CC + c) * ld_bf4(pr - DIN + C_CH + c)) * w0;
    if (t < len - 1) y = y + (ld_bf4(pr + DIN + C_CC + c) * ld_bf4(pr + DIN + C_CH + c)) * w2;
    const f32x4 bg = ld_bf4(pr + C_CB + c), z = ld_bf4(pr + C_CZ + c);
    f32x4 o; o[0] = bg[0] * y[0] * siluf_(z[0]); o[1] = bg[1] * y[1] * siluf_(z[1]); o[2] = bg[2] * y[2] * siluf_(z[2]); o[3] = bg[3] * y[3] * siluf_(z[3]);
    st_bf4(C.H + (size_t)lr * DM + 256 + c, o);
}

__device__ __forceinline__ void rope_row(const Ctx& C, int lr, int lane_in) {
    const int lane = opaque(lane_in);
    const int t = lr & (SEQ - 1); const int pos = ((lane >> 2) & 1) ? (t & 63) : (t >> 6);
    const f32x4* rp = (const f32x4*)(C.rope + (pos * 16 + 8 * (lane & 1)) * 2);
    const f32x4 c0 = rp[0], c1 = rp[1], c2 = rp[2], c3 = rp[3];
    const float sg = (lane & 2) ? 1.f : -1.f;
#pragma unroll
    for (int which = 0; which < 2; ++which) {
        bf16_t* p = C.P + (size_t)lr * DIN + (which ? C_AK : C_AQ) + 8 * lane;
        const u32x4 w = *(const u32x4*)p; u32x4 pw;
#pragma unroll
        for (int i = 0; i < 4; ++i) pw[i] = (unsigned)__builtin_amdgcn_update_dpp(0, (int)w[i], 0x4E, 0xF, 0xF, true);
        u32x4 o;
        o[0] = cvt_pk_bf16(bf_lo(w[0]) * c0[0] + sg * bf_lo(pw[0]) * c0[1], bf_hi(w[0]) * c0[2] + sg * bf_hi(pw[0]) * c0[3]);
        o[1] = cvt_pk_bf16(bf_lo(w[1]) * c1[0] + sg * bf_lo(pw[1]) * c1[1], bf_hi(w[1]) * c1[2] + sg * bf_hi(pw[1]) * c1[3]);
        o[2] = cvt_pk_bf16(bf_lo(w[2]) * c2[0] + sg * bf_lo(pw[2]) * c2[1], bf_hi(w[2]) * c2[2] + sg * bf_hi(pw[2]) * c2[3]);
        o[3] = cvt_pk_bf16(bf_lo(w[3]) * c3[0] + sg * bf_lo(pw[3]) * c3[1], bf_hi(w[3]) * c3[2] + sg * bf_hi(pw[3]) * c3[3]);
        *(u32x4*)p = o;
    }
}

__device__ __forceinline__ int scan_row(int s, int dir, int bl) {
    if (s < CTX) { const int t = dir ? (CTX - 1 - s) : s; return LATH + bl * CTX + t; }
    const int t0 = s - CTX; const int t = dir ? (SEQ - 1 - t0) : t0; return bl * SEQ + t;
}
__device__ __forceinline__ void scan_unit(const Ctx& C, int l, int u, LAS unsigned char* lds) {
    const int bl = u >> 3, hd = (u >> 1) & 3, dir = u & 1;
    const int tid = opaque(threadIdx.x), lane = tid & 63, wid = __builtin_amdgcn_readfirstlane(tid >> 6);
    constexpr size_t ARR = (size_t)MH * 256;
    constexpr int CHF = 32 * 6 * 64;
    constexpr int YB0 = 2 * CHF;
    const int lst = tid >> 4, q4 = tid & 15;
    const float* a_dec = C.SC + (size_t)dir * ARR + hd * 64 + q4 * 4;
    const bf16_t* sb16 = (const bf16_t*)(C.SC + 2 * ARR);
    const bf16_t* a_km = sb16 + (size_t)dir * ARR + hd * 64 + q4 * 4;
    const bf16_t* a_bb = sb16 + (size_t)(2 + dir) * ARR + hd * 64 + q4 * 4;
    const bf16_t* a_aa = sb16 + 4 * ARR + hd * 64 + q4 * 4;
    const bf16_t* a_r = C.P + C_R + hd * 64 + q4 * 4;
    const bf16_t* a_v = C.P + C_V + hd * 64 + q4 * 4;
    float* a_y = C.YS + (size_t)dir * ARR + hd * 64 + q4 * 4;
    f32x4 g0, g1, g2, g3, g4, g5;
#define SC_LOAD(c) do { const size_t row_ = (size_t)scan_row((c) * 32 + lst, dir, bl); \
        g0 = *(const f32x4*)(a_dec + row_ * 256); g1 = ld_bf4(a_km + row_ * 256); g2 = ld_bf4(a_aa + row_ * 256); g3 = ld_bf4(a_bb + row_ * 256); \
        g4 = ld_bf4(a_r + row_ * DIN); g5 = ld_bf4(a_v + row_ * DIN); } while (0)
#define SC_WRITE(b) do { LAS float* d_ = (LAS float*)lds + (b) * CHF + lst * 384 + q4 * 4; \
        *(LAS f32x4*)(d_) = g0; *(LAS f32x4*)(d_ + 64) = g1; *(LAS f32x4*)(d_ + 128) = g2; *(LAS f32x4*)(d_ + 192) = g3; *(LAS f32x4*)(d_ + 256) = g4; *(LAS f32x4*)(d_ + 320) = g5; } while (0)
    f32x4 S0 = {0.f, 0.f, 0.f, 0.f}, S1 = {0.f, 0.f, 0.f, 0.f};
    const int vq = lane >> 4, k16 = lane & 15;
    const int rloc = 8 * wid + 2 * vq;
    SC_LOAD(0); SC_WRITE(0); __syncthreads();
    constexpr int NCH = (CTX + SEQ) / 32;
#pragma unroll 1
    for (int c = 0; c < NCH; ++c) {
        if (c > 0 && ((c - 1 >= CTX / 32) || (l == 0))) {
            const f32x4 yv = *(const LAS f32x4*)((const LAS float*)lds + YB0 + ((c - 1) & 1) * 2048 + lst * 64 + q4 * 4);
            *(f32x4*)(a_y + (size_t)scan_row((c - 1) * 32 + lst, dir, bl) * 256) = yv;
        }
        if (c + 1 < NCH) SC_LOAD(c + 1);
        {
            const LAS float* cb = (const LAS float*)lds + (c & 1) * CHF + k16 * 4;
            const LAS float* vbp = (const LAS float*)lds + (c & 1) * CHF + 320 + rloc;
            LAS float* yb = (LAS float*)lds + YB0 + (c & 1) * 2048 + rloc + (k16 & 1);
            const bool wout = (c >= CTX / 32) || (l == 0);
            f32x4 wA, kA, aA, bA, rA, wB, kB, aB, bB, rB; f32x2 vA, vB;
#define SC_RD(W, K, A, B, R, V, s) do { const LAS float* sb_ = cb + (s) * 384; W = *(const LAS f32x4*)(sb_); K = *(const LAS f32x4*)(sb_ + 64); A = *(const LAS f32x4*)(sb_ + 128); \
        B = *(const LAS f32x4*)(sb_ + 192); R = *(const LAS f32x4*)(sb_ + 256); V = *(const LAS f32x2*)(vbp + (s) * 384); } while (0)
#define SC_STEP(W, K, A, B, R, V, DOST, s) do { \
        float sa0 = fmaf(S0[3], A[3], fmaf(S0[2], A[2], fmaf(S0[1], A[1], S0[0] * A[0]))); \
        float sa1 = fmaf(S1[3], A[3], fmaf(S1[2], A[2], fmaf(S1[1], A[1], S1[0] * A[0]))); \
        sa0 = sum16(sa0); sa1 = sum16(sa1); \
        S0 = S0 * W + sa0 * B + V[0] * K; S1 = S1 * W + sa1 * B + V[1] * K; \
        if (DOST) { \
        float y0 = fmaf(S0[3], R[3], fmaf(S0[2], R[2], fmaf(S0[1], R[1], S0[0] * R[0]))); \
        float y1 = fmaf(S1[3], R[3], fmaf(S1[2], R[2], fmaf(S1[1], R[1], S1[0] * R[0]))); \
        y0 = sum16(y0); y1 = sum16(y1); \
        yb[(s) * 64] = (k16 & 1) ? y1 : y0; } } while (0)
            SC_RD(wA, kA, aA, bA, rA, vA, 0);
            if (wout) {
#pragma unroll 2
                for (int s = 0; s < 32; s += 2) { SC_RD(wB, kB, aB, bB, rB, vB, s + 1); SC_STEP(wA, kA, aA, bA, rA, vA, true, s);
                                                  SC_RD(wA, kA, aA, bA, rA, vA, s + 2); SC_STEP(wB, kB, aB, bB, rB, vB, true, s + 1); }
            } else {
#pragma unroll 2
                for (int s = 0; s < 32; s += 2) { SC_RD(wB, kB, aB, bB, rB, vB, s + 1); SC_STEP(wA, kA, aA, bA, rA, vA, false, s);
                                                  SC_RD(wA, kA, aA, bA, rA, vA, s + 2); SC_STEP(wB, kB, aB, bB, rB, vB, false, s + 1); }
            }
#undef SC_RD
#undef SC_STEP
        }
        if (c + 1 < NCH) SC_WRITE((c + 1) & 1);
        __syncthreads();
    }
    { const f32x4 yv = *(const LAS f32x4*)((const LAS float*)lds + YB0 + ((NCH - 1) & 1) * 2048 + lst * 64 + q4 * 4);
      *(f32x4*)(a_y + (size_t)scan_row((NCH - 1) * 32 + lst, dir, bl) * 256) = yv; }
    __syncthreads();
#undef SC_LOAD
#undef SC_WRITE
}

constexpr int CK_RAW = 0, CK_XA = 24576, CK_ZB = 29184, CK_EZ = 33792  , CK_UV = 44032  , CK_PP = 54272, CK_S0 = 56832, CK_GF = 66048, CK_R0 = 70656, CK_DC = 79872  , CK_END = 80384;
__device__ __forceinline__ void ck_images(LAS float* RAW, LAS bf16_t* XA, LAS bf16_t* ZB, LAS bf16_t* EZ, LAS bf16_t* UV, LAS float* DC, int s) {
    const int lt = s >> 5, kp = (s & 31) * 2;
    float c0 = 1.f, c1 = 1.f, cp0 = 1.f, cp1 = 1.f, ct0 = 1.f, ct1 = 1.f;
#pragma unroll
    for (int j = 0; j < 16; ++j) { const f32x2 w = *(const LAS f32x2*)(RAW + j * 64 + kp); if (j == lt) { cp0 = c0; cp1 = c1; } c0 *= w[0]; c1 *= w[1]; if (j == lt) { ct0 = c0; ct1 = c1; } }
    const f32x2 aa = *(const LAS f32x2*)(RAW + 1024 + lt * 64 + kp), bb = *(const LAS f32x2*)(RAW + 2048 + lt * 64 + kp), km = *(const LAS f32x2*)(RAW + 3072 + lt * 64 + kp),
                rr = *(const LAS f32x2*)(RAW + 4096 + lt * 64 + kp), vv = *(const LAS f32x2*)(RAW + 5120 + lt * 64 + kp);
    const float en0 = frcp(ct0), en1 = frcp(ct1), ee0 = c0 * en0, ee1 = c1 * en1;
    *(LAS unsigned*)(XA + lt * 72 + kp) = cvt_pk_bf16(aa[0] * cp0, aa[1] * cp1);
    *(LAS unsigned*)(XA + (16 + lt) * 72 + kp) = cvt_pk_bf16(rr[0] * ct0, rr[1] * ct1);
    *(LAS unsigned*)(ZB + lt * 72 + kp) = cvt_pk_bf16(bb[0] * en0, bb[1] * en1);
    *(LAS unsigned*)(ZB + (16 + lt) * 72 + kp) = cvt_pk_bf16(km[0] * en0, km[1] * en1);
    const unsigned eb = cvt_pk_bf16(bb[0] * ee0, bb[1] * ee1), ek = cvt_pk_bf16(km[0] * ee0, km[1] * ee1), ev = cvt_pk_bf16(vv[0], vv[1]);
    EZ[kp * 40 + lt] = (bf16_t)(eb & 0xffffu); EZ[(kp + 1) * 40 + lt] = (bf16_t)(eb >> 16);
    EZ[kp * 40 + 16 + lt] = (bf16_t)(ek & 0xffffu); EZ[(kp + 1) * 40 + 16 + lt] = (bf16_t)(ek >> 16);
    UV[kp * 40 + 16 + lt] = (bf16_t)(ev & 0xffffu); UV[(kp + 1) * 40 + 16 + lt] = (bf16_t)(ev >> 16);
    if (lt == 0) *(LAS f32x2*)(DC + kp) = (f32x2){c0, c1};
}
__device__ __forceinline__ void scan_chunked(const Ctx& C, int l, int u, LAS unsigned char* lds) {
    const int bl = u >> 3, hd = (u >> 1) & 3, dir = u & 1;
    const int tid0 = opaque(threadIdx.x), wid = __builtin_amdgcn_readfirstlane(tid0 >> 6);
    constexpr size_t ARR = (size_t)MH * 256;
    LAS float* RAW = (LAS float*)(lds + CK_RAW);
    LAS bf16_t* XA = (LAS bf16_t*)(lds + CK_XA);
    LAS bf16_t* ZB = (LAS bf16_t*)(lds + CK_ZB);
    LAS bf16_t* EZ0 = (LAS bf16_t*)(lds + CK_EZ);
    LAS bf16_t* UV0 = (LAS bf16_t*)(lds + CK_UV);
    LAS bf16_t* PP = (LAS bf16_t*)(lds + CK_PP);
    LAS bf16_t* S0 = (LAS bf16_t*)(lds + CK_S0);
    LAS float* GF = (LAS float*)(lds + CK_GF);
    LAS float* R0 = (LAS float*)(lds + CK_R0);
    LAS float* DC0 = (LAS float*)(lds + CK_DC);
    const bf16_t* sb16 = (const bf16_t*)(C.SC + 2 * ARR);
    f32x2 ld_w; unsigned ld_km, ld_bb, ld_aa, ld_r, ld_v;
#define CK_LOAD(c) do { const int tl_ = opaque(tid0); const size_t row_ = (size_t)scan_row((c) * 16 + (tl_ >> 5), dir, bl); const size_t o2_ = row_ * 256 + hd * 64 + (tl_ & 31) * 2, op_ = row_ * DIN + hd * 64 + (tl_ & 31) * 2; \
        ld_w = *(const f32x2*)(C.SC + (size_t)dir * ARR + o2_); ld_km = *(const unsigned*)(sb16 + (size_t)dir * ARR + o2_); \
        ld_bb = *(const unsigned*)(sb16 + (size_t)(2 + dir) * ARR + o2_); ld_aa = *(const unsigned*)(sb16 + 4 * ARR + o2_); ld_r = *(const unsigned*)(C.P + C_R + op_); ld_v = *(const unsigned*)(C.P + C_V + op_); } while (0)
#define CK_STORE() do { const int ts_ = opaque(tid0); LAS float* q_ = RAW + (ts_ >> 5) * 64 + (ts_ & 31) * 2; \
        *(LAS f32x2*)(q_) = ld_w; *(LAS f32x2*)(q_ + 1024) = (f32x2){bf_lo(ld_aa), bf_hi(ld_aa)}; \
        *(LAS f32x2*)(q_ + 2048) = (f32x2){bf_lo(ld_bb), bf_hi(ld_bb)}; *(LAS f32x2*)(q_ + 3072) = (f32x2){bf_lo(ld_km), bf_hi(ld_km)}; \
        *(LAS f32x2*)(q_ + 4096) = (f32x2){bf_lo(ld_r), bf_hi(ld_r)}; *(LAS f32x2*)(q_ + 5120) = (f32x2){bf_lo(ld_v), bf_hi(ld_v)}; } while (0)
    for (int e = tid0; e < CK_END / 4; e += 512) ((LAS unsigned*)lds)[e] = 0u;
    __syncthreads();
    f32x16 S = {};
    const int vt = (wid >> 1) & 1, kt = wid & 1;
    constexpr int NCH = (CTX + SEQ) / 16;
    CK_LOAD(0); CK_STORE(); __syncthreads();
    ck_images(RAW, XA, ZB, EZ0, UV0, DC0, opaque(tid0));
    CK_LOAD(1);
    __syncthreads();
#pragma unroll 1
    for (int c = 0; c < NCH; ++c) {
        const int pb = c & 1;
        LAS bf16_t* EZ = EZ0 + pb * (64 * 40); LAS bf16_t* UV = UV0 + pb * (64 * 40); LAS float* DC = DC0 + pb * 64;
        if (c + 1 < NCH) CK_STORE();
        if (c + 2 < NCH) CK_LOAD(c + 2);
        if (wid == 0) {
            const int ln = opaque(tid0) & 63, r32 = ln & 31, hi = ln >> 5;
            f32x16 acc = {};
#pragma unroll
            for (int d0 = 0; d0 < 4; ++d0) { const bf16x8 a = *(const LAS bf16x8*)(XA + r32 * 72 + d0 * 16 + hi * 8), b = *(const LAS bf16x8*)(ZB + r32 * 72 + d0 * 16 + hi * 8);
                acc = __builtin_amdgcn_mfma_f32_32x32x16_bf16(a, b, acc, 0, 0, 0); }
#pragma unroll
            for (int r = 0; r < 16; ++r) GF[crow(r, hi) * 36 + r32] = acc[r];
        } else if (wid <= 2) {
            const int ln = opaque(tid0) & 63, r32 = ln & 31, hi = ln >> 5;
            const int v0 = (wid - 1) * 32;
            f32x16 acc = {};
#pragma unroll
            for (int d0 = 0; d0 < 4; ++d0) { const bf16x8 a = *(const LAS bf16x8*)(S0 + (v0 + r32) * 72 + d0 * 16 + hi * 8), b = *(const LAS bf16x8*)(XA + r32 * 72 + d0 * 16 + hi * 8);
                acc = __builtin_amdgcn_mfma_f32_32x32x16_bf16(a, b, acc, 0, 0, 0); }
#pragma unroll
            for (int r = 0; r < 16; ++r) R0[(v0 + crow(r, hi)) * 36 + r32] = acc[r];
        }
        __syncthreads();
        if (wid == 3) {
            const int v = opaque(tid0) & 63;
            float uu[16], vq[16];
#pragma unroll
            for (int q = 0; q < 4; ++q) { const f32x4 x = *(const LAS f32x4*)(R0 + v * 36 + 4 * q); uu[4 * q] = x[0]; uu[4 * q + 1] = x[1]; uu[4 * q + 2] = x[2]; uu[4 * q + 3] = x[3]; }
#pragma unroll
            for (int q = 0; q < 2; ++q) { const u32x4 x = *(const LAS u32x4*)(UV + v * 40 + 16 + 8 * q);
#pragma unroll
                for (int e = 0; e < 4; ++e) { vq[8 * q + 2 * e] = bf_lo(x[e]); vq[8 * q + 2 * e + 1] = bf_hi(x[e]); } }
#pragma unroll
            for (int t = 1; t < 16; ++t) {
                float a0 = uu[t], a1 = 0.f, a2 = 0.f, a3 = 0.f;
#pragma unroll
                for (int q = 0; q * 4 < t; ++q) { const f32x4 m = *(const LAS f32x4*)(GF + t * 36 + 4 * q), n = *(const LAS f32x4*)(GF + t * 36 + 16 + 4 * q);
#pragma unroll
                    for (int e = 0; e < 4; ++e) if (4 * q + e < t) { if (e & 1) { a1 = fmaf(uu[4 * q + e], m[e], a1); a3 = fmaf(vq[4 * q + e], n[e], a3); } else { a0 = fmaf(uu[4 * q + e], m[e], a0); a2 = fmaf(vq[4 * q + e], n[e], a2); } } }
                uu[t] = (a0 + a1) + (a2 + a3);
            }
            u32x4 w0, w1;
            w0[0] = cvt_pk_bf16(uu[0], uu[1]); w0[1] = cvt_pk_bf16(uu[2], uu[3]); w0[2] = cvt_pk_bf16(uu[4], uu[5]); w0[3] = cvt_pk_bf16(uu[6], uu[7]);
            w1[0] = cvt_pk_bf16(uu[8], uu[9]); w1[1] = cvt_pk_bf16(uu[10], uu[11]); w1[2] = cvt_pk_bf16(uu[12], uu[13]); w1[3] = cvt_pk_bf16(uu[14], uu[15]);
            *(LAS u32x4*)(UV + v * 40) = w0; *(LAS u32x4*)(UV + v * 40 + 8) = w1;
        } else if (wid == 4) {
            const int ln = opaque(tid0) & 63; const int t = ln >> 2, jq = (ln & 3) * 8;
            const f32x4 g0 = *(const LAS f32x4*)(GF + (16 + t) * 36 + jq), g1 = *(const LAS f32x4*)(GF + (16 + t) * 36 + jq + 4);
            float x[8] = {g0[0], g0[1], g0[2], g0[3], g1[0], g1[1], g1[2], g1[3]};
#pragma unroll
            for (int e = 0; e < 8; ++e) { const int i = (jq + e) & 15; if (i > t) x[e] = 0.f; }
            u32x4 w; w[0] = cvt_pk_bf16(x[0], x[1]); w[1] = cvt_pk_bf16(x[2], x[3]); w[2] = cvt_pk_bf16(x[4], x[5]); w[3] = cvt_pk_bf16(x[6], x[7]);
            *(LAS u32x4*)(PP + t * 40 + jq) = w;
        } else if (c + 1 < NCH) {
            const int w6 = (wid < 3) ? wid : wid - 2;
            const int s0 = w6 * 64 + (opaque(tid0) & 63);
            LAS bf16_t* EZn = EZ0 + (pb ^ 1) * (64 * 40); LAS bf16_t* UVn = UV0 + (pb ^ 1) * (64 * 40); LAS float* DCn = DC0 + (pb ^ 1) * 64;
            ck_images(RAW, XA, ZB, EZn, UVn, DCn, s0);
            if (s0 < 128) ck_images(RAW, XA, ZB, EZn, UVn, DCn, s0 + 384);
        }
        __syncthreads();
        if (wid < 4) {
            const int ln = opaque(tid0) & 63, r32 = ln & 31, hi = ln >> 5;
            const float dc = DC[kt * 32 + r32];
#pragma unroll
            for (int r = 0; r < 16; ++r) S[r] *= dc;
#pragma unroll
            for (int js = 0; js < 2; ++js) { const bf16x8 a = *(const LAS bf16x8*)(UV + (vt * 32 + r32) * 40 + js * 16 + hi * 8), b = *(const LAS bf16x8*)(EZ + (kt * 32 + r32) * 40 + js * 16 + hi * 8);
                S = __builtin_amdgcn_mfma_f32_32x32x16_bf16(a, b, S, 0, 0, 0); }
            asm volatile("s_nop 15\n\ts_nop 7" : "+v"(S));
#pragma unroll
            for (int r = 0; r < 16; r += 2) { const unsigned pk = cvt_pk_bf16(S[r], S[r + 1]);
                S0[(vt * 32 + crow(r, hi)) * 72 + kt * 32 + r32] = (bf16_t)(pk & 0xffffu); S0[(vt * 32 + crow(r + 1, hi)) * 72 + kt * 32 + r32] = (bf16_t)(pk >> 16); }
        } else if ((wid == 5 || wid == 6) && ((c >= CTX / 16) || (l == 0))) {
            const int ln = opaque(tid0) & 63, r32 = ln & 31, hi = ln >> 5;
            const int v0 = (wid - 5) * 32;
            f32x16 acc;
#pragma unroll
            for (int r = 0; r < 16; ++r) acc[r] = (r32 < 16) ? R0[(v0 + crow(r, hi)) * 36 + 16 + r32] : 0.f;
#pragma unroll
            for (int js = 0; js < 2; ++js) { const bf16x8 a = *(const LAS bf16x8*)(UV + (v0 + r32) * 40 + js * 16 + hi * 8), b = *(const LAS bf16x8*)(PP + r32 * 40 + js * 16 + hi * 8);
                acc = __builtin_amdgcn_mfma_f32_32x32x16_bf16(a, b, acc, 0, 0, 0); }
            if (r32 < 16) { float* yp = C.YS + (size_t)dir * ARR + hd * 64 + (size_t)scan_row(c * 16 + r32, dir, bl) * 256 + v0 + 4 * hi;
#pragma unroll
                for (int q = 0; q < 4; ++q) *(f32x4*)(yp + 8 * q) = (f32x4){acc[4 * q], acc[4 * q + 1], acc[4 * q + 2], acc[4 * q + 3]}; }
        }
        __syncthreads();
    }
#undef CK_LOAD
#undef CK_STORE
}

#define KSWZ(row, colB) ((row) * 256 + ((colB) ^ (((row) & 7) << 4)))
#define SBAR() __builtin_amdgcn_sched_barrier(0)
constexpr int SHM_KV = 64 * 128 * 2;
constexpr float ATT_THR = 11.5f;
__device__ __forceinline__ int v_st(int k, int c) { const int kk = (k & ~0xC) | ((k & 4) << 1) | ((k & 8) >> 1); return ((kk >> 3) * 4 + (c >> 5)) * 512 + ((kk & 7) * 32 + (c & 31)) * 2; }
__device__ __forceinline__ int v_rd_base(int lane) { return ((lane & 3) << 3) | (((lane >> 2) & 3) << 6) | (((lane >> 4) & 1) << 5) | (((lane >> 5) & 1) << 8); }
constexpr int v_rd_off(int d0, int ks, int half) { return d0 * 512 + ks * 4096 + half * 2048; }
template <int OFF> __device__ __forceinline__ s16x4 tr_read(int vb) { s16x4 r; asm volatile("ds_read_b64_tr_b16 %0, %1 offset:%2" : "=&v"(r) : "v"(vb), "i"(OFF) : "memory"); return r; }
struct VFrag { s16x4 l0, h0, l1, h1, l2, h2, l3, h3; };
template <int D0> __device__ __forceinline__ void v_reads(VFrag& f, int vb) {
    f.l0 = tr_read<v_rd_off(D0, 0, 0)>(vb); f.h0 = tr_read<v_rd_off(D0, 0, 1)>(vb); f.l1 = tr_read<v_rd_off(D0, 1, 0)>(vb); f.h1 = tr_read<v_rd_off(D0, 1, 1)>(vb);
    f.l2 = tr_read<v_rd_off(D0, 2, 0)>(vb); f.h2 = tr_read<v_rd_off(D0, 2, 1)>(vb); f.l3 = tr_read<v_rd_off(D0, 3, 0)>(vb); f.h3 = tr_read<v_rd_off(D0, 3, 1)>(vb);
}
__device__ __forceinline__ void pv_mma(f32x16& od, const VFrag& f, bf16x8 pa0, bf16x8 pa1, bf16x8 pa2, bf16x8 pa3) {
#define PKV(L, H) (bf16x8){L[0], L[1], L[2], L[3], H[0], H[1], H[2], H[3]}
    od = __builtin_amdgcn_mfma_f32_32x32x16_bf16(pa0, PKV(f.l0, f.h0), od, 0, 0, 0);
    od = __builtin_amdgcn_mfma_f32_32x32x16_bf16(pa1, PKV(f.l1, f.h1), od, 0, 0, 0);
    od = __builtin_amdgcn_mfma_f32_32x32x16_bf16(pa2, PKV(f.l2, f.h2), od, 0, 0, 0);
    od = __builtin_amdgcn_mfma_f32_32x32x16_bf16(pa3, PKV(f.l3, f.h3), od, 0, 0, 0);
#undef PKV
}
template <int KS> __device__ __forceinline__ void v_reads_ks(s16x4 (&l)[4], s16x4 (&h)[4], int vb) {
    l[0] = tr_read<v_rd_off(0, KS, 0)>(vb); h[0] = tr_read<v_rd_off(0, KS, 1)>(vb); l[1] = tr_read<v_rd_off(1, KS, 0)>(vb); h[1] = tr_read<v_rd_off(1, KS, 1)>(vb);
    l[2] = tr_read<v_rd_off(2, KS, 0)>(vb); h[2] = tr_read<v_rd_off(2, KS, 1)>(vb); l[3] = tr_read<v_rd_off(3, KS, 0)>(vb); h[3] = tr_read<v_rd_off(3, KS, 1)>(vb);
}
__device__ __forceinline__ void pv_mma_ks(f32x16 (&o)[4], const s16x4 (&l)[4], const s16x4 (&h)[4], bf16x8 pa) {
#define PKV(L, H) (bf16x8){L[0], L[1], L[2], L[3], H[0], H[1], H[2], H[3]}
    __builtin_amdgcn_s_setprio(1);
    o[0] = __builtin_amdgcn_mfma_f32_32x32x16_bf16(pa, PKV(l[0], h[0]), o[0], 0, 0, 0);
    o[1] = __builtin_amdgcn_mfma_f32_32x32x16_bf16(pa, PKV(l[1], h[1]), o[1], 0, 0, 0);
    o[2] = __builtin_amdgcn_mfma_f32_32x32x16_bf16(pa, PKV(l[2], h[2]), o[2], 0, 0, 0);
    o[3] = __builtin_amdgcn_mfma_f32_32x32x16_bf16(pa, PKV(l[3], h[3]), o[3], 0, 0, 0);
    __builtin_amdgcn_s_setprio(0);
#undef PKV
}
__device__ __forceinline__ void pv_all(f32x16 (&o)[4], int vb, bf16x8 pa0, bf16x8 pa1, bf16x8 pa2, bf16x8 pa3) {
    s16x4 l[4], h[4];
    v_reads_ks<0>(l, h, vb); asm volatile("s_waitcnt lgkmcnt(0)" ::: "memory"); SBAR(); pv_mma_ks(o, l, h, pa0);
    v_reads_ks<1>(l, h, vb); asm volatile("s_waitcnt lgkmcnt(0)" ::: "memory"); SBAR(); pv_mma_ks(o, l, h, pa1);
    v_reads_ks<2>(l, h, vb); asm volatile("s_waitcnt lgkmcnt(0)" ::: "memory"); SBAR(); pv_mma_ks(o, l, h, pa2);
    v_reads_ks<3>(l, h, vb); asm volatile("s_waitcnt lgkmcnt(0)" ::: "memory"); SBAR(); pv_mma_ks(o, l, h, pa3);
}
__device__ __forceinline__ void qk_tile(f32x16& p0, f32x16& p1, const bf16x8* qr, const char* Ks, int cb0, int r32, int hi) {
    bf16x8 kf[8];
#pragma unroll
    for (int d0 = 0; d0 < 4; ++d0) { const int cb = cb0 + (d0 * 16 + hi * 8) * 2; kf[2 * d0] = *(const bf16x8*)(Ks + KSWZ(r32, cb)); kf[2 * d0 + 1] = *(const bf16x8*)(Ks + KSWZ(32 + r32, cb)); }
    p0 = f32x16{}; p1 = f32x16{};
    __builtin_amdgcn_s_setprio(1);
#pragma unroll
    for (int d0 = 0; d0 < 4; ++d0) {
        p0 = __builtin_amdgcn_mfma_f32_32x32x16_bf16(kf[2 * d0], qr[d0], p0, 0, 0, 0);
        p1 = __builtin_amdgcn_mfma_f32_32x32x16_bf16(kf[2 * d0 + 1], qr[d0], p1, 0, 0, 0); }
    __builtin_amdgcn_s_setprio(0);
}
__device__ __forceinline__ void sm_pv(f32x16 (&o)[4], f32x16& p0, f32x16& p1, float& m_reg, float& l_reg, int vb, float* al_l, int r32, int hi) {
    float pmax;
    { float m0 = fmaxf(p0[0], p1[0]), m1 = fmaxf(p0[1], p1[1]), m2 = fmaxf(p0[2], p1[2]), m3 = fmaxf(p0[3], p1[3]);
#pragma unroll
      for (int r = 4; r < 16; r += 4) { m0 = fmaxf(fmaxf(m0, p0[r]), p1[r]); m1 = fmaxf(fmaxf(m1, p0[r + 1]), p1[r + 1]); m2 = fmaxf(fmaxf(m2, p0[r + 2]), p1[r + 2]); m3 = fmaxf(fmaxf(m3, p0[r + 3]), p1[r + 3]); }
      pmax = fmaxf(fmaxf(m0, m1), fmaxf(m2, m3)); }
    { auto rr = __builtin_amdgcn_permlane32_swap(__float_as_uint(pmax), __float_as_uint(pmax), false, false); pmax = fmaxf(__uint_as_float(rr[0]), __uint_as_float(rr[1])); }
    float mn, alpha;
    if (__builtin_expect(__all(pmax - m_reg <= ATT_THR), 1)) { mn = m_reg; alpha = 1.f; }
    else { mn = fmaxf(m_reg, pmax); alpha = fexp2(m_reg - mn); m_reg = mn; }
#pragma unroll
    for (int r = 0; r < 16; ++r) { p0[r] = fexp2(p0[r] - mn); p1[r] = fexp2(p1[r] - mn); }
    float ps;
    { float s0 = p0[0] + p1[0], s1 = p0[1] + p1[1], s2 = p0[2] + p1[2], s3 = p0[3] + p1[3];
#pragma unroll
      for (int r = 4; r < 16; r += 4) { s0 += p0[r] + p1[r]; s1 += p0[r + 1] + p1[r + 1]; s2 += p0[r + 2] + p1[r + 2]; s3 += p0[r + 3] + p1[r + 3]; }
      ps = (s0 + s1) + (s2 + s3); }
    { auto rr = __builtin_amdgcn_permlane32_swap(__float_as_uint(ps), __float_as_uint(ps), false, false); ps = __uint_as_float(rr[0]) + __uint_as_float(rr[1]); }
    l_reg = l_reg * alpha + ps;
    if (__any(alpha < 1.f)) { if (hi == 0) al_l[r32] = alpha; asm volatile("s_waitcnt lgkmcnt(0)" ::: "memory");
#pragma unroll
        for (int d = 0; d < 4; ++d)
#pragma unroll
            for (int r = 0; r < 16; ++r) o[d][r] *= al_l[crow(r, hi)]; }
    bf16x8 pa0, pa1, pa2, pa3;
#define PK4(P, BASE, OUT) do { unsigned a0 = cvt_pk_bf16(P[BASE + 0], P[BASE + 1]), a1 = cvt_pk_bf16(P[BASE + 2], P[BASE + 3]); \
        unsigned b0 = cvt_pk_bf16(P[BASE + 4], P[BASE + 5]), b1 = cvt_pk_bf16(P[BASE + 6], P[BASE + 7]); \
        auto r0 = __builtin_amdgcn_permlane32_swap(a0, b0, false, false); auto r1 = __builtin_amdgcn_permlane32_swap(a1, b1, false, false); \
        u32x4 w = {r0[0], r1[0], r0[1], r1[1]}; OUT = __builtin_bit_cast(bf16x8, w); } while (0)
    PK4(p0, 0, pa0); PK4(p0, 8, pa1); PK4(p1, 0, pa2); PK4(p1, 8, pa3);
#undef PK4
    pv_all(o, vb, pa0, pa1, pa2, pa3);
}
__device__ __forceinline__ void attn_unit(const Ctx& C, int l, int hd, int qrow0, int latbase, int ctxbase, int nlat, int NT, float lam, char* lds) {
    const int tid = opaque(threadIdx.x), wid = __builtin_amdgcn_readfirstlane(tid >> 6), lane = tid & 63, r32 = lane & 31, hi = lane >> 5, g = wid & 3, sj = wid >> 2;
    char* V_lds = lds; char* K_lds = lds + 2 * SHM_KV;
    float* wsf = (float*)(lds + 5 * SHM_KV) + wid * 64; float* al_l = wsf; float* li_l = wsf + 32;
    const bf16_t* Qw = C.P + (size_t)(qrow0 + g * 32 + r32) * DIN + C_AQ + hd * 128 + sj * 64 + hi * 8;
    bf16x8 qr[4];
#pragma unroll
    for (int d0 = 0; d0 < 4; ++d0) qr[d0] = *(const bf16x8*)(Qw + d0 * 16);
    const int sr = tid >> 4, sc = (tid & 15) * 8, vst0 = v_st(sr, sc), vst1 = v_st(32 + sr, sc);
    const int vb0 = (int)(uintptr_t)V_lds + v_rd_base(lane);
    const bf16_t* Kc = C.P + C_AK + hd * 128 + sc; const bf16_t* Vc = C.P + C_AV + hd * 128 + sc;
    bf16x8 vs0, vs1, ks0, ks1;
#define TROW(t) ((t) < nlat ? latbase + (t) * 64 : ctxbase + ((t) - nlat) * 64)
#define LOADK(t) do { const size_t rb_ = (size_t)TROW(t); ks0 = *(const bf16x8*)(Kc + (rb_ + sr) * DIN); ks1 = *(const bf16x8*)(Kc + (rb_ + 32 + sr) * DIN); } while (0)
#define LOADV(t) do { const size_t rb_ = (size_t)TROW(t); vs0 = *(const bf16x8*)(Vc + (rb_ + sr) * DIN); vs1 = *(const bf16x8*)(Vc + (rb_ + 32 + sr) * DIN); } while (0)
#define WRITEK(b) do { *(bf16x8*)(K_lds + (b) * SHM_KV + KSWZ(sr, sc * 2)) = ks0; *(bf16x8*)(K_lds + (b) * SHM_KV + KSWZ(32 + sr, sc * 2)) = ks1; } while (0)
#define WRITEV(b) do { *(bf16x8*)(V_lds + (b) * SHM_KV + vst0) = vs0; *(bf16x8*)(V_lds + (b) * SHM_KV + vst1) = vs1; } while (0)
    float m_reg = -1e30f, l_reg = 0.f;
    f32x16 o[4] = {};
    f32x16 pA0, pA1, pB0, pB1;
    LOADK(0); LOADV(0); WRITEK(0); WRITEV(0); LOADK(1); WRITEK(1); __syncthreads();
    qk_tile(pA0, pA1, qr, K_lds, sj * 128, r32, hi);
    int kb1 = 1, kb2 = 2;
#define ATT_STEP(PC0, PC1, PN0, PN1, jj) do { \
        if ((jj) + 2 < NT) LOADK((jj) + 2); if ((jj) + 1 < NT) LOADV((jj) + 1); \
        if ((jj) + 1 < NT) qk_tile(PN0, PN1, qr, K_lds + kb1 * SHM_KV, sj * 128, r32, hi); \
        sm_pv(o, PC0, PC1, m_reg, l_reg, vb0 + ((jj) & 1) * SHM_KV, al_l, r32, hi); \
        if ((jj) + 2 < NT) WRITEK(kb2); if ((jj) + 1 < NT) WRITEV(((jj) + 1) & 1); \
        kb1 = kb2; kb2 = (kb2 == 2) ? 0 : kb2 + 1; \
        __syncthreads(); } while (0)
#pragma unroll 1
    for (int j = 0; j < NT; j += 2) {
        ATT_STEP(pA0, pA1, pB0, pB1, j);
        ATT_STEP(pB0, pB1, pA0, pA1, j + 1);
    }
#undef ATT_STEP
#undef TROW
#undef LOADK
#undef LOADV
#undef WRITEK
#undef WRITEV
    if (hi == 0) li_l[r32] = (sj ? lam : 1.f) * frcp(l_reg);
    asm volatile("s_waitcnt lgkmcnt(0)" ::: "memory");
    float* xb = (float*)lds + g * 4096 + lane;
    if (sj == 1) {
#pragma unroll
        for (int r = 0; r < 16; ++r) { const float a = li_l[crow(r, hi)];
#pragma unroll
            for (int d = 0; d < 4; ++d) xb[(d * 16 + r) * 64] = o[d][r] * a; }
    }
    __syncthreads();
    if (sj == 0) {
        const float lam1m = (l == 0) ? 0.8f : (1.f - 0.35550906759f);
        float g4[4];
#pragma unroll
        for (int d = 0; d < 4; ++d) g4[d] = C.subg[l * 128 + d * 32 + r32] * lam1m;
#pragma unroll
        for (int r = 0; r < 16; ++r) { const int rw = crow(r, hi); const float a = li_l[rw];
            float ss = 0.f; float v4[4];
#pragma unroll
            for (int d = 0; d < 4; ++d) { const float v = o[d][r] * a - xb[(d * 16 + r) * 64]; v4[d] = v; ss += v * v; }
            ss = sum32(ss);
            const float rstd = __builtin_amdgcn_rsqf(ss * (1.f / 128.f) + NORM_EPS);
            const size_t row = (size_t)(qrow0 + g * 32 + rw);
            const bf16_t* zp = C.P + row * DIN + C_AZ + hd * 128 + r32; bf16_t* op = C.H + row * DM + 512 + hd * 128 + r32;
#pragma unroll
            for (int d = 0; d < 4; ++d) { const float z = bf2f(zp[d * 32]); const float v = v4[d] * rstd * g4[d] * siluf_(z);
                op[d * 32] = (bf16_t)(cvt_pk_bf16(v, 0.f) & 0xffffu); } }
    }
    __syncthreads();
}

__device__ __forceinline__ void readout_row(const Ctx& C, int l, int lr, int lane_in) {
    const int lane = opaque(lane_in);
    constexpr size_t ARR = (size_t)MH * 256;
    const int j = 4 * lane; const size_t off = (size_t)lr * 256 + j;
    f32x4 y = *(const f32x4*)(C.YS + off) + *(const f32x4*)(C.YS + ARR + off);
    float s = (y[0] + y[1]) + (y[2] + y[3]);
    s = sum16(s);
    const float mu = s * (1.f / 64.f);
    y = y - mu;
    float q = (y[0] * y[0] + y[1] * y[1]) + (y[2] * y[2] + y[3] * y[3]);
    q = sum16(q);
    const float rstd = __builtin_amdgcn_rsqf(q * (1.f / 64.f) + GN_EPS);
    const f32x4 lg = *(const f32x4*)(C.ln_g + l * 256 + j), lb = *(const f32x4*)(C.ln_b + l * 256 + j), rk = *(const f32x4*)(C.r_k + l * 256 + j);
    const bf16_t* pr = C.P + (size_t)lr * DIN;
    const f32x4 r = ld_bf4(pr + C_R + j), v = ld_bf4(pr + C_V + j), z = ld_bf4(pr + C_ZR + j);
    const bf16_t* sb16 = (const bf16_t*)(C.SC + 2 * ARR);
    const f32x4 ks = ld_bf4(sb16 + off) + ld_bf4(sb16 + ARR + off);
    const f32x4 t = r * ks * rk;
    float bs = (t[0] + t[1]) + (t[2] + t[3]);
    bs = sum16(bs);
    f32x4 o = y * rstd * lg + lb + bs * v;
    o[0] *= siluf_(z[0]); o[1] *= siluf_(z[1]); o[2] *= siluf_(z[2]); o[3] *= siluf_(z[3]);
    st_bf4(C.H + (size_t)lr * DM + j, o);
}

#define XB_TMO      128
#define XB_XCNT(j)  (256  + 64 * (j))
#define XB_XSUB(j)  (1280 + 64 * (j))
#define XB_XGEN(j)  (2304 + 64 * (j))
#define XB_TOP      3328
#define XB_TOPGEN   3392
#define XCD_BAR_WORDS 3456
#define XB_SPIN_CAP (1u << 20)
__device__ __forceinline__ unsigned xb_ld(unsigned* p)              { return __hip_atomic_load(p, __ATOMIC_RELAXED, __HIP_MEMORY_SCOPE_AGENT); }
__device__ __forceinline__ unsigned xb_add(unsigned* p, unsigned v) { return __hip_atomic_fetch_add(p, v, __ATOMIC_RELAXED, __HIP_MEMORY_SCOPE_AGENT); }
__device__ __forceinline__ unsigned xb_xcc_id() { return (unsigned)__builtin_amdgcn_s_getreg((3 << 11) | 20) & 0xFu; }
#define XB_SPIN(cond, bar) do { unsigned _sp = 0; while (cond) { __builtin_amdgcn_s_sleep(1); \
    if ((++_sp & 255u) == 0u) { if (xb_ld(&(bar)[XB_TMO])) break; if (_sp > XB_SPIN_CAP) { atomicAdd(&(bar)[XB_TMO], 1u); break; } } } } while (0)
struct XcdBarrier { unsigned* bar; unsigned x; volatile LAS unsigned* st; };
__device__ __forceinline__ XcdBarrier xcd_barrier_post(unsigned* bar, volatile LAS unsigned* st) {
    XcdBarrier b; b.bar = bar; b.x = xb_xcc_id(); b.st = st;
    if (threadIdx.x == 0) (void)xb_add(&bar[XB_XCNT(b.x)], 1u);
    return b;
}
__device__ __forceinline__ void xcd_barrier_complete(unsigned* bar, unsigned x, unsigned& nloc, unsigned& nx) {
    const unsigned G = gridDim.x * gridDim.y * gridDim.z;
    unsigned sum, cnt, mine, sp = 0u;
    for (;;) {
        sum = 0u; cnt = 0u; mine = 0u;
#pragma unroll
        for (unsigned j = 0; j < 16; ++j) { const unsigned c = xb_ld(&bar[XB_XCNT(j)]); sum += c; cnt += (c > 0u) ? 1u : 0u; mine = (j == x) ? c : mine; }
        if (sum == G) break;
        __builtin_amdgcn_s_sleep(1);
        if ((++sp & 255u) == 0u) { if (xb_ld(&bar[XB_TMO])) break; if (sp > XB_SPIN_CAP) { atomicAdd(&bar[XB_TMO], 1u); break; } }
    }
    nloc = mine > 0u ? mine : 1u; nx = cnt > 0u ? cnt : 1u;
}
__device__ __forceinline__ void xcd_barrier(const XcdBarrier& b) {
    asm volatile("s_waitcnt vmcnt(0)" ::: "memory");
    __syncthreads();
    if (threadIdx.x == 0) {
        unsigned* bar = b.bar;
        __builtin_amdgcn_s_waitcnt(0);
        unsigned nloc = b.st[0], nx = b.st[1];
        if (nloc == 0u) { xcd_barrier_complete(bar, b.x, nloc, nx); b.st[0] = nloc; b.st[1] = nx; }
        const unsigned old = xb_add(&bar[XB_XSUB(b.x)], 1u);
        const unsigned gen = old / nloc;
        if (old + 1u == (gen + 1u) * nloc) {
            __builtin_amdgcn_fence(__ATOMIC_RELEASE, "agent");
            asm volatile("s_waitcnt vmcnt(0)" ::: "memory");
            const unsigned og = xb_add(&bar[XB_TOP], 1u);
            const unsigned tg = og / nx;
            if (og + 1u == (tg + 1u) * nx) xb_add(&bar[XB_TOPGEN], 1u);
            else XB_SPIN(xb_ld(&bar[XB_TOPGEN]) == tg, bar);
            __builtin_amdgcn_fence(__ATOMIC_ACQUIRE, "agent");
            xb_add(&bar[XB_XGEN(b.x)], 1u);
            asm volatile("s_waitcnt vmcnt(0)" ::: "memory");
        } else {
            XB_SPIN(xb_ld(&bar[XB_XGEN(b.x)]) == gen, bar);
            __builtin_amdgcn_fence(__ATOMIC_ACQUIRE, "agent");
            asm volatile("s_waitcnt vmcnt(0)" ::: "memory");
        }
    }
    __syncthreads();
}

#ifndef REP_ATT
#define REP_ATT 1
#endif
#ifndef REP_SCAN
#define REP_SCAN 1
#endif
#ifndef REP_G1
#define REP_G1 1
#endif
#ifndef REP_P3
#define REP_P3 1
#endif
#ifndef REP_RD
#define REP_RD 1
#endif
#ifndef REP_G0
#define REP_G0 1
#endif
#ifndef REP_P1
#define REP_P1 1
#endif
#ifndef REP_SYNC
#define REP_SYNC 1
#endif
#ifndef REP_G2
#define REP_G2 1
#endif
#ifndef REP_FIN
#define REP_FIN 1
#endif
struct Args { const float* in[22]; float* out; unsigned char* ws; };
__global__ void __launch_bounds__(512, 2) mk_fwd(Args a) {
    extern __shared__ __attribute__((aligned(16))) unsigned char lds_raw[];
    cg::grid_group grid = cg::this_grid();
    LAS unsigned char* lds = (LAS unsigned char*)lds_raw;
    Ctx C;
    C.x = a.in[0]; C.c = a.in[1]; C.ctx = a.in[2]; C.c_ctx = a.in[3]; C.mod_w = a.in[4]; C.mod_b = a.in[5]; C.pre_g = a.in[6]; C.post_g = a.in[7]; C.w_in = a.in[8]; C.w_out = a.in[9];
    C.w0 = a.in[10]; C.w_up = a.in[11]; C.a0 = a.in[12]; C.a_up = a.in[13]; C.k_k = a.in[14]; C.k_a = a.in[15]; C.r_k = a.in[16]; C.ln_g = a.in[17]; C.ln_b = a.in[18]; C.conv_w = a.in[19];
    C.dlam = a.in[20]; C.subg = a.in[21]; C.out = a.out;
    unsigned char* ws = a.ws;
    C.WinT = (bf16_t*)(ws + WS_WIN); C.WoutT = (bf16_t*)(ws + WS_WOUT); C.WupT = (bf16_t*)(ws + WS_WUP); C.mod = (float*)(ws + WS_MOD); C.rope = (float*)(ws + WS_ROPE);
    C.xc1 = (float*)(ws + WS_XC1); C.H = (bf16_t*)(ws + WS_H); C.P = (bf16_t*)(ws + WS_P); C.Y = (bf16_t*)(ws + WS_P); C.SC = (float*)(ws + WS_SC); C.YS = (float*)(ws + WS_YS);
    const int tid = threadIdx.x, wid = __builtin_amdgcn_readfirstlane(tid >> 6), G = gridDim.x, bx = blockIdx.x;
#define lane (opaque(tid) & 63)
    const int gw0 = bx * 8 + wid, ngw = G * 8;
#define gw opaque_s(gw0)

    if (bx == 0) for (int i = tid; i < 4096; i += 512) ((unsigned*)ws)[i] = 0u;
    if (tid < 2) ((volatile LAS unsigned*)(lds + 131072 + 1024))[tid] = 0u;
    __syncthreads();
#ifdef PROBE_A
    unsigned long long tprev = __builtin_amdgcn_s_memrealtime(); float tacc[9] = {0.f, 0.f, 0.f, 0.f, 0.f, 0.f, 0.f, 0.f, 0.f};
#define STAMP(k) do { const unsigned long long tn_ = __builtin_amdgcn_s_memrealtime(); tacc[k] += (float)(tn_ - tprev) * 0.01f; tprev = tn_; } while (0)
#else
#define STAMP(k) do { } while (0)
#endif
#ifndef NO_G0
    for (int rep = 0; rep < REP_G0; ++rep) g0_prologue(C, lds);
#endif
    grid.sync(); STAMP(0);
    const XcdBarrier xbar = xcd_barrier_post((unsigned*)ws, (volatile LAS unsigned*)(lds + 131072 + 1024));
#define GSYNC() xcd_barrier(xbar)
#pragma unroll 1
    for (int hf = 0; hf < 2; ++hf) {
#pragma unroll 1
        for (int l = 0; l < 2; ++l) {
#ifndef NO_NORM
            for (int rep = 0; rep < REP_P1; ++rep) { if (l == 0) norm_phase<0>(C, hf, gw, ngw, lane); else norm_phase<1>(C, hf, gw, ngw, lane); }
#endif
            for (int rep = 0; rep < REP_SYNC; ++rep) GSYNC();
            STAMP(1);
            { pg8::Gemm g{C.H, C.WinT + (size_t)l * DIN * DM, MH, DIN, DM}; pg8::StaticOrder S; S.init(MH, DIN, G, bx);
#ifndef NO_GEMM1
              pg8::EpiBf16 E{C.P, DIN}; for (int rep = 0; rep < REP_G1; ++rep) pg8::gemm_phase<pg8::EpiBf16, true>(lds, g, S, E);
#endif
            }
            GSYNC(); STAMP(2);
#ifndef NO_PREP
            for (int rep = 0; rep < REP_P3; ++rep) for (int t = bx; t < MH / 64; t += G) prep_block(C, l, t, lds);
#endif
            for (int r4 = gw; r4 < MH / 4; r4 += ngw) { const bool do_conv = (l == 0) || (r4 < LATH / 4); if (do_conv || r4 < LATH / 4) rowpass4(C, l, r4 * 4, lane, do_conv); }
            GSYNC(); STAMP(3);
#ifndef NO_SCAN
            unsigned* sdone = (unsigned*)ws + 3840 + (hf * 2 + l) * 64;
            { unsigned nscan = 0;
              if (G == 256) { if (((bx >> 3) & 1) == 0) { scan_chunked(C, l, (bx >> 4) * 8 + (bx & 7), lds); nscan = 1; } } else { for (int u = bx; u < 128; u += G) { scan_chunked(C, l, u, lds); ++nscan; } }
              if (nscan) { asm volatile("s_waitcnt vmcnt(0)" ::: "memory"); __syncthreads();
                  if (tid == 0) { __builtin_amdgcn_fence(__ATOMIC_RELEASE, "agent"); asm volatile("s_waitcnt vmcnt(0)" ::: "memory");
                                  (void)__hip_atomic_fetch_add(sdone, nscan, __ATOMIC_RELAXED, __HIP_MEMORY_SCOPE_AGENT); } } }
#endif
            STAMP(4);
#ifndef NO_ATT
            {
                float lam;
                { const int ln = opaque(lane); const float* dl = C.dlam + l * 256; const float sa = wave_sum_dpp(dl[ln] * dl[64 + ln]), sb = wave_sum_dpp(dl[128 + ln] * dl[192 + ln]);
                  lam = fexp2(1.4426950408889634f * sa) - fexp2(1.4426950408889634f * sb) + ((l == 0) ? 0.2f : 0.35550906759f); }
                unsigned* qctr = (unsigned*)ws + 3584 + (hf * 2 + l) * 64;
                volatile LAS unsigned* qslot = (volatile LAS unsigned*)(lds + 131072 + 1024 + 64);
                const int nunits = (l == 0) ? 1024 + 128 : 1024;
                for (;;) {
                    if (tid == 0) qslot[0] = __hip_atomic_fetch_add(qctr, 1u, __ATOMIC_RELAXED, __HIP_MEMORY_SCOPE_AGENT);
                    __syncthreads();
                    const int u = (int)qslot[0];
                    __syncthreads();
                    if (u >= nunits) break;
                    if (u < 1024) { const int bl = u >> 6, hd = (u >> 4) & 3, qb = u & 15;
                        attn_unit(C, l, hd, bl * SEQ + qb * 128, bl * SEQ, LATH + bl * CTX, 32, 36, lam, (char*)lds_raw); }
                    else { const int v = u - 1024; const int bl = v >> 3, hd = (v >> 1) & 3, qb = v & 1;
                        attn_unit(C, l, hd, LATH + bl * CTX + qb * 128, 0, LATH + bl * CTX, 0, 4, lam, (char*)lds_raw); }
                }
            }
#endif
            STAMP(5);
            {
                volatile LAS unsigned* qslot = (volatile LAS unsigned*)(lds + 131072 + 1024 + 64);
                if (tid == 0) { unsigned sp = 0;
                    while (__hip_atomic_load(sdone, __ATOMIC_RELAXED, __HIP_MEMORY_SCOPE_AGENT) < 128u) { __builtin_amdgcn_s_sleep(4); if (++sp > (1u << 22)) break; }
                    __builtin_amdgcn_fence(__ATOMIC_ACQUIRE, "agent"); asm volatile("s_waitcnt vmcnt(0)" ::: "memory"); }
                __syncthreads();
                unsigned* rq = sdone + 16;
                const int nch = ((l == 0) ? MH : LATH) / 64;
                for (;;) {
                    if (tid == 0) qslot[0] = __hip_atomic_fetch_add(rq, 1u, __ATOMIC_RELAXED, __HIP_MEMORY_SCOPE_AGENT);
                    __syncthreads();
                    const int ch = (int)qslot[0];
                    __syncthreads();
                    if (ch >= nch) break;
#pragma unroll 1
                    for (int i = 0; i < 4; ++i) { const int r = ch * 64 + wid * 8 + i * 2; readout_row(C, l, r, lane); readout_row(C, l, r + 1, lane); }
                }
            }
            GSYNC(); STAMP(6);
            { const int M5 = (l == 0) ? MH : LATH; pg8::Gemm g{C.H, C.WoutT + (size_t)l * DM * DM, M5, DM, DM}; pg8::StaticOrder S; S.init(M5, DM, G, bx);
#ifndef NO_GEMM2
              pg8::EpiBf16 E{C.Y, DM}; for (int rep = 0; rep < REP_G2; ++rep) pg8::gemm_phase<pg8::EpiBf16, true>(lds, g, S, E);
#endif
            }
            GSYNC(); STAMP(7);
        }
#ifdef PROBE_A
        norm_phase<2>(C, hf, gw, ngw, lane, 2e-3f * tacc[PROBE_A], 1e-3f * tacc[PROBE_B]); STAMP(8);
#else
        norm_phase<2>(C, hf, gw, ngw, lane);
#endif
    }
#undef gw
#undef lane
}

extern "C" void kernel_launch(void* const* d_in, const int* in_sizes, int n_in, void* d_out, int out_size, void* d_ws, size_t ws_size, hipStream_t stream) {
    static int grid = 0;
    if (grid == 0) {
        if (n_in != 22 || ws_size < WS_END) { fprintf(stderr, "kernel_launch: unexpected n_in %d / ws %zu\n", n_in, ws_size); grid = -1; return; }
        int dev = 0, cus = 0, per_cu = 0;
        hipGetDevice(&dev); hipDeviceGetAttribute(&cus, hipDeviceAttributeMultiprocessorCount, dev);
        if (hipFuncSetAttribute((const void*)mk_fwd, hipFuncAttributeMaxDynamicSharedMemorySize, LDS_BYTES) != hipSuccess) { fprintf(stderr, "kernel_launch: hipFuncSetAttribute failed\n"); grid = -1; return; }
        if (hipOccupancyMaxActiveBlocksPerMultiprocessor(&per_cu, (const void*)mk_fwd, 512, LDS_BYTES) != hipSuccess || per_cu < 1) { fprintf(stderr, "kernel_launch: occupancy query says %d\n", per_cu); per_cu = 1; }
        (void)hipGetLastError();
        grid = cus * 1;
    }
    if (grid < 0) return;
    Args a{};
    for (int i = 0; i < 22; ++i) a.in[i] = (const float*)d_in[i];
    a.out = (float*)d_out; a.ws = (unsigned char*)d_ws;
    void* args[] = {&a};
    hipError_t e = hipLaunchCooperativeKernel((const void*)mk_fwd, dim3(grid), dim3(512), args, LDS_BYTES, stream);
    if (e != hipSuccess) fprintf(stderr, "cooperative launch failed: %s (grid %d)\n", hipGetErrorString(e), grid);
}
```

```cpp
#include <hip/hip_runtime.h>
#include <hip/hip_cooperative_groups.h>
#include <cstdio>
#include <cstdint>
namespace cg = cooperative_groups;

#define LAS __attribute__((address_space(3)))
typedef unsigned short bf16_t;
typedef short bf16x8 __attribute__((ext_vector_type(8)));
typedef short s16x4 __attribute__((ext_vector_type(4)));
typedef float f32x2 __attribute__((ext_vector_type(2)));
typedef float f32x4 __attribute__((ext_vector_type(4)));
typedef float f32x16 __attribute__((ext_vector_type(16)));
typedef unsigned u32x2 __attribute__((ext_vector_type(2)));
typedef unsigned u32x4 __attribute__((ext_vector_type(4)));

constexpr int DM = 1024, SEQ = 2048, CTX = 256, DIN = 4352;
constexpr int HB = 16;
constexpr int LATH = HB * SEQ;
constexpr int CTXH = HB * CTX;
constexpr int MH = LATH + CTXH;
constexpr int C_R = 0, C_K = 256, C_V = 512, C_LWF = 768, C_LWB = 832, C_LAF = 896, C_LAB = 960, C_ZR = 1024,
              C_CB = 1280, C_CC = 1536, C_CH = 1792, C_CZ = 2048, C_AQ = 2304, C_AK = 2816, C_AV = 3328, C_AZ = 3840;
constexpr float C2 = 0.125f * 1.4426950408889634f;
constexpr float NORM_EPS = 1e-6f, GN_EPS = 64e-5f;

constexpr size_t MiB = 1u << 20;
constexpr size_t WS_WIN = 1 * MiB, WS_WOUT = 18 * MiB, WS_WUP = 22 * MiB, WS_MOD = 23 * MiB, WS_ROPE = 24 * MiB, WS_XC1 = 25 * MiB,
                 WS_H = 57 * MiB, WS_P = 129 * MiB, WS_SC = 435 * MiB, WS_YS = 687 * MiB, WS_END = 759 * MiB;
static_assert(WS_WIN + 2ull * DIN * DM * 2 <= WS_WOUT && WS_H + (size_t)MH * DM * 2 <= WS_P && WS_P + (size_t)MH * DIN * 2 <= WS_SC &&
              WS_SC + 7ull * MH * 256 * 4 <= WS_YS && WS_YS + 2ull * MH * 256 * 4 <= WS_END, "ws map");
constexpr int LDS_BYTES = 131072 + 2048;

struct Ctx {
    const float *x, *c, *ctx, *c_ctx, *mod_w, *mod_b, *pre_g, *post_g, *w_in, *w_out, *w0, *w_up, *a0, *a_up, *k_k, *k_a, *r_k, *ln_g, *ln_b, *conv_w, *dlam, *subg;
    float* out;
    bf16_t *WinT, *WoutT, *WupT; float *mod, *rope, *xc1; bf16_t *H, *P, *Y; float *SC, *YS;
};

__device__ __forceinline__ unsigned cvt_pk_bf16(float lo, float hi) { unsigned r; asm volatile("v_cvt_pk_bf16_f32 %0, %1, %2" : "=v"(r) : "v"(lo), "v"(hi)); return r; }
__device__ __forceinline__ float bf_lo(unsigned w) { return __uint_as_float(w << 16); }
__device__ __forceinline__ float bf_hi(unsigned w) { return __uint_as_float(w & 0xffff0000u); }
__device__ __forceinline__ float bf2f(bf16_t b) { return __uint_as_float((unsigned)b << 16); }
__device__ __forceinline__ f32x4 ld_bf4(const bf16_t* p) { const u32x2 w = *(const u32x2*)p; return (f32x4){bf_lo(w.x), bf_hi(w.x), bf_lo(w.y), bf_hi(w.y)}; }
__device__ __forceinline__ void st_bf4(bf16_t* p, f32x4 v) { u32x2 w; w.x = cvt_pk_bf16(v[0], v[1]); w.y = cvt_pk_bf16(v[2], v[3]); *(u32x2*)p = w; }
__device__ __forceinline__ int opaque(int v) { asm volatile("" : "+v"(v)); return v; }
__device__ __forceinline__ int opaque_s(int v) { asm volatile("" : "+s"(v)); return v; }
__device__ __forceinline__ float fexp2(float x) { return __builtin_amdgcn_exp2f(x); }
__device__ __forceinline__ float frcp(float x) { return __builtin_amdgcn_rcpf(x); }
__device__ __forceinline__ float sigmoidf_(float x) { return frcp(1.f + fexp2(-1.4426950408889634f * x)); }
__device__ __forceinline__ float siluf_(float x) { return x * sigmoidf_(x); }
__device__ __forceinline__ float sum16(float v) {
    v += __int_as_float(__builtin_amdgcn_update_dpp(0, __float_as_int(v), 0xB1, 0xF, 0xF, true));
    v += __int_as_float(__builtin_amdgcn_update_dpp(0, __float_as_int(v), 0x4E, 0xF, 0xF, true));
    v += __int_as_float(__builtin_amdgcn_update_dpp(0, __float_as_int(v), 0x141, 0xF, 0xF, true));
    v += __int_as_float(__builtin_amdgcn_update_dpp(0, __float_as_int(v), 0x140, 0xF, 0xF, true));
    return v;
}
__device__ __forceinline__ float wave_sum(float v) {
    const int ri = __float_as_int(sum16(v));
    return (__int_as_float(__builtin_amdgcn_readlane(ri, 0)) + __int_as_float(__builtin_amdgcn_readlane(ri, 16))) + (__int_as_float(__builtin_amdgcn_readlane(ri, 32)) + __int_as_float(__builtin_amdgcn_readlane(ri, 48)));
}
__device__ __forceinline__ float wave_sum_dpp(float v) {
    const int ri = __float_as_int(sum16(v));
    return (__int_as_float(__builtin_amdgcn_readlane(ri, 0)) + __int_as_float(__builtin_amdgcn_readlane(ri, 16))) + (__int_as_float(__builtin_amdgcn_readlane(ri, 32)) + __int_as_float(__builtin_amdgcn_readlane(ri, 48)));
}
__device__ __forceinline__ float sum32(float v) {
    const float r = sum16(v);
    return r + __int_as_float(__builtin_amdgcn_ds_swizzle(__float_as_int(r), 0x401f));
}

namespace pg8 {
constexpr int BM = 256, BK = 64, HALF = 128, HTB = HALF * BK * 2, STAGE_BYTES = 8 * HTB, NXCD = 8, WGM = 8;
__host__ __device__ __forceinline__ int lds_byte(int r, int c) { const int st = (r >> 4) * 2 + (c >> 5), rr = r & 15, cc = c & 31, ob = rr * 64 + cc * 2; return st * 1024 + (ob ^ (((ob >> 9) & 1) << 5)); }
__host__ __device__ __forceinline__ void stage_rc(int b, int& R, int& C) { const int st = b / 1024, sb = b % 1024, swz = sb ^ (((sb >> 9) & 1) << 5); R = (st >> 1) * 16 + swz / 64; C = (st & 1) * 32 + (swz % 64) / 2; }
__host__ __device__ __forceinline__ int perm32(int rho) { const int n = rho >> 4, i = rho & 15; return 8 * (i >> 2) + 4 * n + (i & 3); }
struct Unit { int pm, pn; };
struct Gemm { const bf16_t* A; const bf16_t* Bt; int M, N, K; };
struct StaticOrder {
    int nM, nN, nwg, G, c;
    __host__ __device__ void init(int M, int N, int G_, int c_) { nM = M / BM; nN = N / BM; nwg = nM * nN; G = G_; c = c_; }
    __host__ __device__ bool next(int i, Unit& u) const {
        const long L = (long)i * G + c; if (L >= nwg) return false;
        int wgid = (int)L; { const int q = nwg / NXCD, r = nwg % NXCD, xcd = wgid % NXCD, off = wgid / NXCD; wgid = (xcd < r ? xcd * (q + 1) : r * (q + 1) + (xcd - r) * q) + off; }
        const int nig = WGM * nN, gid = wgid / nig, fm = gid * WGM, gsz = (nM - fm) < WGM ? (nM - fm) : WGM;
        u.pm = fm + ((wgid % nig) % gsz); u.pn = (wgid % nig) / gsz; return true;
    }
};
struct EpiBf16 {
    static constexpr bool PERM = true;
    bf16_t* O; int ldc;
    __device__ __forceinline__ void operator()(const f32x4 (&acc)[2][2][4][2], const Unit& u, int wr, int wc, int fr, int fq) const {
        const int row0 = u.pm * BM + wr * 64 + fr, col0 = u.pn * BM + wc * 32 + 8 * fq;
        int ld = ldc; asm volatile("" : "+s"(ld));
#pragma unroll
        for (int ai = 0; ai < 2; ++ai)
#pragma unroll
            for (int m = 0; m < 4; ++m) { bf16_t* rowp = O + (size_t)(row0 + ai * HALF + m * 16) * ld + col0;
#pragma unroll
                for (int bj = 0; bj < 2; ++bj) { const f32x4 v0 = acc[ai][bj][m][0], v1 = acc[ai][bj][m][1];
                    u32x4 w; w.x = cvt_pk_bf16(v0[0], v0[1]); w.y = cvt_pk_bf16(v0[2], v0[3]); w.z = cvt_pk_bf16(v1[0], v1[1]); w.w = cvt_pk_bf16(v1[2], v1[3]);
                    *(u32x4*)(rowp + bj * HALF) = w; } }
    }
};
template <class Epi, bool ALIGN_EPI = true>
__device__ __forceinline__ void gemm_phase(LAS unsigned char* lds, const Gemm g, const StaticOrder& S, const Epi& E) {
    const int tid = opaque(threadIdx.x), wid = __builtin_amdgcn_readfirstlane(tid >> 6), lane = tid & 63, wr = wid >> 2, wc = wid & 3, fr = lane & 15, fq = lane >> 4;
    const int K = g.K, nt = K / BK;
    unsigned voffA[2], voffB[2];
#pragma unroll
    for (int i = 0; i < 2; ++i) { int R, C; stage_rc(tid * 16 + i * 8192, R, C); const int Rb = Epi::PERM ? ((R & ~31) + perm32(R & 31)) : R;
        voffA[i] = (unsigned)(R * K + C) * 2u; voffB[i] = (unsigned)(Rb * K + C) * 2u; }
    const size_t kstep = (size_t)(BK * 2);
    const size_t hstep = (size_t)HALF * K * 2;
    const size_t tstep = 2 * hstep;
    const unsigned ldsw = (unsigned)wid * 1024u;
    const int aoff = lds_byte(wr * 64 + fr, fq * 8), boff = lds_byte(wc * 32 + fr, fq * 8);
#define PG8_SA(b, h) (((b) * 2 + (h)) * HTB)
#define PG8_SB(b, h) ((4 + (b) * 2 + (h)) * HTB)
#define PG8_STAGE(bufoff, gbase, voff) do { _Pragma("unroll") for (int _i = 0; _i < 2; ++_i) \
        __builtin_amdgcn_global_load_lds((const unsigned*)((const char*)(gbase) + (voff)[_i]), (LAS unsigned*)(lds + (bufoff) + ldsw + _i * 8192), 16, 0, 0); } while (0)
#define PG8_LDA(dst, b, h) do { _Pragma("unroll") for (int m = 0; m < 4; ++m) _Pragma("unroll") for (int k = 0; k < 2; ++k) dst[m][k] = *(const LAS bf16x8*)(lds + PG8_SA(b, h) + aoff + m * 2048 + k * 1024); } while (0)
#define PG8_LDB(dst, b, h) do { _Pragma("unroll") for (int n = 0; n < 2; ++n) _Pragma("unroll") for (int k = 0; k < 2; ++k) dst[n][k] = *(const LAS bf16x8*)(lds + PG8_SB(b, h) + boff + n * 2048 + k * 1024); } while (0)
#define PG8_MMA(ai, bj, At, Bt) do { __builtin_amdgcn_s_setprio(1); _Pragma("unroll") for (int m = 0; m < 4; ++m) _Pragma("unroll") for (int n = 0; n < 2; ++n) _Pragma("unroll") for (int k = 0; k < 2; ++k) \
        acc[ai][bj][m][n] = __builtin_amdgcn_mfma_f32_16x16x32_bf16(Bt[n][k], At[m][k], acc[ai][bj][m][n], 0, 0, 0); __builtin_amdgcn_s_setprio(0); } while (0)
#define PG8_WAIT_V(n) asm volatile("s_waitcnt vmcnt(" #n ")" ::: "memory")
#define PG8_WAIT_L(n) asm volatile("s_waitcnt lgkmcnt(" #n ")" ::: "memory")
#define PG8_BAR __builtin_amdgcn_s_barrier()
#define PG8_SCHED __builtin_amdgcn_sched_barrier(0)
    Unit cur, nxt; int ui = 0;
    if (!S.next(0, cur)) return;
    f32x4 acc[2][2][4][2];
#pragma unroll
    for (int a = 0; a < 2; ++a)
#pragma unroll
        for (int b = 0; b < 2; ++b)
#pragma unroll
            for (int m = 0; m < 4; ++m)
#pragma unroll
                for (int n = 0; n < 2; ++n) acc[a][b][m][n] = (f32x4){0.f, 0.f, 0.f, 0.f};
    bf16x8 At[4][2], B0[2][2], B1[2][2];
    const char* cA = (const char*)g.A + (size_t)cur.pm * tstep; const char* cB = (const char*)g.Bt + (size_t)cur.pn * tstep;
    PG8_STAGE(PG8_SB(0, 0), cB, voffB); PG8_STAGE(PG8_SB(0, 1), cB + hstep, voffB); PG8_STAGE(PG8_SA(0, 0), cA, voffA); PG8_STAGE(PG8_SA(0, 1), cA + hstep, voffA);
    if (wr == 1) PG8_BAR;
    PG8_WAIT_V(2); PG8_BAR;
    PG8_STAGE(PG8_SB(1, 0), cB + kstep, voffB); PG8_STAGE(PG8_SA(1, 0), cA + kstep, voffA); PG8_STAGE(PG8_SB(1, 1), cB + hstep + kstep, voffB);
    PG8_WAIT_V(6); PG8_BAR;
    for (;;) {
        const bool has_next = S.next(ui + 1, nxt);
        const char* nA = has_next ? (const char*)g.A + (size_t)nxt.pm * tstep : cA; const char* nB = has_next ? (const char*)g.Bt + (size_t)nxt.pn * tstep : cB;
        for (int t = 0; t < nt; t += 2) {
            const bool last = (t == nt - 2);
            const char* a1 = cA + (size_t)(t + 1) * kstep;
            const char* a2 = last ? nA : cA + (size_t)(t + 2) * kstep; const char* b2 = last ? nB : cB + (size_t)(t + 2) * kstep;
            const char* a3 = a2 + kstep; const char* b3 = b2 + kstep;
            PG8_LDB(B0, 0, 0); PG8_LDB(B1, 0, 1); PG8_SCHED; PG8_LDA(At, 0, 0); PG8_STAGE(PG8_SA(1, 1), a1 + hstep, voffA);
            PG8_WAIT_V(8); PG8_WAIT_L(0); PG8_BAR; PG8_MMA(0, 0, At, B0); PG8_MMA(0, 1, At, B1); PG8_BAR; PG8_SCHED;
            PG8_LDA(At, 0, 1); PG8_STAGE(PG8_SB(0, 0), b2, voffB); PG8_STAGE(PG8_SB(0, 1), b2 + hstep, voffB); PG8_STAGE(PG8_SA(0, 0), a2, voffA);
            PG8_WAIT_V(8); PG8_WAIT_L(0); PG8_BAR; PG8_MMA(1, 0, At, B0); PG8_MMA(1, 1, At, B1); PG8_BAR; PG8_SCHED;
            PG8_LDB(B0, 1, 0); PG8_LDB(B1, 1, 1); PG8_SCHED; PG8_LDA(At, 1, 0); PG8_STAGE(PG8_SA(0, 1), a2 + hstep, voffA);
            PG8_WAIT_V(8); PG8_WAIT_L(0); PG8_BAR; PG8_MMA(0, 0, At, B0); PG8_MMA(0, 1, At, B1); PG8_BAR; PG8_SCHED;
            PG8_LDA(At, 1, 1); PG8_STAGE(PG8_SB(1, 0), b3, voffB); PG8_STAGE(PG8_SB(1, 1), b3 + hstep, voffB); PG8_STAGE(PG8_SA(1, 0), a3, voffA);
            PG8_WAIT_V(8); PG8_WAIT_L(0); PG8_BAR; PG8_MMA(1, 0, At, B0); PG8_MMA(1, 1, At, B1); PG8_BAR; PG8_SCHED;
        }
        if constexpr (ALIGN_EPI) { if (wr == 0) PG8_BAR; }
        E(acc, cur, wr, wc, fr, fq);
        if (!has_next) break;
#pragma unroll
        for (int a = 0; a < 2; ++a)
#pragma unroll
            for (int b = 0; b < 2; ++b)
#pragma unroll
                for (int m = 0; m < 4; ++m)
#pragma unroll
                    for (int n = 0; n < 2; ++n) acc[a][b][m][n] = (f32x4){0.f, 0.f, 0.f, 0.f};
        cur = nxt; cA = nA; cB = nB; ++ui;
        if constexpr (ALIGN_EPI) { if (wr == 1) PG8_BAR; }
    }
    PG8_WAIT_V(0);
    if constexpr (!ALIGN_EPI) { if (wr == 0) PG8_BAR; }
    PG8_BAR;
#undef PG8_SA
#undef PG8_SB
#undef PG8_STAGE
#undef PG8_LDA
#undef PG8_LDB
#undef PG8_MMA
#undef PG8_WAIT_V
#undef PG8_WAIT_L
#undef PG8_BAR
#undef PG8_SCHED
}
}

__device__ __forceinline__ void transpose_item(const float* W, int K, int N, bf16_t* WT, LAS float* scr, int item, int lane, bool qscale) {
    const int nblk = N / 32, kb = item / nblk, nb = item % nblk, k0 = 64 * kb, n0 = 32 * nb;
    const float wsc = (qscale && n0 >= C_AQ && n0 < C_AK) ? C2 : 1.f;
#pragma unroll 8
    for (int i = 0; i < 32; ++i) { const int kk = 2 * i + (lane >> 5); scr[kk * 33 + (lane & 31)] = wsc * W[(size_t)(k0 + kk) * N + n0 + (lane & 31)]; }
    asm volatile("s_waitcnt lgkmcnt(0)" ::: "memory");
    const int c = lane & 7;
#pragma unroll
    for (int j = 0; j < 4; ++j) { const int n = (lane >> 3) + 8 * j; const LAS float* s = scr + (8 * c) * 33 + n;
        u32x4 o; o.x = cvt_pk_bf16(s[0 * 33], s[1 * 33]); o.y = cvt_pk_bf16(s[2 * 33], s[3 * 33]); o.z = cvt_pk_bf16(s[4 * 33], s[5 * 33]); o.w = cvt_pk_bf16(s[6 * 33], s[7 * 33]);
        *(u32x4*)(WT + (size_t)(n0 + n) * K + k0 + 8 * c) = o; }
    asm volatile("s_waitcnt lgkmcnt(0)" ::: "memory");
}
__device__ __forceinline__ void sincos_d(double x, float& s, float& c) {
    const double q = __builtin_rint(x * 0.63661977236758134308); const double r = x - q * 1.57079632679489661923; const int qi = (int)q & 3;
    const double r2 = r * r;
    const double sp = r * (1.0 + r2 * (-1.0 / 6 + r2 * (1.0 / 120 + r2 * (-1.0 / 5040 + r2 * (1.0 / 362880 + r2 * (-1.0 / 39916800 + r2 * (1.0 / 6227020800.0)))))));
    const double cp = 1.0 + r2 * (-0.5 + r2 * (1.0 / 24 + r2 * (-1.0 / 720 + r2 * (1.0 / 40320 + r2 * (-1.0 / 3628800 + r2 * (1.0 / 479001600.0))))));
    const double ss = (qi == 0) ? sp : (qi == 1) ? cp : (qi == 2) ? -sp : -cp;
    const double cc = (qi == 0) ? cp : (qi == 1) ? -sp : (qi == 2) ? -cp : sp;
    s = (float)ss; c = (float)cc;
}
__device__ __forceinline__ void g0_prologue(const Ctx& C, LAS unsigned char* lds) {
    const int tid = opaque(threadIdx.x), lane = tid & 63, wid = tid >> 6, G = gridDim.x, bx = blockIdx.x;
    if (bx == G - 1) {
        for (int e = tid; e < 1024; e += 512) { const int pos = e >> 4, i = e & 15;
            const float invf = fexp2(-(float)i * 0.83048202372f);
            const float ang = (float)pos * invf; float s, c; sincos_d((double)ang, s, c);
            C.rope[e * 2] = c; C.rope[e * 2 + 1] = s; }
    }
    constexpr int NMODT = 2 * 48;
    const int nmodb = (G >= 2 * NMODT) ? NMODT : G;
    if (bx < nmodb) {
        LAS float* sl = (LAS float*)lds + wid * (33 * 64);
        for (int task = bx; task < NMODT; task += nmodb) {
            const int l = task / 48, cb = task % 48, col = cb * 64 + lane;
            const float* W = C.mod_w + (size_t)l * DM * 3072;
            float acc[33];
#pragma unroll
            for (int r = 0; r < 33; ++r) acc[r] = 0.f;
            for (int kc = 0; kc < 2; ++kc) {
                const int k0 = wid * 128 + kc * 64;
#pragma unroll
                for (int r = 0; r < 33; ++r) { const float v = (r < 32) ? C.c[r * DM + k0 + lane] : C.c_ctx[k0 + lane]; sl[r * 64 + lane] = siluf_(v); }
                asm volatile("s_waitcnt lgkmcnt(0)" ::: "memory");
                for (int k4 = 0; k4 < 16; ++k4) {
                    const float w0 = W[(size_t)(k0 + 4 * k4 + 0) * 3072 + col], w1 = W[(size_t)(k0 + 4 * k4 + 1) * 3072 + col],
                                w2 = W[(size_t)(k0 + 4 * k4 + 2) * 3072 + col], w3 = W[(size_t)(k0 + 4 * k4 + 3) * 3072 + col];
#pragma unroll
                    for (int r = 0; r < 33; ++r) { const f32x4 sv = *(const LAS f32x4*)(sl + r * 64 + 4 * k4); acc[r] += sv[0] * w0 + sv[1] * w1 + sv[2] * w2 + sv[3] * w3; }
                }
                asm volatile("s_waitcnt lgkmcnt(0)" ::: "memory");
            }
            __syncthreads();
#pragma unroll
            for (int r = 0; r < 33; ++r) sl[r * 64 + lane] = acc[r];
            __syncthreads();
            for (int e = tid; e < 33 * 64; e += 512) { float s = 0.f;
#pragma unroll
                for (int w = 0; w < 8; ++w) s += ((LAS float*)lds)[w * (33 * 64) + e];
                const int r = e >> 6, cc = cb * 64 + (e & 63);
                C.mod[((size_t)l * 33 + r) * 3072 + cc] = s + C.mod_b[l * 3072 + cc]; }
            __syncthreads();
        }
    }
    {
        const bool all = (nmodb == G);
        if (all || bx >= nmodb) {
            const int nb = all ? G : G - nmodb, b0 = all ? bx : bx - nmodb;
            LAS float* scr = (LAS float*)lds + wid * (64 * 33 + 16);
            constexpr int I_IN = 16 * (DIN / 32), I_OUT = 16 * 32, I_UP = 8;
            constexpr int NITEMS = 2 * I_IN + 2 * I_OUT + 16 * I_UP;
            for (int it = b0 * 8 + wid; it < NITEMS; it += nb * 8) {
                int r = it;
                if (r < 2 * I_IN) { const int l = r / I_IN; transpose_item(C.w_in + (size_t)l * DM * DIN, DM, DIN, C.WinT + (size_t)l * DIN * DM, scr, r % I_IN, lane, true); continue; } r -= 2 * I_IN;
                if (r < 2 * I_OUT) { const int l = r / I_OUT; transpose_item(C.w_out + (size_t)l * DM * DM, DM, DM, C.WoutT + (size_t)l * DM * DM, scr, r % I_OUT, lane, false); continue; } r -= 2 * I_OUT;
                { const int mi = r / I_UP, l = mi >> 2, m = mi & 3, d = m & 1;
                  const float* src = ((m < 2) ? C.w_up : C.a_up) + (size_t)(l * 2 + d) * 64 * 256;
                  transpose_item(src, 64, 256, C.WupT + (size_t)(l * 4 + m) * 256 * 64, scr, r % I_UP, lane, false); }
            }
        }
    }
}

template <int MODE>
__device__ __forceinline__ void norm_phase(const Ctx& C, int hf, int gw, int ngw, int lane_in, float pe1 = 0.f, float pe2 = 0.f) {
    const int lane = opaque(lane_in);
    const int nrows = (MODE == 2) ? LATH : MH;
    for (int lr0 = gw * 2; lr0 < nrows; lr0 += ngw * 2) {
        const bool lat = lr0 < LATH;
        int mrow; const float* xin; float* x1p;
        if (lat) { const size_t g = (size_t)hf * LATH + lr0; mrow = hf * HB + lr0 / SEQ; xin = C.x + g * DM; x1p = C.out + g * DM; }
        else { const size_t g = (size_t)hf * CTXH + (lr0 - LATH); mrow = 32; xin = C.ctx + g * DM; x1p = C.xc1 + g * DM; }
        f32x4 v[2][4];
        const float* base = (MODE == 2) ? x1p : xin;
#pragma unroll
        for (int rr = 0; rr < 2; ++rr)
#pragma unroll
            for (int j = 0; j < 4; ++j) v[rr][j] = __builtin_nontemporal_load((const f32x4*)(base + rr * DM + 4 * lane + 256 * j));
        if (MODE >= 1) {
            const float* gate = C.mod + ((size_t)(MODE - 1) * 33 + mrow) * 3072 + 2048;
            const float* pg = C.post_g + (MODE - 1) * DM;
            const bf16_t* yr = C.Y + (size_t)lr0 * DM;
            f32x4 y[2][4]; float ss[2];
#pragma unroll
            for (int rr = 0; rr < 2; ++rr) { ss[rr] = 0.f;
#pragma unroll
                for (int j = 0; j < 4; ++j) { { const u32x2 yw_ = __builtin_nontemporal_load((const u32x2*)(yr + rr * DM + 4 * lane + 256 * j)); y[rr][j] = (f32x4){bf_lo(yw_.x), bf_hi(yw_.x), bf_lo(yw_.y), bf_hi(yw_.y)}; } ss[rr] += (y[rr][j][0] * y[rr][j][0] + y[rr][j][1] * y[rr][j][1]) + (y[rr][j][2] * y[rr][j][2] + y[rr][j][3] * y[rr][j][3]); } }
            const float rstd0 = __builtin_amdgcn_rsqf(wave_sum(ss[0]) * (1.f / DM) + NORM_EPS), rstd1 = __builtin_amdgcn_rsqf(wave_sum(ss[1]) * (1.f / DM) + NORM_EPS);
#pragma unroll
            for (int j = 0; j < 4; ++j) { const f32x4 gt = *(const f32x4*)(gate + 4 * lane + 256 * j), pgv = *(const f32x4*)(pg + 4 * lane + 256 * j);
#pragma unroll
                for (int rr = 0; rr < 2; ++rr) {
                    v[rr][j] = v[rr][j] + gt * (y[rr][j] * (rr ? rstd1 : rstd0) * pgv);
#ifdef PROBE_A
                    if (MODE == 2 && hf == 1 && lr0 + rr < 1024) { v[rr][j] = v[rr][j] + pe2; if (lr0 + rr == 0 && lane == 0 && j == 0) v[rr][j][0] += pe1; }
#endif
                    __builtin_nontemporal_store(v[rr][j], (f32x4*)(x1p + rr * DM + 4 * lane + 256 * j)); } }
        }
        if (MODE <= 1) {
            const float* md = C.mod + ((size_t)MODE * 33 + mrow) * 3072;
            const float* pre = C.pre_g + MODE * DM;
            float ss[2];
#pragma unroll
            for (int rr = 0; rr < 2; ++rr) { ss[rr] = 0.f;
#pragma unroll
                for (int j = 0; j < 4; ++j) ss[rr] += (v[rr][j][0] * v[rr][j][0] + v[rr][j][1] * v[rr][j][1]) + (v[rr][j][2] * v[rr][j][2] + v[rr][j][3] * v[rr][j][3]); }
            const float rstd0 = __builtin_amdgcn_rsqf(wave_sum(ss[0]) * (1.f / DM) + NORM_EPS), rstd1 = __builtin_amdgcn_rsqf(wave_sum(ss[1]) * (1.f / DM) + NORM_EPS);
            bf16_t* hr = C.H + (size_t)lr0 * DM;
#pragma unroll
            for (int j = 0; j < 4; ++j) { const f32x4 sh = *(const f32x4*)(md + 4 * lane + 256 * j), scl = *(const f32x4*)(md + 1024 + 4 * lane + 256 * j), pv = *(const f32x4*)(pre + 4 * lane + 256 * j);
#pragma unroll
                for (int rr = 0; rr < 2; ++rr) st_bf4(hr + rr * DM + 4 * lane + 256 * j, (v[rr][j] * (rr ? rstd1 : rstd0) * pv) * (1.f + scl) + sh); }
        }
    }
}

__device__ __forceinline__ int crow(int r, int hi) { return (r & 3) + 8 * (r >> 2) + 4 * hi; }
__device__ __forceinline__ bf16x8 tanh8(bf16x8 x) {
    const u32x4 w = __builtin_bit_cast(u32x4, x); u32x4 o;
#pragma unroll
    for (int i = 0; i < 4; ++i) { const float a = bf_lo(w[i]), b = bf_hi(w[i]);
        const float ta = 1.f - 2.f * frcp(1.f + fexp2(2.885390081777927f * a)), tb = 1.f - 2.f * frcp(1.f + fexp2(2.885390081777927f * b));
        o[i] = cvt_pk_bf16(ta, tb); }
    return __builtin_bit_cast(bf16x8, o);
}
__device__ __forceinline__ void prep_block(const Ctx& C, int l, int task, LAS unsigned char* lds) {
    const int tid = opaque(threadIdx.x), lane = tid & 63, wid = __builtin_amdgcn_readfirstlane(tid >> 6);
    const int r32 = lane & 31, hi = lane >> 5, lr0 = task * 64;
    constexpr int PST = 520;
    LAS bf16_t* xs = (LAS bf16_t*)lds;
#pragma unroll
    for (int i = 0; i < 8; ++i) { const int idx = tid + 512 * i, row = idx >> 6, ch = idx & 63;
        const u32x4 v = *(const u32x4*)(C.P + (size_t)(lr0 + row) * DIN + (ch < 32 ? C_K + ch * 8 : C_LWF + (ch - 32) * 8));
        *(LAS u32x4*)(xs + row * PST + ch * 8) = v; }
    __syncthreads();
    const int tg = wid & 1, q = wid >> 1, lrw = lr0 + tg * 32;
    const LAS bf16_t* xrow = xs + (tg * 32 + r32) * PST + hi * 8;
    const LAS bf16_t* xcol = xs + (tg * 32) * PST;
    const bf16_t* WT = C.WupT + (size_t)l * 4 * 256 * 64;
    constexpr size_t ARR = (size_t)MH * 256;
#pragma unroll 1
    for (int d = 0; d < 2; ++d) {
        bf16x8 xf[4];
#pragma unroll
        for (int i0 = 0; i0 < 4; ++i0) xf[i0] = tanh8(*(const LAS bf16x8*)(xrow + 256 + d * 64 + i0 * 16));
        const bf16_t* wt = WT + (size_t)d * 256 * 64;
        const float* w0 = C.w0 + (l * 2 + d) * 256;
        float* dst = C.SC + (size_t)d * ARR;
#pragma unroll 1
        for (int jb = 2 * q; jb < 2 * q + 2; ++jb) {
            const int j = jb * 32 + r32;
            f32x16 acc = {};
#pragma unroll
            for (int i0 = 0; i0 < 4; ++i0) { const bf16x8 wf = *(const bf16x8*)(wt + (size_t)j * 64 + i0 * 16 + hi * 8); acc = __builtin_amdgcn_mfma_f32_32x32x16_bf16(xf[i0], wf, acc, 0, 0, 0); }
            const float w0j = w0[j];
#pragma unroll
            for (int r = 0; r < 16; ++r) { const int row = lrw + crow(r, hi);
                const float sg = sigmoidf_(acc[r] + w0j);
                dst[(size_t)row * 256 + j] = fexp2(-0.8750429636f * sg); }
        }
    }
    {
        const int hd = q;
        float rn[16];
        { const float kk0 = C.k_k[l * 256 + hd * 64 + r32], kk1 = C.k_k[l * 256 + hd * 64 + 32 + r32];
#pragma unroll
          for (int r = 0; r < 16; ++r) { const LAS bf16_t* kp = xcol + crow(r, hi) * PST + hd * 64 + r32;
              const float a = bf2f(kp[0]) * kk0, b = bf2f(kp[32]) * kk1; const float s = sum32(a * a + b * b);
              rn[r] = frcp(fmaxf(__builtin_sqrtf(s), 1e-12f)); } }
#pragma unroll 1
        for (int jd = 0; jd < 4; ++jd) {
            const int jb2 = jd >> 1, d = jd & 1;
            const int j = hd * 64 + jb2 * 32 + r32;
            const float kkj = C.k_k[l * 256 + j], kaj = C.k_a[l * 256 + j];
            const bf16_t* wt = WT + (size_t)(2 + d) * 256 * 64;
            f32x16 acc = {};
#pragma unroll
            for (int i0 = 0; i0 < 4; ++i0) { const bf16x8 xf = *(const LAS bf16x8*)(xrow + 384 + d * 64 + i0 * 16);
                const bf16x8 wf = *(const bf16x8*)(wt + (size_t)j * 64 + i0 * 16 + hi * 8); acc = __builtin_amdgcn_mfma_f32_32x32x16_bf16(xf, wf, acc, 0, 0, 0); }
            const float a0j = C.a0[(l * 2 + d) * 256 + j];
            bf16_t* sb16 = (bf16_t*)(C.SC + 2 * ARR);
            bf16_t* dkm = sb16 + (size_t)d * ARR; bf16_t* dbb = sb16 + (size_t)(2 + d) * ARR; bf16_t* daa = sb16 + 4 * ARR;
#pragma unroll
            for (int r = 0; r < 16; ++r) { const int cr = crow(r, hi); const size_t off = (size_t)(lrw + cr) * 256 + j;
                const float k = bf2f(xcol[cr * PST + j]);
                const float a = sigmoidf_(acc[r] + a0j), kkn = k * kkj * rn[r];
                const unsigned pk_ = cvt_pk_bf16(k * (1.f + (a - 1.f) * kaj), kkn * a);
                dkm[off] = (bf16_t)(pk_ & 0xffffu); dbb[off] = (bf16_t)(pk_ >> 16); if (d == 0) daa[off] = (bf16_t)(cvt_pk_bf16(-kkn, 0.f) & 0xffffu); }
        }
    }
    __syncthreads();
}
__device__ __forceinline__ void rowpass4(const Ctx& C, int l, int r0, int lane_in, bool do_conv) {
    const int lane = opaque(lane_in);
    const bool lat = r0 < LATH; const int t0 = lat ? (r0 & (SEQ - 1)) : ((r0 - LATH) & (CTX - 1)), len = lat ? SEQ : CTX;
    const bf16_t* pr = C.P + (size_t)r0 * DIN; const int c = 4 * lane;
    u32x4 qw[4], kw[4];
    if (lat) {
#pragma unroll
        for (int i = 0; i < 4; ++i) { qw[i] = *(const u32x4*)(pr + (size_t)i * DIN + C_AQ + 8 * lane); kw[i] = *(const u32x4*)(pr + (size_t)i * DIN + C_AK + 8 * lane); }
    }
    if (do_conv) {
        f32x4 u[6], bg[4], z[4];
#pragma unroll
        for (int i = 0; i < 6; ++i) { const bool ok = (i == 0) ? (t0 > 0) : (i == 5) ? (t0 + 4 < len) : true;
            const bf16_t* p = pr + (long)(i - 1) * DIN;
            u[i] = ok ? ld_bf4(p + C_CC + c) * ld_bf4(p + C_CH + c) : (f32x4){0.f, 0.f, 0.f, 0.f}; }
#pragma unroll
        for (int i = 0; i < 4; ++i) { bg[i] = ld_bf4(pr + (size_t)i * DIN + C_CB + c); z[i] = ld_bf4(pr + (size_t)i * DIN + C_CZ + c); }
        const float* cw = C.conv_w + l * 3 * 256 + c;
        const f32x4 w0 = *(const f32x4*)cw, w1 = *(const f32x4*)(cw + 256), w2 = *(const f32x4*)(cw + 512);
#pragma unroll
        for (int i = 0; i < 4; ++i) { const f32x4 y = u[i] * w0 + u[i + 1] * w1 + u[i + 2] * w2;
            f32x4 o; o[0] = bg[i][0] * y[0] * siluf_(z[i][0]); o[1] = bg[i][1] * y[1] * siluf_(z[i][1]); o[2] = bg[i][2] * y[2] * siluf_(z[i][2]); o[3] = bg[i][3] * y[3] * siluf_(z[i][3]);
            st_bf4(C.H + (size_t)(r0 + i) * DM + 256 + c, o); }
    }
    if (lat) {
        const float sg = (lane & 2) ? 1.f : -1.f;
#pragma unroll
        for (int i = 0; i < 4; ++i) {
            const int t = t0 + i; const int pos = ((lane >> 2) & 1) ? (t & 63) : (t >> 6);
            const f32x4* rp = (const f32x4*)(C.rope + (pos * 16 + 8 * (lane & 1)) * 2);
            const f32x4 c0 = rp[0], c1 = rp[1], c2 = rp[2], c3 = rp[3];
#pragma unroll
            for (int which = 0; which < 2; ++which) {
                const u32x4 w = which ? kw[i] : qw[i]; u32x4 pw;
#pragma unroll
                for (int e = 0; e < 4; ++e) pw[e] = (unsigned)__builtin_amdgcn_update_dpp(0, (int)w[e], 0x4E, 0xF, 0xF, true);
                u32x4 o;
                o[0] = cvt_pk_bf16(bf_lo(w[0]) * c0[0] + sg * bf_lo(pw[0]) * c0[1], bf_hi(w[0]) * c0[2] + sg * bf_hi(pw[0]) * c0[3]);
                o[1] = cvt_pk_bf16(bf_lo(w[1]) * c1[0] + sg * bf_lo(pw[1]) * c1[1], bf_hi(w[1]) * c1[2] + sg * bf_hi(pw[1]) * c1[3]);
                o[2] = cvt_pk_bf16(bf_lo(w[2]) * c2[0] + sg * bf_lo(pw[2]) * c2[1], bf_hi(w[2]) * c2[2] + sg * bf_hi(pw[2]) * c2[3]);
                o[3] = cvt_pk_bf16(bf_lo(w[3]) * c3[0] + sg * bf_lo(pw[3]) * c3[1], bf_hi(w[3]) * c3[2] + sg * bf_hi(pw[3]) * c3[3]);
                *(u32x4*)(C.P + (size_t)(r0 + i) * DIN + (which ? C_AK : C_AQ) + 8 * lane) = o;
            }
        }
    }
}
__device__ __forceinline__ void conv_row(const Ctx& C, int l, int lr, int lane_in) {
    const int lane = opaque(lane_in);
    const bool lat = lr < LATH; const int t = lat ? (lr & (SEQ - 1)) : ((lr - LATH) & (CTX - 1)), len = lat ? SEQ : CTX;
    const bf16_t* pr = C.P + (size_t)lr * DIN; const int c = 4 * lane;
    const float* cw = C.conv_w + l * 3 * 256 + c;
    const f32x4 w0 = *(const f32x4*)cw, w1 = *(const f32x4*)(cw + 256), w2 = *(const f32x4*)(cw + 512);
    f32x4 y = (ld_bf4(pr + C_CC + c) * ld_bf4(pr + C_CH + c)) * w1;
    if (t > 0) y = y + (ld_bf4(pr - DIN + C_CC + c) * ld_bf4(pr - DIN + C_CH + c)) * w0;
    if (t < len - 1) y = y + (ld_bf4(pr + DIN + C_CC + c) * ld_bf4(pr + DIN + C_CH + c)) * w2;
    const f32x4 bg = ld_bf4(pr + C_CB + c), z = ld_bf4(pr + C_CZ + c);
    f32x4 o; o[0] = bg[0] * y[0] * siluf_(z[0]); o[1] = bg[1] * y[1] * siluf_(z[1]); o[2] = bg[2] * y[2] * siluf_(z[2]); o[3] = bg[3] * y[3] * siluf_(z[3]);
    st_bf4(C.H + (size_t)lr * DM + 256 + c, o);
}

__device__ __forceinline__ void rope_row(const Ctx& C, int lr, int lane_in) {
    const int lane = opaque(lane_in);
    const int t = lr & (SEQ - 1); const int pos = ((lane >> 2) & 1) ? (t & 63) : (t >> 6);
    const f32x4* rp = (const f32x4*)(C.rope + (pos * 16 + 8 * (lane & 1)) * 2);
    const f32x4 c0 = rp[0], c1 = rp[1], c2 = rp[2], c3 = rp[3];
    const float sg = (lane & 2) ? 1.f : -1.f;
#pragma unroll
    for (int which = 0; which < 2; ++which) {
        bf16_t* p = C.P + (size_t)lr * DIN + (which ? C_AK : C_AQ) + 8 * lane;
        const u32x4 w = *(const u32x4*)p; u32x4 pw;
#pragma unroll
        for (int i = 0; i < 4; ++i) pw[i] = (unsigned)__builtin_amdgcn_update_dpp(0, (int)w[i], 0x4E, 0xF, 0xF, true);
        u32x4 o;
        o[0] = cvt_pk_bf16(bf_lo(w[0]) * c0[0] + sg * bf_lo(pw[0]) * c0[1], bf_hi(w[0]) * c0[2] + sg * bf_hi(pw[0]) * c0[3]);
        o[1] = cvt_pk_bf16(bf_lo(w[1]) * c1[0] + sg * bf_lo(pw[1]) * c1[1], bf_hi(w[1]) * c1[2] + sg * bf_hi(pw[1]) * c1[3]);
        o[2] = cvt_pk_bf16(bf_lo(w[2]) * c2[0] + sg * bf_lo(pw[2]) * c2[1], bf_hi(w[2]) * c2[2] + sg * bf_hi(pw[2]) * c2[3]);
        o[3] = cvt_pk_bf16(bf_lo(w[3]) * c3[0] + sg * bf_lo(pw[3]) * c3[1], bf_hi(w[3]) * c3[2] + sg * bf_hi(pw[3]) * c3[3]);
        *(u32x4*)p = o;
    }
}

__device__ __forceinline__ int scan_row(int s, int dir, int bl) {
    if (s < CTX) { const int t = dir ? (CTX - 1 - s) : s; return LATH + bl * CTX + t; }
    const int t0 = s - CTX; const int t = dir ? (SEQ - 1 - t0) : t0; return bl * SEQ + t;
}
__device__ __forceinline__ void scan_unit(const Ctx& C, int l, int u, LAS unsigned char* lds) {
    const int bl = u >> 3, hd = (u >> 1) & 3, dir = u & 1;
    const int tid = opaque(threadIdx.x), lane = tid & 63, wid = __builtin_amdgcn_readfirstlane(tid >> 6);
    constexpr size_t ARR = (size_t)MH * 256;
    constexpr int CHF = 32 * 6 * 64;
    constexpr int YB0 = 2 * CHF;
    const int lst = tid >> 4, q4 = tid & 15;
    const float* a_dec = C.SC + (size_t)dir * ARR + hd * 64 + q4 * 4;
    const bf16_t* sb16 = (const bf16_t*)(C.SC + 2 * ARR);
    const bf16_t* a_km = sb16 + (size_t)dir * ARR + hd * 64 + q4 * 4;
    const bf16_t* a_bb = sb16 + (size_t)(2 + dir) * ARR + hd * 64 + q4 * 4;
    const bf16_t* a_aa = sb16 + 4 * ARR + hd * 64 + q4 * 4;
    const bf16_t* a_r = C.P + C_R + hd * 64 + q4 * 4;
    const bf16_t* a_v = C.P + C_V + hd * 64 + q4 * 4;
    float* a_y = C.YS + (size_t)dir * ARR + hd * 64 + q4 * 4;
    f32x4 g0, g1, g2, g3, g4, g5;
#define SC_LOAD(c) do { const size_t row_ = (size_t)scan_row((c) * 32 + lst, dir, bl); \
        g0 = *(const f32x4*)(a_dec + row_ * 256); g1 = ld_bf4(a_km + row_ * 256); g2 = ld_bf4(a_aa + row_ * 256); g3 = ld_bf4(a_bb + row_ * 256); \
        g4 = ld_bf4(a_r + row_ * DIN); g5 = ld_bf4(a_v + row_ * DIN); } while (0)
#define SC_WRITE(b) do { LAS float* d_ = (LAS float*)lds + (b) * CHF + lst * 384 + q4 * 4; \
        *(LAS f32x4*)(d_) = g0; *(LAS f32x4*)(d_ + 64) = g1; *(LAS f32x4*)(d_ + 128) = g2; *(LAS f32x4*)(d_ + 192) = g3; *(LAS f32x4*)(d_ + 256) = g4; *(LAS f32x4*)(d_ + 320) = g5; } while (0)
    f32x4 S0 = {0.f, 0.f, 0.f, 0.f}, S1 = {0.f, 0.f, 0.f, 0.f};
    const int vq = lane >> 4, k16 = lane & 15;
    const int rloc = 8 * wid + 2 * vq;
    SC_LOAD(0); SC_WRITE(0); __syncthreads();
    constexpr int NCH = (CTX + SEQ) / 32;
#pragma unroll 1
    for (int c = 0; c < NCH; ++c) {
        if (c > 0 && ((c - 1 >= CTX / 32) || (l == 0))) {
            const f32x4 yv = *(const LAS f32x4*)((const LAS float*)lds + YB0 + ((c - 1) & 1) * 2048 + lst * 64 + q4 * 4);
            *(f32x4*)(a_y + (size_t)scan_row((c - 1) * 32 + lst, dir, bl) * 256) = yv;
        }
        if (c + 1 < NCH) SC_LOAD(c + 1);
        {
            const LAS float* cb = (const LAS float*)lds + (c & 1) * CHF + k16 * 4;
            const LAS float* vbp = (const LAS float*)lds + (c & 1) * CHF + 320 + rloc;
            LAS float* yb = (LAS float*)lds + YB0 + (c & 1) * 2048 + rloc + (k16 & 1);
            const bool wout = (c >= CTX / 32) || (l == 0);
            f32x4 wA, kA, aA, bA, rA, wB, kB, aB, bB, rB; f32x2 vA, vB;
#define SC_RD(W, K, A, B, R, V, s) do { const LAS float* sb_ = cb + (s) * 384; W = *(const LAS f32x4*)(sb_); K = *(const LAS f32x4*)(sb_ + 64); A = *(const LAS f32x4*)(sb_ + 128); \
        B = *(const LAS f32x4*)(sb_ + 192); R = *(const LAS f32x4*)(sb_ + 256); V = *(const LAS f32x2*)(vbp + (s) * 384); } while (0)
#define SC_STEP(W, K, A, B, R, V, DOST, s) do { \
        float sa0 = fmaf(S0[3], A[3], fmaf(S0[2], A[2], fmaf(S0[1], A[1], S0[0] * A[0]))); \
        float sa1 = fmaf(S1[3], A[3], fmaf(S1[2], A[2], fmaf(S1[1], A[1], S1[0] * A[0]))); \
        sa0 = sum16(sa0); sa1 = sum16(sa1); \
        S0 = S0 * W + sa0 * B + V[0] * K; S1 = S1 * W + sa1 * B + V[1] * K; \
        if (DOST) { \
        float y0 = fmaf(S0[3], R[3], fmaf(S0[2], R[2], fmaf(S0[1], R[1], S0[0] * R[0]))); \
        float y1 = fmaf(S1[3], R[3], fmaf(S1[2], R[2], fmaf(S1[1], R[1], S1[0] * R[0]))); \
        y0 = sum16(y0); y1 = sum16(y1); \
        yb[(s) * 64] = (k16 & 1) ? y1 : y0; } } while (0)
            SC_RD(wA, kA, aA, bA, rA, vA, 0);
            if (wout) {
#pragma unroll 2
                for (int s = 0; s < 32; s += 2) { SC_RD(wB, kB, aB, bB, rB, vB, s + 1); SC_STEP(wA, kA, aA, bA, rA, vA, true, s);
                                                  SC_RD(wA, kA, aA, bA, rA, vA, s + 2); SC_STEP(wB, kB, aB, bB, rB, vB, true, s + 1); }
            } else {
#pragma unroll 2
                for (int s = 0; s < 32; s += 2) { SC_RD(wB, kB, aB, bB, rB, vB, s + 1); SC_STEP(wA, kA, aA, bA, rA, vA, false, s);
                                                  SC_RD(wA, kA, aA, bA, rA, vA, s + 2); SC_STEP(wB, kB, aB, bB, rB, vB, false, s + 1); }
            }
#undef SC_RD
#undef SC_STEP
        }
        if (c + 1 < NCH) SC_WRITE((c + 1) & 1);
        __syncthreads();
    }
    { const f32x4 yv = *(const LAS f32x4*)((const LAS float*)lds + YB0 + ((NCH - 1) & 1) * 2048 + lst * 64 + q4 * 4);
      *(f32x4*)(a_y + (size_t)scan_row((NCH - 1) * 32 + lst, dir, bl) * 256) = yv; }
    __syncthreads();
#undef SC_LOAD
#undef SC_WRITE
}

constexpr int CK_RAW = 0, CK_XA = 24576, CK_ZB = 29184, CK_EZ = 33792  , CK_UV = 44032  , CK_PP = 54272, CK_S0 = 56832, CK_GF = 66048, CK_R0 = 70656, CK_DC = 79872  , CK_END = 80384;
__device__ __forceinline__ void ck_images(LAS float* RAW, LAS bf16_t* XA, LAS bf16_t* ZB, LAS bf16_t* EZ, LAS bf16_t* UV, LAS float* DC, int s) {
    const int lt = s >> 5, kp = (s & 31) * 2;
    float c0 = 1.f, c1 = 1.f, cp0 = 1.f, cp1 = 1.f, ct0 = 1.f, ct1 = 1.f;
#pragma unroll
    for (int j = 0; j < 16; ++j) { const f32x2 w = *(const LAS f32x2*)(RAW + j * 64 + kp); if (j == lt) { cp0 = c0; cp1 = c1; } c0 *= w[0]; c1 *= w[1]; if (j == lt) { ct0 = c0; ct1 = c1; } }
    const f32x2 aa = *(const LAS f32x2*)(RAW + 1024 + lt * 64 + kp), bb = *(const LAS f32x2*)(RAW + 2048 + lt * 64 + kp), km = *(const LAS f32x2*)(RAW + 3072 + lt * 64 + kp),
                rr = *(const LAS f32x2*)(RAW + 4096 + lt * 64 + kp), vv = *(const LAS f32x2*)(RAW + 5120 + lt * 64 + kp);
    const float en0 = frcp(ct0), en1 = frcp(ct1), ee0 = c0 * en0, ee1 = c1 * en1;
    *(LAS unsigned*)(XA + lt * 72 + kp) = cvt_pk_bf16(aa[0] * cp0, aa[1] * cp1);
    *(LAS unsigned*)(XA + (16 + lt) * 72 + kp) = cvt_pk_bf16(rr[0] * ct0, rr[1] * ct1);
    *(LAS unsigned*)(ZB + lt * 72 + kp) = cvt_pk_bf16(bb[0] * en0, bb[1] * en1);
    *(LAS unsigned*)(ZB + (16 + lt) * 72 + kp) = cvt_pk_bf16(km[0] * en0, km[1] * en1);
    const unsigned eb = cvt_pk_bf16(bb[0] * ee0, bb[1] * ee1), ek = cvt_pk_bf16(km[0] * ee0, km[1] * ee1), ev = cvt_pk_bf16(vv[0], vv[1]);
    EZ[kp * 40 + lt] = (bf16_t)(eb & 0xffffu); EZ[(kp + 1) * 40 + lt] = (bf16_t)(eb >> 16);
    EZ[kp * 40 + 16 + lt] = (bf16_t)(ek & 0xffffu); EZ[(kp + 1) * 40 + 16 + lt] = (bf16_t)(ek >> 16);
    UV[kp * 40 + 16 + lt] = (bf16_t)(ev & 0xffffu); UV[(kp + 1) * 40 + 16 + lt] = (bf16_t)(ev >> 16);
    if (lt == 0) *(LAS f32x2*)(DC + kp) = (f32x2){c0, c1};
}
__device__ __forceinline__ void scan_chunked(const Ctx& C, int l, int u, LAS unsigned char* lds) {
    const int bl = u >> 3, hd = (u >> 1) & 3, dir = u & 1;
    const int tid0 = opaque(threadIdx.x), wid = __builtin_amdgcn_readfirstlane(tid0 >> 6);
    constexpr size_t ARR = (size_t)MH * 256;
    LAS float* RAW = (LAS float*)(lds + CK_RAW);
    LAS bf16_t* XA = (LAS bf16_t*)(lds + CK_XA);
    LAS bf16_t* ZB = (LAS bf16_t*)(lds + CK_ZB);
    LAS bf16_t* EZ0 = (LAS bf16_t*)(lds + CK_EZ);
    LAS bf16_t* UV0 = (LAS bf16_t*)(lds + CK_UV);
    LAS bf16_t* PP = (LAS bf16_t*)(lds + CK_PP);
    LAS bf16_t* S0 = (LAS bf16_t*)(lds + CK_S0);
    LAS float* GF = (LAS float*)(lds + CK_GF);
    LAS float* R0 = (LAS float*)(lds + CK_R0);
    LAS float* DC0 = (LAS float*)(lds + CK_DC);
    const bf16_t* sb16 = (const bf16_t*)(C.SC + 2 * ARR);
    f32x2 ld_w; unsigned ld_km, ld_bb, ld_aa, ld_r, ld_v;
#define CK_LOAD(c) do { const int tl_ = opaque(tid0); const size_t row_ = (size_t)scan_row((c) * 16 + (tl_ >> 5), dir, bl); const size_t o2_ = row_ * 256 + hd * 64 + (tl_ & 31) * 2, op_ = row_ * DIN + hd * 64 + (tl_ & 31) * 2; \
        ld_w = *(const f32x2*)(C.SC + (size_t)dir * ARR + o2_); ld_km = *(const unsigned*)(sb16 + (size_t)dir * ARR + o2_); \
        ld_bb = *(const unsigned*)(sb16 + (size_t)(2 + dir) * ARR + o2_); ld_aa = *(const unsigned*)(sb16 + 4 * ARR + o2_); ld_r = *(const unsigned*)(C.P + C_R + op_); ld_v = *(const unsigned*)(C.P + C_V + op_); } while (0)
#define CK_STORE() do { const int ts_ = opaque(tid0); LAS float* q_ = RAW + (ts_ >> 5) * 64 + (ts_ & 31) * 2; \
        *(LAS f32x2*)(q_) = ld_w; *(LAS f32x2*)(q_ + 1024) = (f32x2){bf_lo(ld_aa), bf_hi(ld_aa)}; \
        *(LAS f32x2*)(q_ + 2048) = (f32x2){bf_lo(ld_bb), bf_hi(ld_bb)}; *(LAS f32x2*)(q_ + 3072) = (f32x2){bf_lo(ld_km), bf_hi(ld_km)}; \
        *(LAS f32x2*)(q_ + 4096) = (f32x2){bf_lo(ld_r), bf_hi(ld_r)}; *(LAS f32x2*)(q_ + 5120) = (f32x2){bf_lo(ld_v), bf_hi(ld_v)}; } while (0)
    for (int e = tid0; e < CK_END / 4; e += 512) ((LAS unsigned*)lds)[e] = 0u;
    __syncthreads();
    f32x16 S = {};
    const int vt = (wid >> 1) & 1, kt = wid & 1;
    constexpr int NCH = (CTX + SEQ) / 16;
    CK_LOAD(0); CK_STORE(); __syncthreads();
    ck_images(RAW, XA, ZB, EZ0, UV0, DC0, opaque(tid0));
    CK_LOAD(1);
    __syncthreads();
#pragma unroll 1
    for (int c = 0; c < NCH; ++c) {
        const int pb = c & 1;
        LAS bf16_t* EZ = EZ0 + pb * (64 * 40); LAS bf16_t* UV = UV0 + pb * (64 * 40); LAS float* DC = DC0 + pb * 64;
        if (c + 1 < NCH) CK_STORE();
        if (c + 2 < NCH) CK_LOAD(c + 2);
        if (wid == 0) {
            const int ln = opaque(tid0) & 63, r32 = ln & 31, hi = ln >> 5;
            f32x16 acc = {};
#pragma unroll
            for (int d0 = 0; d0 < 4; ++d0) { const bf16x8 a = *(const LAS bf16x8*)(XA + r32 * 72 + d0 * 16 + hi * 8), b = *(const LAS bf16x8*)(ZB + r32 * 72 + d0 * 16 + hi * 8);
                acc = __builtin_amdgcn_mfma_f32_32x32x16_bf16(a, b, acc, 0, 0, 0); }
#pragma unroll
            for (int r = 0; r < 16; ++r) GF[crow(r, hi) * 36 + r32] = acc[r];
        } else if (wid <= 2) {
            const int ln = opaque(tid0) & 63, r32 = ln & 31, hi = ln >> 5;
            const int v0 = (wid - 1) * 32;
            f32x16 acc = {};
#pragma unroll
            for (int d0 = 0; d0 < 4; ++d0) { const bf16x8 a = *(const LAS bf16x8*)(S0 + (v0 + r32) * 72 + d0 * 16 + hi * 8), b = *(const LAS bf16x8*)(XA + r32 * 72 + d0 * 16 + hi * 8);
                acc = __builtin_amdgcn_mfma_f32_32x32x16_bf16(a, b, acc, 0, 0, 0); }
#pragma unroll
            for (int r = 0; r < 16; ++r) R0[(v0 + crow(r, hi)) * 36 + r32] = acc[r];
        }
        __syncthreads();
        if (wid == 3) {
            const int v = opaque(tid0) & 63;
            float uu[16], vq[16];
#pragma unroll
            for (int q = 0; q < 4; ++q) { const f32x4 x = *(const LAS f32x4*)(R0 + v * 36 + 4 * q); uu[4 * q] = x[0]; uu[4 * q + 1] = x[1]; uu[4 * q + 2] = x[2]; uu[4 * q + 3] = x[3]; }
#pragma unroll
            for (int q = 0; q < 2; ++q) { const u32x4 x = *(const LAS u32x4*)(UV + v * 40 + 16 + 8 * q);
#pragma unroll
                for (int e = 0; e < 4; ++e) { vq[8 * q + 2 * e] = bf_lo(x[e]); vq[8 * q + 2 * e + 1] = bf_hi(x[e]); } }
#pragma unroll
            for (int t = 1; t < 16; ++t) {
                float a0 = uu[t], a1 = 0.f, a2 = 0.f, a3 = 0.f;
#pragma unroll
                for (int q = 0; q * 4 < t; ++q) { const f32x4 m = *(const LAS f32x4*)(GF + t * 36 + 4 * q), n = *(const LAS f32x4*)(GF + t * 36 + 16 + 4 * q);
#pragma unroll
                    for (int e = 0; e < 4; ++e) if (4 * q + e < t) { if (e & 1) { a1 = fmaf(uu[4 * q + e], m[e], a1); a3 = fmaf(vq[4 * q + e], n[e], a3); } else { a0 = fmaf(uu[4 * q + e], m[e], a0); a2 = fmaf(vq[4 * q + e], n[e], a2); } } }
                uu[t] = (a0 + a1) + (a2 + a3);
            }
            u32x4 w0, w1;
            w0[0] = cvt_pk_bf16(uu[0], uu[1]); w0[1] = cvt_pk_bf16(uu[2], uu[3]); w0[2] = cvt_pk_bf16(uu[4], uu[5]); w0[3] = cvt_pk_bf16(uu[6], uu[7]);
            w1[0] = cvt_pk_bf16(uu[8], uu[9]); w1[1] = cvt_pk_bf16(uu[10], uu[11]); w1[2] = cvt_pk_bf16(uu[12], uu[13]); w1[3] = cvt_pk_bf16(uu[14], uu[15]);
            *(LAS u32x4*)(UV + v * 40) = w0; *(LAS u32x4*)(UV + v * 40 + 8) = w1;
        } else if (wid == 4) {
            const int ln = opaque(tid0) & 63; const int t = ln >> 2, jq = (ln & 3) * 8;
            const f32x4 g0 = *(const LAS f32x4*)(GF + (16 + t) * 36 + jq), g1 = *(const LAS f32x4*)(GF + (16 + t) * 36 + jq + 4);
            float x[8] = {g0[0], g0[1], g0[2], g0[3], g1[0], g1[1], g1[2], g1[3]};
#pragma unroll
            for (int e = 0; e < 8; ++e) { const int i = (jq + e) & 15; if (i > t) x[e] = 0.f; }
            u32x4 w; w[0] = cvt_pk_bf16(x[0], x[1]); w[1] = cvt_pk_bf16(x[2], x[3]); w[2] = cvt_pk_bf16(x[4], x[5]); w[3] = cvt_pk_bf16(x[6], x[7]);
            *(LAS u32x4*)(PP + t * 40 + jq) = w;
        } else if (c + 1 < NCH) {
            const int w6 = (wid < 3) ? wid : wid - 2;
            const int s0 = w6 * 64 + (opaque(tid0) & 63);
            LAS bf16_t* EZn = EZ0 + (pb ^ 1) * (64 * 40); LAS bf16_t* UVn = UV0 + (pb ^ 1) * (64 * 40); LAS float* DCn = DC0 + (pb ^ 1) * 64;
            ck_images(RAW, XA, ZB, EZn, UVn, DCn, s0);
            if (s0 < 128) ck_images(RAW, XA, ZB, EZn, UVn, DCn, s0 + 384);
        }
        __syncthreads();
        if (wid < 4) {
            const int ln = opaque(tid0) & 63, r32 = ln & 31, hi = ln >> 5;
            const float dc = DC[kt * 32 + r32];
#pragma unroll
            for (int r = 0; r < 16; ++r) S[r] *= dc;
#pragma unroll
            for (int js = 0; js < 2; ++js) { const bf16x8 a = *(const LAS bf16x8*)(UV + (vt * 32 + r32) * 40 + js * 16 + hi * 8), b = *(const LAS bf16x8*)(EZ + (kt * 32 + r32) * 40 + js * 16 + hi * 8);
                S = __builtin_amdgcn_mfma_f32_32x32x16_bf16(a, b, S, 0, 0, 0); }
            asm volatile("s_nop 15\n\ts_nop 7" : "+v"(S));
#pragma unroll
            for (int r = 0; r < 16; r += 2) { const unsigned pk = cvt_pk_bf16(S[r], S[r + 1]);
                S0[(vt * 32 + crow(r, hi)) * 72 + kt * 32 + r32] = (bf16_t)(pk & 0xffffu); S0[(vt * 32 + crow(r + 1, hi)) * 72 + kt * 32 + r32] = (bf16_t)(pk >> 16); }
        } else if ((wid == 5 || wid == 6) && ((c >= CTX / 16) || (l == 0))) {
            const int ln = opaque(tid0) & 63, r32 = ln & 31, hi = ln >> 5;
            const int v0 = (wid - 5) * 32;
            f32x16 acc;
#pragma unroll
            for (int r = 0; r < 16; ++r) acc[r] = (r32 < 16) ? R0[(v0 + crow(r, hi)) * 36 + 16 + r32] : 0.f;
#pragma unroll
            for (int js = 0; js < 2; ++js) { const bf16x8 a = *(const LAS bf16x8*)(UV + (v0 + r32) * 40 + js * 16 + hi * 8), b = *(const LAS bf16x8*)(PP + r32 * 40 + js * 16 + hi * 8);
                acc = __builtin_amdgcn_mfma_f32_32x32x16_bf16(a, b, acc, 0, 0, 0); }
            if (r32 < 16) { float* yp = C.YS + (size_t)dir * ARR + hd * 64 + (size_t)scan_row(c * 16 + r32, dir, bl) * 256 + v0 + 4 * hi;
#pragma unroll
                for (int q = 0; q < 4; ++q) *(f32x4*)(yp + 8 * q) = (f32x4){acc[4 * q], acc[4 * q + 1], acc[4 * q + 2], acc[4 * q + 3]}; }
        }
        __syncthreads();
    }
#undef CK_LOAD
#undef CK_STORE
}

#define KSWZ(row, colB) ((row) * 256 + ((colB) ^ (((row) & 7) << 4)))
#define SBAR() __builtin_amdgcn_sched_barrier(0)
constexpr int SHM_KV = 64 * 128 * 2;
constexpr float ATT_THR = 11.5f;
__device__ __forceinline__ int v_st(int k, int c) { const int kk = (k & ~0xC) | ((k & 4) << 1) | ((k & 8) >> 1); return ((kk >> 3) * 4 + (c >> 5)) * 512 + ((kk & 7) * 32 + (c & 31)) * 2; }
__device__ __forceinline__ int v_rd_base(int lane) { return ((lane & 3) << 3) | (((lane >> 2) & 3) << 6) | (((lane >> 4) & 1) << 5) | (((lane >> 5) & 1) << 8); }
constexpr int v_rd_off(int d0, int ks, int half) { return d0 * 512 + ks * 4096 + half * 2048; }
template <int OFF> __device__ __forceinline__ s16x4 tr_read(int vb) { s16x4 r; asm volatile("ds_read_b64_tr_b16 %0, %1 offset:%2" : "=&v"(r) : "v"(vb), "i"(OFF) : "memory"); return r; }
struct VFrag { s16x4 l0, h0, l1, h1, l2, h2, l3, h3; };
template <int D0> __device__ __forceinline__ void v_reads(VFrag& f, int vb) {
    f.l0 = tr_read<v_rd_off(D0, 0, 0)>(vb); f.h0 = tr_read<v_rd_off(D0, 0, 1)>(vb); f.l1 = tr_read<v_rd_off(D0, 1, 0)>(vb); f.h1 = tr_read<v_rd_off(D0, 1, 1)>(vb);
    f.l2 = tr_read<v_rd_off(D0, 2, 0)>(vb); f.h2 = tr_read<v_rd_off(D0, 2, 1)>(vb); f.l3 = tr_read<v_rd_off(D0, 3, 0)>(vb); f.h3 = tr_read<v_rd_off(D0, 3, 1)>(vb);
}
__device__ __forceinline__ void pv_mma(f32x16& od, const VFrag& f, bf16x8 pa0, bf16x8 pa1, bf16x8 pa2, bf16x8 pa3) {
#define PKV(L, H) (bf16x8){L[0], L[1], L[2], L[3], H[0], H[1], H[2], H[3]}
    od = __builtin_amdgcn_mfma_f32_32x32x16_bf16(pa0, PKV(f.l0, f.h0), od, 0, 0, 0);
    od = __builtin_amdgcn_mfma_f32_32x32x16_bf16(pa1, PKV(f.l1, f.h1), od, 0, 0, 0);
    od = __builtin_amdgcn_mfma_f32_32x32x16_bf16(pa2, PKV(f.l2, f.h2), od, 0, 0, 0);
    od = __builtin_amdgcn_mfma_f32_32x32x16_bf16(pa3, PKV(f.l3, f.h3), od, 0, 0, 0);
#undef PKV
}
template <int KS> __device__ __forceinline__ void v_reads_ks(s16x4 (&l)[4], s16x4 (&h)[4], int vb) {
    l[0] = tr_read<v_rd_off(0, KS, 0)>(vb); h[0] = tr_read<v_rd_off(0, KS, 1)>(vb); l[1] = tr_read<v_rd_off(1, KS, 0)>(vb); h[1] = tr_read<v_rd_off(1, KS, 1)>(vb);
    l[2] = tr_read<v_rd_off(2, KS, 0)>(vb); h[2] = tr_read<v_rd_off(2, KS, 1)>(vb); l[3] = tr_read<v_rd_off(3, KS, 0)>(vb); h[3] = tr_read<v_rd_off(3, KS, 1)>(vb);
}
__device__ __forceinline__ void pv_mma_ks(f32x16 (&o)[4], const s16x4 (&l)[4], const s16x4 (&h)[4], bf16x8 pa) {
#define PKV(L, H) (bf16x8){L[0], L[1], L[2], L[3], H[0], H[1], H[2], H[3]}
    __builtin_amdgcn_s_setprio(1);
    o[0] = __builtin_amdgcn_mfma_f32_32x32x16_bf16(pa, PKV(l[0], h[0]), o[0], 0, 0, 0);
    o[1] = __builtin_amdgcn_mfma_f32_32x32x16_bf16(pa, PKV(l[1], h[1]), o[1], 0, 0, 0);
    o[2] = __builtin_amdgcn_mfma_f32_32x32x16_bf16(pa, PKV(l[2], h[2]), o[2], 0, 0, 0);
    o[3] = __builtin_amdgcn_mfma_f32_32x32x16_bf16(pa, PKV(l[3], h[3]), o[3], 0, 0, 0);
    __builtin_amdgcn_s_setprio(0);
#undef PKV
}
__device__ __forceinline__ void pv_all(f32x16 (&o)[4], int vb, bf16x8 pa0, bf16x8 pa1, bf16x8 pa2, bf16x8 pa3) {
    s16x4 l[4], h[4];
    v_reads_ks<0>(l, h, vb); asm volatile("s_waitcnt lgkmcnt(0)" ::: "memory"); SBAR(); pv_mma_ks(o, l, h, pa0);
    v_reads_ks<1>(l, h, vb); asm volatile("s_waitcnt lgkmcnt(0)" ::: "memory"); SBAR(); pv_mma_ks(o, l, h, pa1);
    v_reads_ks<2>(l, h, vb); asm volatile("s_waitcnt lgkmcnt(0)" ::: "memory"); SBAR(); pv_mma_ks(o, l, h, pa2);
    v_reads_ks<3>(l, h, vb); asm volatile("s_waitcnt lgkmcnt(0)" ::: "memory"); SBAR(); pv_mma_ks(o, l, h, pa3);
}
__device__ __forceinline__ void qk_tile(f32x16& p0, f32x16& p1, const bf16x8* qr, const char* Ks, int cb0, int r32, int hi) {
    bf16x8 kf[8];
#pragma unroll
    for (int d0 = 0; d0 < 4; ++d0) { const int cb = cb0 + (d0 * 16 + hi * 8) * 2; kf[2 * d0] = *(const bf16x8*)(Ks + KSWZ(r32, cb)); kf[2 * d0 + 1] = *(const bf16x8*)(Ks + KSWZ(32 + r32, cb)); }
    p0 = f32x16{}; p1 = f32x16{};
    __builtin_amdgcn_s_setprio(1);
#pragma unroll
    for (int d0 = 0; d0 < 4; ++d0) {
        p0 = __builtin_amdgcn_mfma_f32_32x32x16_bf16(kf[2 * d0], qr[d0], p0, 0, 0, 0);
        p1 = __builtin_amdgcn_mfma_f32_32x32x16_bf16(kf[2 * d0 + 1], qr[d0], p1, 0, 0, 0); }
    __builtin_amdgcn_s_setprio(0);
}
__device__ __forceinline__ void sm_pv(f32x16 (&o)[4], f32x16& p0, f32x16& p1, float& m_reg, float& l_reg, int vb, float* al_l, int r32, int hi) {
    float pmax;
    { float m0 = fmaxf(p0[0], p1[0]), m1 = fmaxf(p0[1], p1[1]), m2 = fmaxf(p0[2], p1[2]), m3 = fmaxf(p0[3], p1[3]);
#pragma unroll
      for (int r = 4; r < 16; r += 4) { m0 = fmaxf(fmaxf(m0, p0[r]), p1[r]); m1 = fmaxf(fmaxf(m1, p0[r + 1]), p1[r + 1]); m2 = fmaxf(fmaxf(m2, p0[r + 2]), p1[r + 2]); m3 = fmaxf(fmaxf(m3, p0[r + 3]), p1[r + 3]); }
      pmax = fmaxf(fmaxf(m0, m1), fmaxf(m2, m3)); }
    { auto rr = __builtin_amdgcn_permlane32_swap(__float_as_uint(pmax), __float_as_uint(pmax), false, false); pmax = fmaxf(__uint_as_float(rr[0]), __uint_as_float(rr[1])); }
    float mn, alpha;
    if (__builtin_expect(__all(pmax - m_reg <= ATT_THR), 1)) { mn = m_reg; alpha = 1.f; }
    else { mn = fmaxf(m_reg, pmax); alpha = fexp2(m_reg - mn); m_reg = mn; }
#pragma unroll
    for (int r = 0; r < 16; ++r) { p0[r] = fexp2(p0[r] - mn); p1[r] = fexp2(p1[r] - mn); }
    float ps;
    { float s0 = p0[0] + p1[0], s1 = p0[1] + p1[1], s2 = p0[2] + p1[2], s3 = p0[3] + p1[3];
#pragma unroll
      for (int r = 4; r < 16; r += 4) { s0 += p0[r] + p1[r]; s1 += p0[r + 1] + p1[r + 1]; s2 += p0[r + 2] + p1[r + 2]; s3 += p0[r + 3] + p1[r + 3]; }
      ps = (s0 + s1) + (s2 + s3); }
    { auto rr = __builtin_amdgcn_permlane32_swap(__float_as_uint(ps), __float_as_uint(ps), false, false); ps = __uint_as_float(rr[0]) + __uint_as_float(rr[1]); }
    l_reg = l_reg * alpha + ps;
    if (__any(alpha < 1.f)) { if (hi == 0) al_l[r32] = alpha; asm volatile("s_waitcnt lgkmcnt(0)" ::: "memory");
#pragma unroll
        for (int d = 0; d < 4; ++d)
#pragma unroll
            for (int r = 0; r < 16; ++r) o[d][r] *= al_l[crow(r, hi)]; }
    bf16x8 pa0, pa1, pa2, pa3;
#define PK4(P, BASE, OUT) do { unsigned a0 = cvt_pk_bf16(P[BASE + 0], P[BASE + 1]), a1 = cvt_pk_bf16(P[BASE + 2], P[BASE + 3]); \
        unsigned b0 = cvt_pk_bf16(P[BASE + 4], P[BASE + 5]), b1 = cvt_pk_bf16(P[BASE + 6], P[BASE + 7]); \
        auto r0 = __builtin_amdgcn_permlane32_swap(a0, b0, false, false); auto r1 = __builtin_amdgcn_permlane32_swap(a1, b1, false, false); \
        u32x4 w = {r0[0], r1[0], r0[1], r1[1]}; OUT = __builtin_bit_cast(bf16x8, w); } while (0)
    PK4(p0, 0, pa0); PK4(p0, 8, pa1); PK4(p1, 0, pa2); PK4(p1, 8, pa3);
#undef PK4
    pv_all(o, vb, pa0, pa1, pa2, pa3);
}
__device__ __forceinline__ void attn_unit(const Ctx& C, int l, int hd, int qrow0, int latbase, int ctxbase, int nlat, int NT, float lam, char* lds) {
    const int tid = opaque(threadIdx.x), wid = __builtin_amdgcn_readfirstlane(tid >> 6), lane = tid & 63, r32 = lane & 31, hi = lane >> 5, g = wid & 3, sj = wid >> 2;
    char* V_lds = lds; char* K_lds = lds + 2 * SHM_KV;
    float* wsf = (float*)(lds + 5 * SHM_KV) + wid * 64; float* al_l = wsf; float* li_l = wsf + 32;
    const bf16_t* Qw = C.P + (size_t)(qrow0 + g * 32 + r32) * DIN + C_AQ + hd * 128 + sj * 64 + hi * 8;
    bf16x8 qr[4];
#pragma unroll
    for (int d0 = 0; d0 < 4; ++d0) qr[d0] = *(const bf16x8*)(Qw + d0 * 16);
    const int sr = tid >> 4, sc = (tid & 15) * 8, vst0 = v_st(sr, sc), vst1 = v_st(32 + sr, sc);
    const int vb0 = (int)(uintptr_t)V_lds + v_rd_base(lane);
    const bf16_t* Kc = C.P + C_AK + hd * 128 + sc; const bf16_t* Vc = C.P + C_AV + hd * 128 + sc;
    bf16x8 vs0, vs1, ks0, ks1;
#define TROW(t) ((t) < nlat ? latbase + (t) * 64 : ctxbase + ((t) - nlat) * 64)
#define LOADK(t) do { const size_t rb_ = (size_t)TROW(t); ks0 = *(const bf16x8*)(Kc + (rb_ + sr) * DIN); ks1 = *(const bf16x8*)(Kc + (rb_ + 32 + sr) * DIN); } while (0)
#define LOADV(t) do { const size_t rb_ = (size_t)TROW(t); vs0 = *(const bf16x8*)(Vc + (rb_ + sr) * DIN); vs1 = *(const bf16x8*)(Vc + (rb_ + 32 + sr) * DIN); } while (0)
#define WRITEK(b) do { *(bf16x8*)(K_lds + (b) * SHM_KV + KSWZ(sr, sc * 2)) = ks0; *(bf16x8*)(K_lds + (b) * SHM_KV + KSWZ(32 + sr, sc * 2)) = ks1; } while (0)
#define WRITEV(b) do { *(bf16x8*)(V_lds + (b) * SHM_KV + vst0) = vs0; *(bf16x8*)(V_lds + (b) * SHM_KV + vst1) = vs1; } while (0)
    float m_reg = -1e30f, l_reg = 0.f;
    f32x16 o[4] = {};
    f32x16 pA0, pA1, pB0, pB1;
    LOADK(0); LOADV(0); WRITEK(0); WRITEV(0); LOADK(1); WRITEK(1); __syncthreads();
    qk_tile(pA0, pA1, qr, K_lds, sj * 128, r32, hi);
    int kb1 = 1, kb2 = 2;
#define ATT_STEP(PC0, PC1, PN0, PN1, jj) do { \
        if ((jj) + 2 < NT) LOADK((jj) + 2); if ((jj) + 1 < NT) LOADV((jj) + 1); \
        if ((jj) + 1 < NT) qk_tile(PN0, PN1, qr, K_lds + kb1 * SHM_KV, sj * 128, r32, hi); \
        sm_pv(o, PC0, PC1, m_reg, l_reg, vb0 + ((jj) & 1) * SHM_KV, al_l, r32, hi); \
        if ((jj) + 2 < NT) WRITEK(kb2); if ((jj) + 1 < NT) WRITEV(((jj) + 1) & 1); \
        kb1 = kb2; kb2 = (kb2 == 2) ? 0 : kb2 + 1; \
        __syncthreads(); } while (0)
#pragma unroll 1
    for (int j = 0; j < NT; j += 2) {
        ATT_STEP(pA0, pA1, pB0, pB1, j);
        ATT_STEP(pB0, pB1, pA0, pA1, j + 1);
    }
#undef ATT_STEP
#undef TROW
#undef LOADK
#undef LOADV
#undef WRITEK
#undef WRITEV
    if (hi == 0) li_l[r32] = (sj ? lam : 1.f) * frcp(l_reg);
    asm volatile("s_waitcnt lgkmcnt(0)" ::: "memory");
    float* xb = (float*)lds + g * 4096 + lane;
    if (sj == 1) {
#pragma unroll
        for (int r = 0; r < 16; ++r) { const float a = li_l[crow(r, hi)];
#pragma unroll
            for (int d = 0; d < 4; ++d) xb[(d * 16 + r) * 64] = o[d][r] * a; }
    }
    __syncthreads();
    if (sj == 0) {
        const float lam1m = (l == 0) ? 0.8f : (1.f - 0.35550906759f);
        float g4[4];
#pragma unroll
        for (int d = 0; d < 4; ++d) g4[d] = C.subg[l * 128 + d * 32 + r32] * lam1m;
#pragma unroll
        for (int r = 0; r < 16; ++r) { const int rw = crow(r, hi); const float a = li_l[rw];
            float ss = 0.f; float v4[4];
#pragma unroll
            for (int d = 0; d < 4; ++d) { const float v = o[d][r] * a - xb[(d * 16 + r) * 64]; v4[d] = v; ss += v * v; }
            ss = sum32(ss);
            const float rstd = __builtin_amdgcn_rsqf(ss * (1.f / 128.f) + NORM_EPS);
            const size_t row = (size_t)(qrow0 + g * 32 + rw);
            const bf16_t* zp = C.P + row * DIN + C_AZ + hd * 128 + r32; bf16_t* op = C.H + row * DM + 512 + hd * 128 + r32;
#pragma unroll
            for (int d = 0; d < 4; ++d) { const float z = bf2f(zp[d * 32]); const float v = v4[d] * rstd * g4[d] * siluf_(z);
                op[d * 32] = (bf16_t)(cvt_pk_bf16(v, 0.f) & 0xffffu); } }
    }
    __syncthreads();
}

__device__ __forceinline__ void readout_row(const Ctx& C, int l, int lr, int lane_in) {
    const int lane = opaque(lane_in);
    constexpr size_t ARR = (size_t)MH * 256;
    const int j = 4 * lane; const size_t off = (size_t)lr * 256 + j;
    f32x4 y = *(const f32x4*)(C.YS + off) + *(const f32x4*)(C.YS + ARR + off);
    float s = (y[0] + y[1]) + (y[2] + y[3]);
    s = sum16(s);
    const float mu = s * (1.f / 64.f);
    y = y - mu;
    float q = (y[0] * y[0] + y[1] * y[1]) + (y[2] * y[2] + y[3] * y[3]);
    q = sum16(q);
    const float rstd = __builtin_amdgcn_rsqf(q * (1.f / 64.f) + GN_EPS);
    const f32x4 lg = *(const f32x4*)(C.ln_g + l * 256 + j), lb = *(const f32x4*)(C.ln_b + l * 256 + j), rk = *(const f32x4*)(C.r_k + l * 256 + j);
    const bf16_t* pr = C.P + (size_t)lr * DIN;
    const f32x4 r = ld_bf4(pr + C_R + j), v = ld_bf4(pr + C_V + j), z = ld_bf4(pr + C_ZR + j);
    const bf16_t* sb16 = (const bf16_t*)(C.SC + 2 * ARR);
    const f32x4 ks = ld_bf4(sb16 + off) + ld_bf4(sb16 + ARR + off);
    const f32x4 t = r * ks * rk;
    float bs = (t[0] + t[1]) + (t[2] + t[3]);
    bs = sum16(bs);
    f32x4 o = y * rstd * lg + lb + bs * v;
    o[0] *= siluf_(z[0]); o[1] *= siluf_(z[1]); o[2] *= siluf_(z[2]); o[3] *= siluf_(z[3]);
    st_bf4(C.H + (size_t)lr * DM + j, o);
}

#define XB_TMO      128
#define XB_XCNT(j)  (256  + 64 * (j))
#define XB_XSUB(j)  (1280 + 64 * (j))
#define XB_XGEN(j)  (2304 + 64 * (j))
#define XB_TOP      3328
#define XB_TOPGEN   3392
#define XCD_BAR_WORDS 3456
#define XB_SPIN_CAP (1u << 20)
__device__ __forceinline__ unsigned xb_ld(unsigned* p)              { return __hip_atomic_load(p, __ATOMIC_RELAXED, __HIP_MEMORY_SCOPE_AGENT); }
__device__ __forceinline__ unsigned xb_add(unsigned* p, unsigned v) { return __hip_atomic_fetch_add(p, v, __ATOMIC_RELAXED, __HIP_MEMORY_SCOPE_AGENT); }
__device__ __forceinline__ unsigned xb_xcc_id() { return (unsigned)__builtin_amdgcn_s_getreg((3 << 11) | 20) & 0xFu; }
#define XB_SPIN(cond, bar) do { unsigned _sp = 0; while (cond) { __builtin_amdgcn_s_sleep(1); \
    if ((++_sp & 255u) == 0u) { if (xb_ld(&(bar)[XB_TMO])) break; if (_sp > XB_SPIN_CAP) { atomicAdd(&(bar)[XB_TMO], 1u); break; } } } } while (0)
struct XcdBarrier { unsigned* bar; unsigned x; volatile LAS unsigned* st; };
__device__ __forceinline__ XcdBarrier xcd_barrier_post(unsigned* bar, volatile LAS unsigned* st) {
    XcdBarrier b; b.bar = bar; b.x = xb_xcc_id(); b.st = st;
    if (threadIdx.x == 0) (void)xb_add(&bar[XB_XCNT(b.x)], 1u);
    return b;
}
__device__ __forceinline__ void xcd_barrier_complete(unsigned* bar, unsigned x, unsigned& nloc, unsigned& nx) {
    const unsigned G = gridDim.x * gridDim.y * gridDim.z;
    unsigned sum, cnt, mine, sp = 0u;
    for (;;) {
        sum = 0u; cnt = 0u; mine = 0u;
#pragma unroll
        for (unsigned j = 0; j < 16; ++j) { const unsigned c = xb_ld(&bar[XB_XCNT(j)]); sum += c; cnt += (c > 0u) ? 1u : 0u; mine = (j == x) ? c : mine; }
        if (sum == G) break;
        __builtin_amdgcn_s_sleep(1);
        if ((++sp & 255u) == 0u) { if (xb_ld(&bar[XB_TMO])) break; if (sp > XB_SPIN_CAP) { atomicAdd(&bar[XB_TMO], 1u); break; } }
    }
    nloc = mine > 0u ? mine : 1u; nx = cnt > 0u ? cnt : 1u;
}
__device__ __forceinline__ void xcd_barrier(const XcdBarrier& b) {
    asm volatile("s_waitcnt vmcnt(0)" ::: "memory");
    __syncthreads();
    if (threadIdx.x == 0) {
        unsigned* bar = b.bar;
        __builtin_amdgcn_s_waitcnt(0);
        unsigned nloc = b.st[0], nx = b.st[1];
        if (nloc == 0u) { xcd_barrier_complete(bar, b.x, nloc, nx); b.st[0] = nloc; b.st[1] = nx; }
        const unsigned old = xb_add(&bar[XB_XSUB(b.x)], 1u);
        const unsigned gen = old / nloc;
        if (old + 1u == (gen + 1u) * nloc) {
            __builtin_amdgcn_fence(__ATOMIC_RELEASE, "agent");
            asm volatile("s_waitcnt vmcnt(0)" ::: "memory");
            const unsigned og = xb_add(&bar[XB_TOP], 1u);
            const unsigned tg = og / nx;
            if (og + 1u == (tg + 1u) * nx) xb_add(&bar[XB_TOPGEN], 1u);
            else XB_SPIN(xb_ld(&bar[XB_TOPGEN]) == tg, bar);
            __builtin_amdgcn_fence(__ATOMIC_ACQUIRE, "agent");
            xb_add(&bar[XB_XGEN(b.x)], 1u);
            asm volatile("s_waitcnt vmcnt(0)" ::: "memory");
        } else {
            XB_SPIN(xb_ld(&bar[XB_XGEN(b.x)]) == gen, bar);
            __builtin_amdgcn_fence(__ATOMIC_ACQUIRE, "agent");
            asm volatile("s_waitcnt vmcnt(0)" ::: "memory");
        }
    }
    __syncthreads();
}

#ifndef REP_ATT
#define REP_ATT 1
#endif
#ifndef REP_SCAN
#define REP_SCAN 1
#endif
#ifndef REP_G1
#define REP_G1 1
#endif
#ifndef REP_P3
#define REP_P3 1
#endif
#ifndef REP_RD
#define REP_RD 1
#endif
#ifndef REP_G0
#define REP_G0 1
#endif
#ifndef REP_P1
#define REP_P1 1
#endif
#ifndef REP_SYNC
#define REP_SYNC 1
#endif
#ifndef REP_G2
#define REP_G2 1
#endif
#ifndef REP_FIN
#define REP_FIN 1
#endif
struct Args { const float* in[22]; float* out; unsigned char* ws; };
__global__ void __launch_bounds__(512, 2) mk_fwd(Args a) {
    extern __shared__ __attribute__((aligned(16))) unsigned char lds_raw[];
    cg::grid_group grid = cg::this_grid();
    LAS unsigned char* lds = (LAS unsigned char*)lds_raw;
    Ctx C;
    C.x = a.in[0]; C.c = a.in[1]; C.ctx = a.in[2]; C.c_ctx = a.in[3]; C.mod_w = a.in[4]; C.mod_b = a.in[5]; C.pre_g = a.in[6]; C.post_g = a.in[7]; C.w_in = a.in[8]; C.w_out = a.in[9];
    C.w0 = a.in[10]; C.w_up = a.in[11]; C.a0 = a.in[12]; C.a_up = a.in[13]; C.k_k = a.in[14]; C.k_a = a.in[15]; C.r_k = a.in[16]; C.ln_g = a.in[17]; C.ln_b = a.in[18]; C.conv_w = a.in[19];
    C.dlam = a.in[20]; C.subg = a.in[21]; C.out = a.out;
    unsigned char* ws = a.ws;
    C.WinT = (bf16_t*)(ws + WS_WIN); C.WoutT = (bf16_t*)(ws + WS_WOUT); C.WupT = (bf16_t*)(ws + WS_WUP); C.mod = (float*)(ws + WS_MOD); C.rope = (float*)(ws + WS_ROPE);
    C.xc1 = (float*)(ws + WS_XC1); C.H = (bf16_t*)(ws + WS_H); C.P = (bf16_t*)(ws + WS_P); C.Y = (bf16_t*)(ws + WS_P); C.SC = (float*)(ws + WS_SC); C.YS = (float*)(ws + WS_YS);
    const int tid = threadIdx.x, wid = __builtin_amdgcn_readfirstlane(tid >> 6), G = gridDim.x, bx = blockIdx.x;
#define lane (opaque(tid) & 63)
    const int gw0 = bx * 8 + wid, ngw = G * 8;
#define gw opaque_s(gw0)

    if (bx == 0) for (int i = tid; i < 4096; i += 512) ((unsigned*)ws)[i] = 0u;
    if (tid < 2) ((volatile LAS unsigned*)(lds + 131072 + 1024))[tid] = 0u;
    __syncthreads();
#ifdef PROBE_A
    unsigned long long tprev = __builtin_amdgcn_s_memrealtime(); float tacc[9] = {0.f, 0.f, 0.f, 0.f, 0.f, 0.f, 0.f, 0.f, 0.f};
#define STAMP(k) do { const unsigned long long tn_ = __builtin_amdgcn_s_memrealtime(); tacc[k] += (float)(tn_ - tprev) * 0.01f; tprev = tn_; } while (0)
#else
#define STAMP(k) do { } while (0)
#endif
#ifndef NO_G0
    for (int rep = 0; rep < REP_G0; ++rep) g0_prologue(C, lds);
#endif
    grid.sync(); STAMP(0);
    const XcdBarrier xbar = xcd_barrier_post((unsigned*)ws, (volatile LAS unsigned*)(lds + 131072 + 1024));
#define GSYNC() xcd_barrier(xbar)
#pragma unroll 1
    for (int hf = 0; hf < 2; ++hf) {
#pragma unroll 1
        for (int l = 0; l < 2; ++l) {
#ifndef NO_NORM
            for (int rep = 0; rep < REP_P1; ++rep) { if (l == 0) norm_phase<0>(C, hf, gw, ngw, lane); else norm_phase<1>(C, hf, gw, ngw, lane); }
#endif
            for (int rep = 0; rep < REP_SYNC; ++rep) GSYNC();
            STAMP(1);
            { pg8::Gemm g{C.H, C.WinT + (size_t)l * DIN * DM, MH, DIN, DM}; pg8::StaticOrder S; S.init(MH, DIN, G, bx);
#ifndef NO_GEMM1
              pg8::EpiBf16 E{C.P, DIN}; for (int rep = 0; rep < REP_G1; ++rep) pg8::gemm_phase<pg8::EpiBf16, true>(lds, g, S, E);
#endif
            }
            GSYNC(); STAMP(2);
#ifndef NO_PREP
            for (int rep = 0; rep < REP_P3; ++rep) for (int t = bx; t < MH / 64; t += G) prep_block(C, l, t, lds);
#endif
            for (int r4 = gw; r4 < MH / 4; r4 += ngw) { const bool do_conv = (l == 0) || (r4 < LATH / 4); if (do_conv || r4 < LATH / 4) rowpass4(C, l, r4 * 4, lane, do_conv); }
            GSYNC(); STAMP(3);
#ifndef NO_SCAN
            unsigned* sdone = (unsigned*)ws + 3840 + (hf * 2 + l) * 64;
            { unsigned nscan = 0;
              if (G == 256) { if (((bx >> 3) & 1) == 0) { scan_chunked(C, l, (bx >> 4) * 8 + (bx & 7), lds); nscan = 1; } } else { for (int u = bx; u < 128; u += G) { scan_chunked(C, l, u, lds); ++nscan; } }
              if (nscan) { asm volatile("s_waitcnt vmcnt(0)" ::: "memory"); __syncthreads();
                  if (tid == 0) { __builtin_amdgcn_fence(__ATOMIC_RELEASE, "agent"); asm volatile("s_waitcnt vmcnt(0)" ::: "memory");
                                  (void)__hip_atomic_fetch_add(sdone, nscan, __ATOMIC_RELAXED, __HIP_MEMORY_SCOPE_AGENT); } } }
#endif
            STAMP(4);
#ifndef NO_ATT
            {
                float lam;
                { const int ln = opaque(lane); const float* dl = C.dlam + l * 256; const float sa = wave_sum_dpp(dl[ln] * dl[64 + ln]), sb = wave_sum_dpp(dl[128 + ln] * dl[192 + ln]);
                  lam = fexp2(1.4426950408889634f * sa) - fexp2(1.4426950408889634f * sb) + ((l == 0) ? 0.2f : 0.35550906759f); }
                unsigned* qctr = (unsigned*)ws + 3584 + (hf * 2 + l) * 64;
                volatile LAS unsigned* qslot = (volatile LAS unsigned*)(lds + 131072 + 1024 + 64);
                const int nunits = (l == 0) ? 1024 + 128 : 1024;
                for (;;) {
                    if (tid == 0) qslot[0] = __hip_atomic_fetch_add(qctr, 1u, __ATOMIC_RELAXED, __HIP_MEMORY_SCOPE_AGENT);
                    __syncthreads();
                    const int u = (int)qslot[0];
                    __syncthreads();
                    if (u >= nunits) break;
                    if (u < 1024) { const int bl = u >> 6, hd = (u >> 4) & 3, qb = u & 15;
                        attn_unit(C, l, hd, bl * SEQ + qb * 128, bl * SEQ, LATH + bl * CTX, 32, 36, lam, (char*)lds_raw); }
                    else { const int v = u - 1024; const int bl = v >> 3, hd = (v >> 1) & 3, qb = v & 1;
                        attn_unit(C, l, hd, LATH + bl * CTX + qb * 128, 0, LATH + bl * CTX, 0, 4, lam, (char*)lds_raw); }
                }
            }
#endif
            STAMP(5);
            {
                volatile LAS unsigned* qslot = (volatile LAS unsigned*)(lds + 131072 + 1024 + 64);
                if (tid == 0) { unsigned sp = 0;
                    while (__hip_atomic_load(sdone, __ATOMIC_RELAXED, __HIP_MEMORY_SCOPE_AGENT) < 128u) { __builtin_amdgcn_s_sleep(4); if (++sp > (1u << 22)) break; }
                    __builtin_amdgcn_fence(__ATOMIC_ACQUIRE, "agent"); asm volatile("s_waitcnt vmcnt(0)" ::: "memory"); }
                __syncthreads();
                unsigned* rq = sdone + 16;
                const int nch = ((l == 0) ? MH : LATH) / 64;
                for (;;) {
                    if (tid == 0) qslot[0] = __hip_atomic_fetch_add(rq, 1u, __ATOMIC_RELAXED, __HIP_MEMORY_SCOPE_AGENT);
                    __syncthreads();
                    const int ch = (int)qslot[0];
                    __syncthreads();
                    if (ch >= nch) break;
#pragma unroll 1
                    for (int i = 0; i < 4; ++i) { const int r = ch * 64 + wid * 8 + i * 2; readout_row(C, l, r, lane); readout_row(C, l, r + 1, lane); }
                }
            }
            GSYNC(); STAMP(6);
            { const int M5 = (l == 0) ? MH : LATH; pg8::Gemm g{C.H, C.WoutT + (size_t)l * DM * DM, M5, DM, DM}; pg8::StaticOrder S; S.init(M5, DM, G, bx);
#ifndef NO_GEMM2
              pg8::EpiBf16 E{C.Y, DM}; for (int rep = 0; rep < REP_G2; ++rep) pg8::gemm_phase<pg8::EpiBf16, true>(lds, g, S, E);
#endif
            }
            GSYNC(); STAMP(7);
        }
#ifdef PROBE_A
        norm_phase<2>(C, hf, gw, ngw, lane, 2e-3f * tacc[PROBE_A], 1e-3f * tacc[PROBE_B]); STAMP(8);
#else
        norm_phase<2>(C, hf, gw, ngw, lane);
#endif
    }
#undef gw
#undef lane
}

extern "C" void kernel_launch(void* const* d_in, const int* in_sizes, int n_in, void* d_out, int out_size, void* d_ws, size_t ws_size, hipStream_t stream) {
    static int grid = 0;
    if (grid == 0) {
        if (n_in != 22 || ws_size < WS_END) { fprintf(stderr, "kernel_launch: unexpected n_in %d / ws %zu\n", n_in, ws_size); grid = -1; return; }
        int dev = 0, cus = 0, per_cu = 0;
        hipGetDevice(&dev); hipDeviceGetAttribute(&cus, hipDeviceAttributeMultiprocessorCount, dev);
        if (hipFuncSetAttribute((const void*)mk_fwd, hipFuncAttributeMaxDynamicSharedMemorySize, LDS_BYTES) != hipSuccess) { fprintf(stderr, "kernel_launch: hipFuncSetAttribute failed\n"); grid = -1; return; }
        if (hipOccupancyMaxActiveBlocksPerMultiprocessor(&per_cu, (const void*)mk_fwd, 512, LDS_BYTES) != hipSuccess || per_cu < 1) { fprintf(stderr, "kernel_launch: occupancy query says %d\n", per_cu); per_cu = 1; }
        (void)hipGetLastError();
        grid = cus * 1;
    }
    if (grid < 0) return;
    Args a{};
    for (int i = 0; i < 22; ++i) a.in[i] = (const float*)d_in[i];
    a.out = (float*)d_out; a.ws = (unsigned char*)d_ws;
    void* args[] = {&a};
    hipError_t e = hipLaunchCooperativeKernel((const void*)mk_fwd, dim3(grid), dim3(512), args, LDS_BYTES, stream);
    if (e != hipSuccess) fprintf(stderr, "cooperative launch failed: %s (grid %d)\n", hipGetErrorString(e), grid);
}
```

```cpp
#include <hip/hip_runtime.h>
#include <hip/hip_cooperative_groups.h>
#include <cstdio>
#include <cstdint>
namespace cg = cooperative_groups;

#define LAS __attribute__((address_space(3)))
typedef unsigned short bf16_t;
typedef short bf16x8 __attribute__((ext_vector_type(8)));
typedef short s16x4 __attribute__((ext_vector_type(4)));
typedef float f32x2 __attribute__((ext_vector_type(2)));
typedef float f32x4 __attribute__((ext_vector_type(4)));
typedef float f32x16 __attribute__((ext_vector_type(16)));
typedef unsigned u32x2 __attribute__((ext_vector_type(2)));
typedef unsigned u32x4 __attribute__((ext_vector_type(4)));

constexpr int DM = 1024, SEQ = 2048, CTX = 256, DIN = 4352;
constexpr int HB = 16;
constexpr int LATH = HB * SEQ;
constexpr int CTXH = HB * CTX;
constexpr int MH = LATH + CTXH;
constexpr int C_R = 0, C_K = 256, C_V = 512, C_LWF = 768, C_LWB = 832, C_LAF = 896, C_LAB = 960, C_ZR = 1024,
              C_CB = 1280, C_CC = 1536, C_CH = 1792, C_CZ = 2048, C_AQ = 2304, C_AK = 2816, C_AV = 3328, C_AZ = 3840;
constexpr float C2 = 0.125f * 1.4426950408889634f;
constexpr float NORM_EPS = 1e-6f, GN_EPS = 64e-5f;

constexpr size_t MiB = 1u << 20;
constexpr size_t WS_WIN = 1 * MiB, WS_WOUT = 18 * MiB, WS_WUP = 22 * MiB, WS_MOD = 23 * MiB, WS_ROPE = 24 * MiB, WS_XC1 = 25 * MiB,
                 WS_H = 57 * MiB, WS_P = 129 * MiB, WS_SC = 435 * MiB, WS_YS = 687 * MiB, WS_END = 759 * MiB;
static_assert(WS_WIN + 2ull * DIN * DM * 2 <= WS_WOUT && WS_H + (size_t)MH * DM * 2 <= WS_P && WS_P + (size_t)MH * DIN * 2 <= WS_SC &&
              WS_SC + 7ull * MH * 256 * 4 <= WS_YS && WS_YS + 2ull * MH * 256 * 4 <= WS_END, "ws map");
constexpr int LDS_BYTES = 131072 + 2048;

struct Ctx {
    const float *x, *c, *ctx, *c_ctx, *mod_w, *mod_b, *pre_g, *post_g, *w_in, *w_out, *w0, *w_up, *a0, *a_up, *k_k, *k_a, *r_k, *ln_g, *ln_b, *conv_w, *dlam, *subg;
    float* out;
    bf16_t *WinT, *WoutT, *WupT; float *mod, *rope, *xc1; bf16_t *H, *P, *Y; float *SC, *YS;
};

__device__ __forceinline__ unsigned cvt_pk_bf16(float lo, float hi) { unsigned r; asm volatile("v_cvt_pk_bf16_f32 %0, %1, %2" : "=v"(r) : "v"(lo), "v"(hi)); return r; }
__device__ __forceinline__ float bf_lo(unsigned w) { return __uint_as_float(w << 16); }
__device__ __forceinline__ float bf_hi(unsigned w) { return __uint_as_float(w & 0xffff0000u); }
__device__ __forceinline__ float bf2f(bf16_t b) { return __uint_as_float((unsigned)b << 16); }
__device__ __forceinline__ f32x4 ld_bf4(const bf16_t* p) { const u32x2 w = *(const u32x2*)p; return (f32x4){bf_lo(w.x), bf_hi(w.x), bf_lo(w.y), bf_hi(w.y)}; }
__device__ __forceinline__ f32x4 ld_bf4_nt(const bf16_t* p) { const u32x2 w = __builtin_nontemporal_load((const u32x2*)p); return (f32x4){bf_lo(w.x), bf_hi(w.x), bf_lo(w.y), bf_hi(w.y)}; }
__device__ __forceinline__ void st_bf4(bf16_t* p, f32x4 v) { u32x2 w; w.x = cvt_pk_bf16(v[0], v[1]); w.y = cvt_pk_bf16(v[2], v[3]); *(u32x2*)p = w; }
__device__ __forceinline__ int opaque(int v) { asm volatile("" : "+v"(v)); return v; }
__device__ __forceinline__ int opaque_s(int v) { asm volatile("" : "+s"(v)); return v; }
__device__ __forceinline__ float fexp2(float x) { return __builtin_amdgcn_exp2f(x); }
__device__ __forceinline__ float frcp(float x) { return __builtin_amdgcn_rcpf(x); }
__device__ __forceinline__ float sigmoidf_(float x) { return frcp(1.f + fexp2(-1.4426950408889634f * x)); }
__device__ __forceinline__ float siluf_(float x) { return x * sigmoidf_(x); }
__device__ __forceinline__ float sum16(float v) {
    v += __int_as_float(__builtin_amdgcn_update_dpp(0, __float_as_int(v), 0xB1, 0xF, 0xF, true));
    v += __int_as_float(__builtin_amdgcn_update_dpp(0, __float_as_int(v), 0x4E, 0xF, 0xF, true));
    v += __int_as_float(__builtin_amdgcn_update_dpp(0, __float_as_int(v), 0x141, 0xF, 0xF, true));
    v += __int_as_float(__builtin_amdgcn_update_dpp(0, __float_as_int(v), 0x140, 0xF, 0xF, true));
    return v;
}
__device__ __forceinline__ float wave_sum(float v) {
    const int ri = __float_as_int(sum16(v));
    return (__int_as_float(__builtin_amdgcn_readlane(ri, 0)) + __int_as_float(__builtin_amdgcn_readlane(ri, 16))) + (__int_as_float(__builtin_amdgcn_readlane(ri, 32)) + __int_as_float(__builtin_amdgcn_readlane(ri, 48)));
}
__device__ __forceinline__ float wave_sum_dpp(float v) {
    const int ri = __float_as_int(sum16(v));
    return (__int_as_float(__builtin_amdgcn_readlane(ri, 0)) + __int_as_float(__builtin_amdgcn_readlane(ri, 16))) + (__int_as_float(__builtin_amdgcn_readlane(ri, 32)) + __int_as_float(__builtin_amdgcn_readlane(ri, 48)));
}
__device__ __forceinline__ float sum32(float v) {
    const float r = sum16(v);
    return r + __int_as_float(__builtin_amdgcn_ds_swizzle(__float_as_int(r), 0x401f));
}

namespace pg8 {
constexpr int BM = 256, BK = 64, HALF = 128, HTB = HALF * BK * 2, STAGE_BYTES = 8 * HTB, NXCD = 8, WGM = 8;
__host__ __device__ __forceinline__ int lds_byte(int r, int c) { const int st = (r >> 4) * 2 + (c >> 5), rr = r & 15, cc = c & 31, ob = rr * 64 + cc * 2; return st * 1024 + (ob ^ (((ob >> 9) & 1) << 5)); }
__host__ __device__ __forceinline__ void stage_rc(int b, int& R, int& C) { const int st = b / 1024, sb = b % 1024, swz = sb ^ (((sb >> 9) & 1) << 5); R = (st >> 1) * 16 + swz / 64; C = (st & 1) * 32 + (swz % 64) / 2; }
__host__ __device__ __forceinline__ int perm32(int rho) { const int n = rho >> 4, i = rho & 15; return 8 * (i >> 2) + 4 * n + (i & 3); }
struct Unit { int pm, pn; };
struct Gemm { const bf16_t* A; const bf16_t* Bt; int M, N, K; };
struct StaticOrder {
    int nM, nN, nwg, G, c;
    __host__ __device__ void init(int M, int N, int G_, int c_) { nM = M / BM; nN = N / BM; nwg = nM * nN; G = G_; c = c_; }
    __host__ __device__ bool next(int i, Unit& u) const {
        const long L = (long)i * G + c; if (L >= nwg) return false;
        int wgid = (int)L; { const int q = nwg / NXCD, r = nwg % NXCD, xcd = wgid % NXCD, off = wgid / NXCD; wgid = (xcd < r ? xcd * (q + 1) : r * (q + 1) + (xcd - r) * q) + off; }
        const int nig = WGM * nN, gid = wgid / nig, fm = gid * WGM, gsz = (nM - fm) < WGM ? (nM - fm) : WGM;
        u.pm = fm + ((wgid % nig) % gsz); u.pn = (wgid % nig) / gsz; return true;
    }
};
struct EpiBf16 {
    static constexpr bool PERM = true;
    bf16_t* O; int ldc;
    __device__ __forceinline__ void operator()(const f32x4 (&acc)[2][2][4][2], const Unit& u, int wr, int wc, int fr, int fq) const {
        const int row0 = u.pm * BM + wr * 64 + fr, col0 = u.pn * BM + wc * 32 + 8 * fq;
        int ld = ldc; asm volatile("" : "+s"(ld));
#pragma unroll
        for (int ai = 0; ai < 2; ++ai)
#pragma unroll
            for (int m = 0; m < 4; ++m) { bf16_t* rowp = O + (size_t)(row0 + ai * HALF + m * 16) * ld + col0;
#pragma unroll
                for (int bj = 0; bj < 2; ++bj) { const f32x4 v0 = acc[ai][bj][m][0], v1 = acc[ai][bj][m][1];
                    u32x4 w; w.x = cvt_pk_bf16(v0[0], v0[1]); w.y = cvt_pk_bf16(v0[2], v0[3]); w.z = cvt_pk_bf16(v1[0], v1[1]); w.w = cvt_pk_bf16(v1[2], v1[3]);
                    *(u32x4*)(rowp + bj * HALF) = w; } }
    }
};
template <class Epi, bool ALIGN_EPI = true>
__device__ __forceinline__ void gemm_phase(LAS unsigned char* lds, const Gemm g, const StaticOrder& S, const Epi& E) {
    const int tid = opaque(threadIdx.x), wid = __builtin_amdgcn_readfirstlane(tid >> 6), lane = tid & 63, wr = wid >> 2, wc = wid & 3, fr = lane & 15, fq = lane >> 4;
    const int K = g.K, nt = K / BK;
    unsigned voffA[2], voffB[2];
#pragma unroll
    for (int i = 0; i < 2; ++i) { int R, C; stage_rc(tid * 16 + i * 8192, R, C); const int Rb = Epi::PERM ? ((R & ~31) + perm32(R & 31)) : R;
        voffA[i] = (unsigned)(R * K + C) * 2u; voffB[i] = (unsigned)(Rb * K + C) * 2u; }
    const size_t kstep = (size_t)(BK * 2);
    const size_t hstep = (size_t)HALF * K * 2;
    const size_t tstep = 2 * hstep;
    const unsigned ldsw = (unsigned)wid * 1024u;
    const int aoff = lds_byte(wr * 64 + fr, fq * 8), boff = lds_byte(wc * 32 + fr, fq * 8);
#define PG8_SA(b, h) (((b) * 2 + (h)) * HTB)
#define PG8_SB(b, h) ((4 + (b) * 2 + (h)) * HTB)
#define PG8_STAGE(bufoff, gbase, voff) do { _Pragma("unroll") for (int _i = 0; _i < 2; ++_i) \
        __builtin_amdgcn_global_load_lds((const unsigned*)((const char*)(gbase) + (voff)[_i]), (LAS unsigned*)(lds + (bufoff) + ldsw + _i * 8192), 16, 0, 0); } while (0)
#define PG8_LDA(dst, b, h) do { _Pragma("unroll") for (int m = 0; m < 4; ++m) _Pragma("unroll") for (int k = 0; k < 2; ++k) dst[m][k] = *(const LAS bf16x8*)(lds + PG8_SA(b, h) + aoff + m * 2048 + k * 1024); } while (0)
#define PG8_LDB(dst, b, h) do { _Pragma("unroll") for (int n = 0; n < 2; ++n) _Pragma("unroll") for (int k = 0; k < 2; ++k) dst[n][k] = *(const LAS bf16x8*)(lds + PG8_SB(b, h) + boff + n * 2048 + k * 1024); } while (0)
#define PG8_MMA(ai, bj, At, Bt) do { __builtin_amdgcn_s_setprio(1); _Pragma("unroll") for (int m = 0; m < 4; ++m) _Pragma("unroll") for (int n = 0; n < 2; ++n) _Pragma("unroll") for (int k = 0; k < 2; ++k) \
        acc[ai][bj][m][n] = __builtin_amdgcn_mfma_f32_16x16x32_bf16(Bt[n][k], At[m][k], acc[ai][bj][m][n], 0, 0, 0); __builtin_amdgcn_s_setprio(0); } while (0)
#define PG8_WAIT_V(n) asm volatile("s_waitcnt vmcnt(" #n ")" ::: "memory")
#define PG8_WAIT_L(n) asm volatile("s_waitcnt lgkmcnt(" #n ")" ::: "memory")
#define PG8_BAR __builtin_amdgcn_s_barrier()
#define PG8_SCHED __builtin_amdgcn_sched_barrier(0)
    Unit cur, nxt; int ui = 0;
    if (!S.next(0, cur)) return;
    f32x4 acc[2][2][4][2];
#pragma unroll
    for (int a = 0; a < 2; ++a)
#pragma unroll
        for (int b = 0; b < 2; ++b)
#pragma unroll
            for (int m = 0; m < 4; ++m)
#pragma unroll
                for (int n = 0; n < 2; ++n) acc[a][b][m][n] = (f32x4){0.f, 0.f, 0.f, 0.f};
    bf16x8 At[4][2], B0[2][2], B1[2][2];
    const char* cA = (const char*)g.A + (size_t)cur.pm * tstep; const char* cB = (const char*)g.Bt + (size_t)cur.pn * tstep;
    PG8_STAGE(PG8_SB(0, 0), cB, voffB); PG8_STAGE(PG8_SB(0, 1), cB + hstep, voffB); PG8_STAGE(PG8_SA(0, 0), cA, voffA); PG8_STAGE(PG8_SA(0, 1), cA + hstep, voffA);
    if (wr == 1) PG8_BAR;
    PG8_WAIT_V(2); PG8_BAR;
    PG8_STAGE(PG8_SB(1, 0), cB + kstep, voffB); PG8_STAGE(PG8_SA(1, 0), cA + kstep, voffA); PG8_STAGE(PG8_SB(1, 1), cB + hstep + kstep, voffB);
    PG8_WAIT_V(6); PG8_BAR;
    for (;;) {
        const bool has_next = S.next(ui + 1, nxt);
        const char* nA = has_next ? (const char*)g.A + (size_t)nxt.pm * tstep : cA; const char* nB = has_next ? (const char*)g.Bt + (size_t)nxt.pn * tstep : cB;
        for (int t = 0; t < nt; t += 2) {
            const bool last = (t == nt - 2);
            const char* a1 = cA + (size_t)(t + 1) * kstep;
            const char* a2 = last ? nA : cA + (size_t)(t + 2) * kstep; const char* b2 = last ? nB : cB + (size_t)(t + 2) * kstep;
            const char* a3 = a2 + kstep; const char* b3 = b2 + kstep;
            PG8_LDB(B0, 0, 0); PG8_LDB(B1, 0, 1); PG8_SCHED; PG8_LDA(At, 0, 0); PG8_STAGE(PG8_SA(1, 1), a1 + hstep, voffA);
            PG8_WAIT_V(8); PG8_WAIT_L(0); PG8_BAR; PG8_MMA(0, 0, At, B0); PG8_MMA(0, 1, At, B1); PG8_BAR; PG8_SCHED;
            PG8_LDA(At, 0, 1); PG8_STAGE(PG8_SB(0, 0), b2, voffB); PG8_STAGE(PG8_SB(0, 1), b2 + hstep, voffB); PG8_STAGE(PG8_SA(0, 0), a2, voffA);
            PG8_WAIT_V(8); PG8_WAIT_L(0); PG8_BAR; PG8_MMA(1, 0, At, B0); PG8_MMA(1, 1, At, B1); PG8_BAR; PG8_SCHED;
            PG8_LDB(B0, 1, 0); PG8_LDB(B1, 1, 1); PG8_SCHED; PG8_LDA(At, 1, 0); PG8_STAGE(PG8_SA(0, 1), a2 + hstep, voffA);
            PG8_WAIT_V(8); PG8_WAIT_L(0); PG8_BAR; PG8_MMA(0, 0, At, B0); PG8_MMA(0, 1, At, B1); PG8_BAR; PG8_SCHED;
            PG8_LDA(At, 1, 1); PG8_STAGE(PG8_SB(1, 0), b3, voffB); PG8_STAGE(PG8_SB(1, 1), b3 + hstep, voffB); PG8_STAGE(PG8_SA(1, 0), a3, voffA);
            PG8_WAIT_V(8); PG8_WAIT_L(0); PG8_BAR; PG8_MMA(1, 0, At, B0); PG8_MMA(1, 1, At, B1); PG8_BAR; PG8_SCHED;
        }
        if constexpr (ALIGN_EPI) { if (wr == 0) PG8_BAR; }
        E(acc, cur, wr, wc, fr, fq);
        if (!has_next) break;
#pragma unroll
        for (int a = 0; a < 2; ++a)
#pragma unroll
            for (int b = 0; b < 2; ++b)
#pragma unroll
                for (int m = 0; m < 4; ++m)
#pragma unroll
                    for (int n = 0; n < 2; ++n) acc[a][b][m][n] = (f32x4){0.f, 0.f, 0.f, 0.f};
        cur = nxt; cA = nA; cB = nB; ++ui;
        if constexpr (ALIGN_EPI) { if (wr == 1) PG8_BAR; }
    }
    PG8_WAIT_V(0);
    if constexpr (!ALIGN_EPI) { if (wr == 0) PG8_BAR; }
    PG8_BAR;
#undef PG8_SA
#undef PG8_SB
#undef PG8_STAGE
#undef PG8_LDA
#undef PG8_LDB
#undef PG8_MMA
#undef PG8_WAIT_V
#undef PG8_WAIT_L
#undef PG8_BAR
#undef PG8_SCHED
}
}

__device__ __forceinline__ void transpose_item(const float* W, int K, int N, bf16_t* WT, LAS float* scr, int item, int lane, bool qscale) {
    const int nblk = N / 32, kb = item / nblk, nb = item % nblk, k0 = 64 * kb, n0 = 32 * nb;
    const float wsc = (qscale && n0 >= C_AQ && n0 < C_AK) ? C2 : 1.f;
#pragma unroll 8
    for (int i = 0; i < 32; ++i) { const int kk = 2 * i + (lane >> 5); scr[kk * 33 + (lane & 31)] = wsc * W[(size_t)(k0 + kk) * N + n0 + (lane & 31)]; }
    asm volatile("s_waitcnt lgkmcnt(0)" ::: "memory");
    const int c = lane & 7;
#pragma unroll
    for (int j = 0; j < 4; ++j) { const int n = (lane >> 3) + 8 * j; const LAS float* s = scr + (8 * c) * 33 + n;
        u32x4 o; o.x = cvt_pk_bf16(s[0 * 33], s[1 * 33]); o.y = cvt_pk_bf16(s[2 * 33], s[3 * 33]); o.z = cvt_pk_bf16(s[4 * 33], s[5 * 33]); o.w = cvt_pk_bf16(s[6 * 33], s[7 * 33]);
        *(u32x4*)(WT + (size_t)(n0 + n) * K + k0 + 8 * c) = o; }
    asm volatile("s_waitcnt lgkmcnt(0)" ::: "memory");
}
__device__ __forceinline__ void sincos_d(double x, float& s, float& c) {
    const double q = __builtin_rint(x * 0.63661977236758134308); const double r = x - q * 1.57079632679489661923; const int qi = (int)q & 3;
    const double r2 = r * r;
    const double sp = r * (1.0 + r2 * (-1.0 / 6 + r2 * (1.0 / 120 + r2 * (-1.0 / 5040 + r2 * (1.0 / 362880 + r2 * (-1.0 / 39916800 + r2 * (1.0 / 6227020800.0)))))));
    const double cp = 1.0 + r2 * (-0.5 + r2 * (1.0 / 24 + r2 * (-1.0 / 720 + r2 * (1.0 / 40320 + r2 * (-1.0 / 3628800 + r2 * (1.0 / 479001600.0))))));
    const double ss = (qi == 0) ? sp : (qi == 1) ? cp : (qi == 2) ? -sp : -cp;
    const double cc = (qi == 0) ? cp : (qi == 1) ? -sp : (qi == 2) ? -cp : sp;
    s = (float)ss; c = (float)cc;
}
__device__ __forceinline__ void g0_prologue(const Ctx& C, LAS unsigned char* lds) {
    const int tid = opaque(threadIdx.x), lane = tid & 63, wid = tid >> 6, G = gridDim.x, bx = blockIdx.x;
    if (bx == G - 1) {
        for (int e = tid; e < 1024; e += 512) { const int pos = e >> 4, i = e & 15;
            const float invf = fexp2(-(float)i * 0.83048202372f);
            const float ang = (float)pos * invf; float s, c; sincos_d((double)ang, s, c);
            C.rope[e * 2] = c; C.rope[e * 2 + 1] = s; }
    }
    constexpr int NMODT = 2 * 48;
    const int nmodb = (G >= 2 * NMODT) ? NMODT : G;
    if (bx < nmodb) {
        LAS float* sl = (LAS float*)lds + wid * (33 * 64);
        for (int task = bx; task < NMODT; task += nmodb) {
            const int l = task / 48, cb = task % 48, col = cb * 64 + lane;
            const float* W = C.mod_w + (size_t)l * DM * 3072;
            float acc[33];
#pragma unroll
            for (int r = 0; r < 33; ++r) acc[r] = 0.f;
            for (int kc = 0; kc < 2; ++kc) {
                const int k0 = wid * 128 + kc * 64;
#pragma unroll
                for (int r = 0; r < 33; ++r) { const float v = (r < 32) ? C.c[r * DM + k0 + lane] : C.c_ctx[k0 + lane]; sl[r * 64 + lane] = siluf_(v); }
                asm volatile("s_waitcnt lgkmcnt(0)" ::: "memory");
                for (int k4 = 0; k4 < 16; ++k4) {
                    const float w0 = W[(size_t)(k0 + 4 * k4 + 0) * 3072 + col], w1 = W[(size_t)(k0 + 4 * k4 + 1) * 3072 + col],
                                w2 = W[(size_t)(k0 + 4 * k4 + 2) * 3072 + col], w3 = W[(size_t)(k0 + 4 * k4 + 3) * 3072 + col];
#pragma unroll
                    for (int r = 0; r < 33; ++r) { const f32x4 sv = *(const LAS f32x4*)(sl + r * 64 + 4 * k4); acc[r] += sv[0] * w0 + sv[1] * w1 + sv[2] * w2 + sv[3] * w3; }
                }
                asm volatile("s_waitcnt lgkmcnt(0)" ::: "memory");
            }
            __syncthreads();
#pragma unroll
            for (int r = 0; r < 33; ++r) sl[r * 64 + lane] = acc[r];
            __syncthreads();
            for (int e = tid; e < 33 * 64; e += 512) { float s = 0.f;
#pragma unroll
                for (int w = 0; w < 8; ++w) s += ((LAS float*)lds)[w * (33 * 64) + e];
                const int r = e >> 6, cc = cb * 64 + (e & 63);
                C.mod[((size_t)l * 33 + r) * 3072 + cc] = s + C.mod_b[l * 3072 + cc]; }
            __syncthreads();
        }
    }
    {
        const bool all = (nmodb == G);
        if (all || bx >= nmodb) {
            const int nb = all ? G : G - nmodb, b0 = all ? bx : bx - nmodb;
            LAS float* scr = (LAS float*)lds + wid * (64 * 33 + 16);
            constexpr int I_IN = 16 * (DIN / 32), I_OUT = 16 * 32, I_UP = 8;
            constexpr int NITEMS = 2 * I_IN + 2 * I_OUT + 16 * I_UP;
            for (int it = b0 * 8 + wid; it < NITEMS; it += nb * 8) {
                int r = it;
                if (r < 2 * I_IN) { const int l = r / I_IN; transpose_item(C.w_in + (size_t)l * DM * DIN, DM, DIN, C.WinT + (size_t)l * DIN * DM, scr, r % I_IN, lane, true); continue; } r -= 2 * I_IN;
                if (r < 2 * I_OUT) { const int l = r / I_OUT; transpose_item(C.w_out + (size_t)l * DM * DM, DM, DM, C.WoutT + (size_t)l * DM * DM, scr, r % I_OUT, lane, false); continue; } r -= 2 * I_OUT;
                { const int mi = r / I_UP, l = mi >> 2, m = mi & 3, d = m & 1;
                  const float* src = ((m < 2) ? C.w_up : C.a_up) + (size_t)(l * 2 + d) * 64 * 256;
                  transpose_item(src, 64, 256, C.WupT + (size_t)(l * 4 + m) * 256 * 64, scr, r % I_UP, lane, false); }
            }
        }
    }
}

template <int MODE>
__device__ __forceinline__ void norm_phase(const Ctx& C, int hf, int gw, int ngw, int lane_in, float pe1 = 0.f, float pe2 = 0.f) {
    const int lane = opaque(lane_in);
    const int nrows = (MODE == 2) ? LATH : MH;
    for (int lr0 = gw * 2; lr0 < nrows; lr0 += ngw * 2) {
        const bool lat = lr0 < LATH;
        int mrow; const float* xin; float* x1p;
        if (lat) { const size_t g = (size_t)hf * LATH + lr0; mrow = hf * HB + lr0 / SEQ; xin = C.x + g * DM; x1p = C.out + g * DM; }
        else { const size_t g = (size_t)hf * CTXH + (lr0 - LATH); mrow = 32; xin = C.ctx + g * DM; x1p = C.xc1 + g * DM; }
        f32x4 v[2][4];
        const float* base = (MODE == 2) ? x1p : xin;
#pragma unroll
        for (int rr = 0; rr < 2; ++rr)
#pragma unroll
            for (int j = 0; j < 4; ++j) v[rr][j] = __builtin_nontemporal_load((const f32x4*)(base + rr * DM + 4 * lane + 256 * j));
        if (MODE >= 1) {
            const float* gate = C.mod + ((size_t)(MODE - 1) * 33 + mrow) * 3072 + 2048;
            const float* pg = C.post_g + (MODE - 1) * DM;
            const bf16_t* yr = C.Y + (size_t)lr0 * DM;
            f32x4 y[2][4]; float ss[2];
#pragma unroll
            for (int rr = 0; rr < 2; ++rr) { ss[rr] = 0.f;
#pragma unroll
                for (int j = 0; j < 4; ++j) { { const u32x2 yw_ = __builtin_nontemporal_load((const u32x2*)(yr + rr * DM + 4 * lane + 256 * j)); y[rr][j] = (f32x4){bf_lo(yw_.x), bf_hi(yw_.x), bf_lo(yw_.y), bf_hi(yw_.y)}; } ss[rr] += (y[rr][j][0] * y[rr][j][0] + y[rr][j][1] * y[rr][j][1]) + (y[rr][j][2] * y[rr][j][2] + y[rr][j][3] * y[rr][j][3]); } }
            const float rstd0 = __builtin_amdgcn_rsqf(wave_sum(ss[0]) * (1.f / DM) + NORM_EPS), rstd1 = __builtin_amdgcn_rsqf(wave_sum(ss[1]) * (1.f / DM) + NORM_EPS);
#pragma unroll
            for (int j = 0; j < 4; ++j) { const f32x4 gt = *(const f32x4*)(gate + 4 * lane + 256 * j), pgv = *(const f32x4*)(pg + 4 * lane + 256 * j);
#pragma unroll
                for (int rr = 0; rr < 2; ++rr) {
                    v[rr][j] = v[rr][j] + gt * (y[rr][j] * (rr ? rstd1 : rstd0) * pgv);
#ifdef PROBE_A
                    if (MODE == 2 && hf == 1 && lr0 + rr < 1024) { v[rr][j] = v[rr][j] + pe2; if (lr0 + rr == 0 && lane == 0 && j == 0) v[rr][j][0] += pe1; }
#endif
                    __builtin_nontemporal_store(v[rr][j], (f32x4*)(x1p + rr * DM + 4 * lane + 256 * j)); } }
        }
        if (MODE <= 1) {
            const float* md = C.mod + ((size_t)MODE * 33 + mrow) * 3072;
            const float* pre = C.pre_g + MODE * DM;
            float ss[2];
#pragma unroll
            for (int rr = 0; rr < 2; ++rr) { ss[rr] = 0.f;
#pragma unroll
                for (int j = 0; j < 4; ++j) ss[rr] += (v[rr][j][0] * v[rr][j][0] + v[rr][j][1] * v[rr][j][1]) + (v[rr][j][2] * v[rr][j][2] + v[rr][j][3] * v[rr][j][3]); }
            const float rstd0 = __builtin_amdgcn_rsqf(wave_sum(ss[0]) * (1.f / DM) + NORM_EPS), rstd1 = __builtin_amdgcn_rsqf(wave_sum(ss[1]) * (1.f / DM) + NORM_EPS);
            bf16_t* hr = C.H + (size_t)lr0 * DM;
#pragma unroll
            for (int j = 0; j < 4; ++j) { const f32x4 sh = *(const f32x4*)(md + 4 * lane + 256 * j), scl = *(const f32x4*)(md + 1024 + 4 * lane + 256 * j), pv = *(const f32x4*)(pre + 4 * lane + 256 * j);
#pragma unroll
                for (int rr = 0; rr < 2; ++rr) st_bf4(hr + rr * DM + 4 * lane + 256 * j, (v[rr][j] * (rr ? rstd1 : rstd0) * pv) * (1.f + scl) + sh); }
        }
    }
}

__device__ __forceinline__ int crow(int r, int hi) { return (r & 3) + 8 * (r >> 2) + 4 * hi; }
__device__ __forceinline__ bf16x8 tanh8(bf16x8 x) {
    const u32x4 w = __builtin_bit_cast(u32x4, x); u32x4 o;
#pragma unroll
    for (int i = 0; i < 4; ++i) { const float a = bf_lo(w[i]), b = bf_hi(w[i]);
        const float ta = 1.f - 2.f * frcp(1.f + fexp2(2.885390081777927f * a)), tb = 1.f - 2.f * frcp(1.f + fexp2(2.885390081777927f * b));
        o[i] = cvt_pk_bf16(ta, tb); }
    return __builtin_bit_cast(bf16x8, o);
}
__device__ __forceinline__ void prep_block(const Ctx& C, int l, int task, LAS unsigned char* lds) {
    const int tid = opaque(threadIdx.x), lane = tid & 63, wid = __builtin_amdgcn_readfirstlane(tid >> 6);
    const int r32 = lane & 31, hi = lane >> 5, lr0 = task * 64;
    constexpr int PST = 520;
    LAS bf16_t* xs = (LAS bf16_t*)lds;
#pragma unroll
    for (int i = 0; i < 8; ++i) { const int idx = tid + 512 * i, row = idx >> 6, ch = idx & 63;
        const u32x4 v = *(const u32x4*)(C.P + (size_t)(lr0 + row) * DIN + (ch < 32 ? C_K + ch * 8 : C_LWF + (ch - 32) * 8));
        *(LAS u32x4*)(xs + row * PST + ch * 8) = v; }
    __syncthreads();
    const int tg = wid & 1, q = wid >> 1, lrw = lr0 + tg * 32;
    const LAS bf16_t* xrow = xs + (tg * 32 + r32) * PST + hi * 8;
    const LAS bf16_t* xcol = xs + (tg * 32) * PST;
    const bf16_t* WT = C.WupT + (size_t)l * 4 * 256 * 64;
    constexpr size_t ARR = (size_t)MH * 256;
#pragma unroll 1
    for (int d = 0; d < 2; ++d) {
        bf16x8 xf[4];
#pragma unroll
        for (int i0 = 0; i0 < 4; ++i0) xf[i0] = tanh8(*(const LAS bf16x8*)(xrow + 256 + d * 64 + i0 * 16));
        const bf16_t* wt = WT + (size_t)d * 256 * 64;
        const float* w0 = C.w0 + (l * 2 + d) * 256;
        float* dst = C.SC + (size_t)d * ARR;
#pragma unroll 1
        for (int jb = 2 * q; jb < 2 * q + 2; ++jb) {
            const int j = jb * 32 + r32;
            f32x16 acc = {};
#pragma unroll
            for (int i0 = 0; i0 < 4; ++i0) { const bf16x8 wf = *(const bf16x8*)(wt + (size_t)j * 64 + i0 * 16 + hi * 8); acc = __builtin_amdgcn_mfma_f32_32x32x16_bf16(xf[i0], wf, acc, 0, 0, 0); }
            const float w0j = w0[j];
#pragma unroll
            for (int r = 0; r < 16; ++r) { const int row = lrw + crow(r, hi);
                const float sg = sigmoidf_(acc[r] + w0j);
                dst[(size_t)row * 256 + j] = fexp2(-0.8750429636f * sg); }
        }
    }
    {
        const int hd = q;
        float rn[16];
        { const float kk0 = C.k_k[l * 256 + hd * 64 + r32], kk1 = C.k_k[l * 256 + hd * 64 + 32 + r32];
#pragma unroll
          for (int r = 0; r < 16; ++r) { const LAS bf16_t* kp = xcol + crow(r, hi) * PST + hd * 64 + r32;
              const float a = bf2f(kp[0]) * kk0, b = bf2f(kp[32]) * kk1; const float s = sum32(a * a + b * b);
              rn[r] = frcp(fmaxf(__builtin_sqrtf(s), 1e-12f)); } }
#pragma unroll 1
        for (int jd = 0; jd < 4; ++jd) {
            const int jb2 = jd >> 1, d = jd & 1;
            const int j = hd * 64 + jb2 * 32 + r32;
            const float kkj = C.k_k[l * 256 + j], kaj = C.k_a[l * 256 + j];
            const bf16_t* wt = WT + (size_t)(2 + d) * 256 * 64;
            f32x16 acc = {};
#pragma unroll
            for (int i0 = 0; i0 < 4; ++i0) { const bf16x8 xf = *(const LAS bf16x8*)(xrow + 384 + d * 64 + i0 * 16);
                const bf16x8 wf = *(const bf16x8*)(wt + (size_t)j * 64 + i0 * 16 + hi * 8); acc = __builtin_amdgcn_mfma_f32_32x32x16_bf16(xf, wf, acc, 0, 0, 0); }
            const float a0j = C.a0[(l * 2 + d) * 256 + j];
            bf16_t* sb16 = (bf16_t*)(C.SC + 2 * ARR);
            bf16_t* dkm = sb16 + (size_t)d * ARR; bf16_t* dbb = sb16 + (size_t)(2 + d) * ARR; bf16_t* daa = sb16 + 4 * ARR;
#pragma unroll
            for (int r = 0; r < 16; ++r) { const int cr = crow(r, hi); const size_t off = (size_t)(lrw + cr) * 256 + j;
                const float k = bf2f(xcol[cr * PST + j]);
                const float a = sigmoidf_(acc[r] + a0j), kkn = k * kkj * rn[r];
                const unsigned pk_ = cvt_pk_bf16(k * (1.f + (a - 1.f) * kaj), kkn * a);
                dkm[off] = (bf16_t)(pk_ & 0xffffu); dbb[off] = (bf16_t)(pk_ >> 16); if (d == 0) daa[off] = (bf16_t)(cvt_pk_bf16(-kkn, 0.f) & 0xffffu); }
        }
    }
    __syncthreads();
}
__device__ __forceinline__ void rowpass4(const Ctx& C, int l, int r0, int lane_in, bool do_conv) {
    const int lane = opaque(lane_in);
    const bool lat = r0 < LATH; const int t0 = lat ? (r0 & (SEQ - 1)) : ((r0 - LATH) & (CTX - 1)), len = lat ? SEQ : CTX;
    const bf16_t* pr = C.P + (size_t)r0 * DIN; const int c = 4 * lane;
    u32x4 qw[4], kw[4];
    if (lat) {
#pragma unroll
        for (int i = 0; i < 4; ++i) { qw[i] = *(const u32x4*)(pr + (size_t)i * DIN + C_AQ + 8 * lane); kw[i] = *(const u32x4*)(pr + (size_t)i * DIN + C_AK + 8 * lane); }
    }
    if (do_conv) {
        f32x4 u[6], bg[4], z[4];
#pragma unroll
        for (int i = 0; i < 6; ++i) { const bool ok = (i == 0) ? (t0 > 0) : (i == 5) ? (t0 + 4 < len) : true;
            const bf16_t* p = pr + (long)(i - 1) * DIN;
            u[i] = ok ? ld_bf4_nt(p + C_CC + c) * ld_bf4_nt(p + C_CH + c) : (f32x4){0.f, 0.f, 0.f, 0.f}; }
#pragma unroll
        for (int i = 0; i < 4; ++i) { bg[i] = ld_bf4_nt(pr + (size_t)i * DIN + C_CB + c); z[i] = ld_bf4_nt(pr + (size_t)i * DIN + C_CZ + c); }
        const float* cw = C.conv_w + l * 3 * 256 + c;
        const f32x4 w0 = *(const f32x4*)cw, w1 = *(const f32x4*)(cw + 256), w2 = *(const f32x4*)(cw + 512);
#pragma unroll
        for (int i = 0; i < 4; ++i) { const f32x4 y = u[i] * w0 + u[i + 1] * w1 + u[i + 2] * w2;
            f32x4 o; o[0] = bg[i][0] * y[0] * siluf_(z[i][0]); o[1] = bg[i][1] * y[1] * siluf_(z[i][1]); o[2] = bg[i][2] * y[2] * siluf_(z[i][2]); o[3] = bg[i][3] * y[3] * siluf_(z[i][3]);
            st_bf4(C.H + (size_t)(r0 + i) * DM + 256 + c, o); }
    }
    if (lat) {
        const float sg = (lane & 2) ? 1.f : -1.f;
#pragma unroll
        for (int i = 0; i < 4; ++i) {
            const int t = t0 + i; const int pos = ((lane >> 2) & 1) ? (t & 63) : (t >> 6);
            const f32x4* rp = (const f32x4*)(C.rope + (pos * 16 + 8 * (lane & 1)) * 2);
            const f32x4 c0 = rp[0], c1 = rp[1], c2 = rp[2], c3 = rp[3];
#pragma unroll
            for (int which = 0; which < 2; ++which) {
                const u32x4 w = which ? kw[i] : qw[i]; u32x4 pw;
#pragma unroll
                for (int e = 0; e < 4; ++e) pw[e] = (unsigned)__builtin_amdgcn_update_dpp(0, (int)w[e], 0x4E, 0xF, 0xF, true);
                u32x4 o;
                o[0] = cvt_pk_bf16(bf_lo(w[0]) * c0[0] + sg * bf_lo(pw[0]) * c0[1], bf_hi(w[0]) * c0[2] + sg * bf_hi(pw[0]) * c0[3]);
                o[1] = cvt_pk_bf16(bf_lo(w[1]) * c1[0] + sg * bf_lo(pw[1]) * c1[1], bf_hi(w[1]) * c1[2] + sg * bf_hi(pw[1]) * c1[3]);
                o[2] = cvt_pk_bf16(bf_lo(w[2]) * c2[0] + sg * bf_lo(pw[2]) * c2[1], bf_hi(w[2]) * c2[2] + sg * bf_hi(pw[2]) * c2[3]);
                o[3] = cvt_pk_bf16(bf_lo(w[3]) * c3[0] + sg * bf_lo(pw[3]) * c3[1], bf_hi(w[3]) * c3[2] + sg * bf_hi(pw[3]) * c3[3]);
                *(u32x4*)(C.P + (size_t)(r0 + i) * DIN + (which ? C_AK : C_AQ) + 8 * lane) = o;
            }
        }
    }
}
__device__ __forceinline__ void conv_row(const Ctx& C, int l, int lr, int lane_in) {
    const int lane = opaque(lane_in);
    const bool lat = lr < LATH; const int t = lat ? (lr & (SEQ - 1)) : ((lr - LATH) & (CTX - 1)), len = lat ? SEQ : CTX;
    const bf16_t* pr = C.P + (size_t)lr * DIN; const int c = 4 * lane;
    const float* cw = C.conv_w + l * 3 * 256 + c;
    const f32x4 w0 = *(const f32x4*)cw, w1 = *(const f32x4*)(cw + 256), w2 = *(const f32x4*)(cw + 512);
    f32x4 y = (ld_bf4(pr + C_CC + c) * ld_bf4(pr + C_CH + c)) * w1;
    if (t > 0) y = y + (ld_bf4(pr - DIN + C_CC + c) * ld_bf4(pr - DIN + C_CH + c)) * w0;
    if (t < len - 1) y = y + (ld_bf4(pr + DIN + C_CC + c) * ld_bf4(pr + DIN + C_CH + c)) * w2;
    const f32x4 bg = ld_bf4(pr + C_CB + c), z = ld_bf4(pr + C_CZ + c);
    f32x4 o; o[0] = bg[0] * y[0] * siluf_(z[0]); o[1] = bg[1] * y[1] * siluf_(z[1]); o[2] = bg[2] * y[2] * siluf_(z[2]); o[3] = bg[3] * y[3] * siluf_(z[3]);
    st_bf4(C.H + (size_t)lr * DM + 256 + c, o);
}

__device__ __forceinline__ void rope_row(const Ctx& C, int lr, int lane_in) {
    const int lane = opaque(lane_in);
    const int t = lr & (SEQ - 1); const int pos = ((lane >> 2) & 1) ? (t & 63) : (t >> 6);
    const f32x4* rp = (const f32x4*)(C.rope + (pos * 16 + 8 * (lane & 1)) * 2);
    const f32x4 c0 = rp[0], c1 = rp[1], c2 = rp[2], c3 = rp[3];
    const float sg = (lane & 2) ? 1.f : -1.f;
#pragma unroll
    for (int which = 0; which < 2; ++which) {
        bf16_t* p = C.P + (size_t)lr * DIN + (which ? C_AK : C_AQ) + 8 * lane;
        const u32x4 w = *(const u32x4*)p; u32x4 pw;
#pragma unroll
        for (int i = 0; i < 4; ++i) pw[i] = (unsigned)__builtin_amdgcn_update_dpp(0, (int)w[i], 0x4E, 0xF, 0xF, true);
        u32x4 o;
        o[0] = cvt_pk_bf16(bf_lo(w[0]) * c0[0] + sg * bf_lo(pw[0]) * c0[1], bf_hi(w[0]) * c0[2] + sg * bf_hi(pw[0]) * c0[3]);
        o[1] = cvt_pk_bf16(bf_lo(w[1]) * c1[0] + sg * bf_lo(pw[1]) * c1[1], bf_hi(w[1]) * c1[2] + sg * bf_hi(pw[1]) * c1[3]);
        o[2] = cvt_pk_bf16(bf_lo(w[2]) * c2[0] + sg * bf_lo(pw[2]) * c2[1], bf_hi(w[2]) * c2[2] + sg * bf_hi(pw[2]) * c2[3]);
        o[3] = cvt_pk_bf16(bf_lo(w[3]) * c3[0] + sg * bf_lo(pw[3]) * c3[1], bf_hi(w[3]) * c3[2] + sg * bf_hi(pw[3]) * c3[3]);
        *(u32x4*)p = o;
    }
}

__device__ __forceinline__ int scan_row(int s, int dir, int bl) {
    if (s < CTX) { const int t = dir ? (CTX - 1 - s) : s; return LATH + bl * CTX + t; }
    const int t0 = s - CTX; const int t = dir ? (SEQ - 1 - t0) : t0; return bl * SEQ + t;
}
__device__ __forceinline__ void scan_unit(const Ctx& C, int l, int u, LAS unsigned char* lds) {
    const int bl = u >> 3, hd = (u >> 1) & 3, dir = u & 1;
    const int tid = opaque(threadIdx.x), lane = tid & 63, wid = __builtin_amdgcn_readfirstlane(tid >> 6);
    constexpr size_t ARR = (size_t)MH * 256;
    constexpr int CHF = 32 * 6 * 64;
    constexpr int YB0 = 2 * CHF;
    const int lst = tid >> 4, q4 = tid & 15;
    const float* a_dec = C.SC + (size_t)dir * ARR + hd * 64 + q4 * 4;
    const bf16_t* sb16 = (const bf16_t*)(C.SC + 2 * ARR);
    const bf16_t* a_km = sb16 + (size_t)dir * ARR + hd * 64 + q4 * 4;
    const bf16_t* a_bb = sb16 + (size_t)(2 + dir) * ARR + hd * 64 + q4 * 4;
    const bf16_t* a_aa = sb16 + 4 * ARR + hd * 64 + q4 * 4;
    const bf16_t* a_r = C.P + C_R + hd * 64 + q4 * 4;
    const bf16_t* a_v = C.P + C_V + hd * 64 + q4 * 4;
    float* a_y = C.YS + (size_t)dir * ARR + hd * 64 + q4 * 4;
    f32x4 g0, g1, g2, g3, g4, g5;
#define SC_LOAD(c) do { const size_t row_ = (size_t)scan_row((c) * 32 + lst, dir, bl); \
        g0 = *(const f32x4*)(a_dec + row_ * 256); g1 = ld_bf4(a_km + row_ * 256); g2 = ld_bf4(a_aa + row_ * 256); g3 = ld_bf4(a_bb + row_ * 256); \
        g4 = ld_bf4(a_r + row_ * DIN); g5 = ld_bf4(a_v + row_ * DIN); } while (0)
#define SC_WRITE(b) do { LAS float* d_ = (LAS float*)lds + (b) * CHF + lst * 384 + q4 * 4; \
        *(LAS f32x4*)(d_) = g0; *(LAS f32x4*)(d_ + 64) = g1; *(LAS f32x4*)(d_ + 128) = g2; *(LAS f32x4*)(d_ + 192) = g3; *(LAS f32x4*)(d_ + 256) = g4; *(LAS f32x4*)(d_ + 320) = g5; } while (0)
    f32x4 S0 = {0.f, 0.f, 0.f, 0.f}, S1 = {0.f, 0.f, 0.f, 0.f};
    const int vq = lane >> 4, k16 = lane & 15;
    const int rloc = 8 * wid + 2 * vq;
    SC_LOAD(0); SC_WRITE(0); __syncthreads();
    constexpr int NCH = (CTX + SEQ) / 32;
#pragma unroll 1
    for (int c = 0; c < NCH; ++c) {
        if (c > 0 && ((c - 1 >= CTX / 32) || (l == 0))) {
            const f32x4 yv = *(const LAS f32x4*)((const LAS float*)lds + YB0 + ((c - 1) & 1) * 2048 + lst * 64 + q4 * 4);
            *(f32x4*)(a_y + (size_t)scan_row((c - 1) * 32 + lst, dir, bl) * 256) = yv;
        }
        if (c + 1 < NCH) SC_LOAD(c + 1);
        {
            const LAS float* cb = (const LAS float*)lds + (c & 1) * CHF + k16 * 4;
            const LAS float* vbp = (const LAS float*)lds + (c & 1) * CHF + 320 + rloc;
            LAS float* yb = (LAS float*)lds + YB0 + (c & 1) * 2048 + rloc + (k16 & 1);
            const bool wout = (c >= CTX / 32) || (l == 0);
            f32x4 wA, kA, aA, bA, rA, wB, kB, aB, bB, rB; f32x2 vA, vB;
#define SC_RD(W, K, A, B, R, V, s) do { const LAS float* sb_ = cb + (s) * 384; W = *(const LAS f32x4*)(sb_); K = *(const LAS f32x4*)(sb_ + 64); A = *(const LAS f32x4*)(sb_ + 128); \
        B = *(const LAS f32x4*)(sb_ + 192); R = *(const LAS f32x4*)(sb_ + 256); V = *(const LAS f32x2*)(vbp + (s) * 384); } while (0)
#define SC_STEP(W, K, A, B, R, V, DOST, s) do { \
        float sa0 = fmaf(S0[3], A[3], fmaf(S0[2], A[2], fmaf(S0[1], A[1], S0[0] * A[0]))); \
        float sa1 = fmaf(S1[3], A[3], fmaf(S1[2], A[2], fmaf(S1[1], A[1], S1[0] * A[0]))); \
        sa0 = sum16(sa0); sa1 = sum16(sa1); \
        S0 = S0 * W + sa0 * B + V[0] * K; S1 = S1 * W + sa1 * B + V[1] * K; \
        if (DOST) { \
        float y0 = fmaf(S0[3], R[3], fmaf(S0[2], R[2], fmaf(S0[1], R[1], S0[0] * R[0]))); \
        float y1 = fmaf(S1[3], R[3], fmaf(S1[2], R[2], fmaf(S1[1], R[1], S1[0] * R[0]))); \
        y0 = sum16(y0); y1 = sum16(y1); \
        yb[(s) * 64] = (k16 & 1) ? y1 : y0; } } while (0)
            SC_RD(wA, kA, aA, bA, rA, vA, 0);
            if (wout) {
#pragma unroll 2
                for (int s = 0; s < 32; s += 2) { SC_RD(wB, kB, aB, bB, rB, vB, s + 1); SC_STEP(wA, kA, aA, bA, rA, vA, true, s);
                                                  SC_RD(wA, kA, aA, bA, rA, vA, s + 2); SC_STEP(wB, kB, aB, bB, rB, vB, true, s + 1); }
            } else {
#pragma unroll 2
                for (int s = 0; s < 32; s += 2) { SC_RD(wB, kB, aB, bB, rB, vB, s + 1); SC_STEP(wA, kA, aA, bA, rA, vA, false, s);
                                                  SC_RD(wA, kA, aA, bA, rA, vA, s + 2); SC_STEP(wB, kB, aB, bB, rB, vB, false, s + 1); }
            }
#undef SC_RD
#undef SC_STEP
        }
        if (c + 1 < NCH) SC_WRITE((c + 1) & 1);
        __syncthreads();
    }
    { const f32x4 yv = *(const LAS f32x4*)((const LAS float*)lds + YB0 + ((NCH - 1) & 1) * 2048 + lst * 64 + q4 * 4);
      *(f32x4*)(a_y + (size_t)scan_row((NCH - 1) * 32 + lst, dir, bl) * 256) = yv; }
    __syncthreads();
#undef SC_LOAD
#undef SC_WRITE
}

constexpr int CK_RAW = 0, CK_XA = 24576, CK_ZB = 29184, CK_EZ = 33792  , CK_UV = 44032  , CK_PP = 54272, CK_S0 = 56832, CK_GF = 66048, CK_R0 = 70656, CK_DC = 79872  , CK_END = 80384;
__device__ __forceinline__ void ck_images(LAS float* RAW, LAS bf16_t* XA, LAS bf16_t* ZB, LAS bf16_t* EZ, LAS bf16_t* UV, LAS float* DC, int s) {
    const int lt = s >> 5, kp = (s & 31) * 2;
    float c0 = 1.f, c1 = 1.f, cp0 = 1.f, cp1 = 1.f, ct0 = 1.f, ct1 = 1.f;
#pragma unroll
    for (int j = 0; j < 16; ++j) { const f32x2 w = *(const LAS f32x2*)(RAW + j * 64 + kp); if (j == lt) { cp0 = c0; cp1 = c1; } c0 *= w[0]; c1 *= w[1]; if (j == lt) { ct0 = c0; ct1 = c1; } }
    const f32x2 aa = *(const LAS f32x2*)(RAW + 1024 + lt * 64 + kp), bb = *(const LAS f32x2*)(RAW + 2048 + lt * 64 + kp), km = *(const LAS f32x2*)(RAW + 3072 + lt * 64 + kp),
                rr = *(const LAS f32x2*)(RAW + 4096 + lt * 64 + kp), vv = *(const LAS f32x2*)(RAW + 5120 + lt * 64 + kp);
    const float en0 = frcp(ct0), en1 = frcp(ct1), ee0 = c0 * en0, ee1 = c1 * en1;
    *(LAS unsigned*)(XA + lt * 72 + kp) = cvt_pk_bf16(aa[0] * cp0, aa[1] * cp1);
    *(LAS unsigned*)(XA + (16 + lt) * 72 + kp) = cvt_pk_bf16(rr[0] * ct0, rr[1] * ct1);
    *(LAS unsigned*)(ZB + lt * 72 + kp) = cvt_pk_bf16(bb[0] * en0, bb[1] * en1);
    *(LAS unsigned*)(ZB + (16 + lt) * 72 + kp) = cvt_pk_bf16(km[0] * en0, km[1] * en1);
    const unsigned eb = cvt_pk_bf16(bb[0] * ee0, bb[1] * ee1), ek = cvt_pk_bf16(km[0] * ee0, km[1] * ee1), ev = cvt_pk_bf16(vv[0], vv[1]);
    EZ[kp * 40 + lt] = (bf16_t)(eb & 0xffffu); EZ[(kp + 1) * 40 + lt] = (bf16_t)(eb >> 16);
    EZ[kp * 40 + 16 + lt] = (bf16_t)(ek & 0xffffu); EZ[(kp + 1) * 40 + 16 + lt] = (bf16_t)(ek >> 16);
    UV[kp * 40 + 16 + lt] = (bf16_t)(ev & 0xffffu); UV[(kp + 1) * 40 + 16 + lt] = (bf16_t)(ev >> 16);
    if (lt == 0) *(LAS f32x2*)(DC + kp) = (f32x2){c0, c1};
}
__device__ __forceinline__ void scan_chunked(const Ctx& C, int l, int u, LAS unsigned char* lds) {
    const int bl = u >> 3, hd = (u >> 1) & 3, dir = u & 1;
    const int tid0 = opaque(threadIdx.x), wid = __builtin_amdgcn_readfirstlane(tid0 >> 6);
    constexpr size_t ARR = (size_t)MH * 256;
    LAS float* RAW = (LAS float*)(lds + CK_RAW);
    LAS bf16_t* XA = (LAS bf16_t*)(lds + CK_XA);
    LAS bf16_t* ZB = (LAS bf16_t*)(lds + CK_ZB);
    LAS bf16_t* EZ0 = (LAS bf16_t*)(lds + CK_EZ);
    LAS bf16_t* UV0 = (LAS bf16_t*)(lds + CK_UV);
    LAS bf16_t* PP = (LAS bf16_t*)(lds + CK_PP);
    LAS bf16_t* S0 = (LAS bf16_t*)(lds + CK_S0);
    LAS float* GF = (LAS float*)(lds + CK_GF);
    LAS float* R0 = (LAS float*)(lds + CK_R0);
    LAS float* DC0 = (LAS float*)(lds + CK_DC);
    const bf16_t* sb16 = (const bf16_t*)(C.SC + 2 * ARR);
    f32x2 ld_w; unsigned ld_km, ld_bb, ld_aa, ld_r, ld_v;
#define CK_LOAD(c) do { const int tl_ = opaque(tid0); const size_t row_ = (size_t)scan_row((c) * 16 + (tl_ >> 5), dir, bl); const size_t o2_ = row_ * 256 + hd * 64 + (tl_ & 31) * 2, op_ = row_ * DIN + hd * 64 + (tl_ & 31) * 2; \
        ld_w = __builtin_nontemporal_load((const f32x2*)(C.SC + (size_t)dir * ARR + o2_)); ld_km = __builtin_nontemporal_load((const unsigned*)(sb16 + (size_t)dir * ARR + o2_)); \
        ld_bb = __builtin_nontemporal_load((const unsigned*)(sb16 + (size_t)(2 + dir) * ARR + o2_)); ld_aa = __builtin_nontemporal_load((const unsigned*)(sb16 + 4 * ARR + o2_)); ld_r = __builtin_nontemporal_load((const unsigned*)(C.P + C_R + op_)); ld_v = __builtin_nontemporal_load((const unsigned*)(C.P + C_V + op_)); } while (0)
#define CK_STORE() do { const int ts_ = opaque(tid0); LAS float* q_ = RAW + (ts_ >> 5) * 64 + (ts_ & 31) * 2; \
        *(LAS f32x2*)(q_) = ld_w; *(LAS f32x2*)(q_ + 1024) = (f32x2){bf_lo(ld_aa), bf_hi(ld_aa)}; \
        *(LAS f32x2*)(q_ + 2048) = (f32x2){bf_lo(ld_bb), bf_hi(ld_bb)}; *(LAS f32x2*)(q_ + 3072) = (f32x2){bf_lo(ld_km), bf_hi(ld_km)}; \
        *(LAS f32x2*)(q_ + 4096) = (f32x2){bf_lo(ld_r), bf_hi(ld_r)}; *(LAS f32x2*)(q_ + 5120) = (f32x2){bf_lo(ld_v), bf_hi(ld_v)}; } while (0)
    for (int e = tid0; e < CK_END / 4; e += 512) ((LAS unsigned*)lds)[e] = 0u;
    __syncthreads();
    f32x16 S = {};
    const int vt = (wid >> 1) & 1, kt = wid & 1;
    constexpr int NCH = (CTX + SEQ) / 16;
    CK_LOAD(0); CK_STORE(); __syncthreads();
    ck_images(RAW, XA, ZB, EZ0, UV0, DC0, opaque(tid0));
    CK_LOAD(1);
    __syncthreads();
#pragma unroll 1
    for (int c = 0; c < NCH; ++c) {
        const int pb = c & 1;
        LAS bf16_t* EZ = EZ0 + pb * (64 * 40); LAS bf16_t* UV = UV0 + pb * (64 * 40); LAS float* DC = DC0 + pb * 64;
        if (c + 1 < NCH) CK_STORE();
        if (c + 2 < NCH) CK_LOAD(c + 2);
        if (wid == 0) {
            const int ln = opaque(tid0) & 63, r32 = ln & 31, hi = ln >> 5;
            f32x16 acc = {};
#pragma unroll
            for (int d0 = 0; d0 < 4; ++d0) { const bf16x8 a = *(const LAS bf16x8*)(XA + r32 * 72 + d0 * 16 + hi * 8), b = *(const LAS bf16x8*)(ZB + r32 * 72 + d0 * 16 + hi * 8);
                acc = __builtin_amdgcn_mfma_f32_32x32x16_bf16(a, b, acc, 0, 0, 0); }
#pragma unroll
            for (int r = 0; r < 16; ++r) GF[crow(r, hi) * 36 + r32] = acc[r];
        } else if (wid <= 2) {
            const int ln = opaque(tid0) & 63, r32 = ln & 31, hi = ln >> 5;
            const int v0 = (wid - 1) * 32;
            f32x16 acc = {};
#pragma unroll
            for (int d0 = 0; d0 < 4; ++d0) { const bf16x8 a = *(const LAS bf16x8*)(S0 + (v0 + r32) * 72 + d0 * 16 + hi * 8), b = *(const LAS bf16x8*)(XA + r32 * 72 + d0 * 16 + hi * 8);
                acc = __builtin_amdgcn_mfma_f32_32x32x16_bf16(a, b, acc, 0, 0, 0); }
#pragma unroll
            for (int r = 0; r < 16; ++r) R0[(v0 + crow(r, hi)) * 36 + r32] = acc[r];
        }
        __syncthreads();
        if (wid == 3) {
            const int v = opaque(tid0) & 63;
            float uu[16], vq[16];
#pragma unroll
            for (int q = 0; q < 4; ++q) { const f32x4 x = *(const LAS f32x4*)(R0 + v * 36 + 4 * q); uu[4 * q] = x[0]; uu[4 * q + 1] = x[1]; uu[4 * q + 2] = x[2]; uu[4 * q + 3] = x[3]; }
#pragma unroll
            for (int q = 0; q < 2; ++q) { const u32x4 x = *(const LAS u32x4*)(UV + v * 40 + 16 + 8 * q);
#pragma unroll
                for (int e = 0; e < 4; ++e) { vq[8 * q + 2 * e] = bf_lo(x[e]); vq[8 * q + 2 * e + 1] = bf_hi(x[e]); } }
#pragma unroll
            for (int t = 1; t < 16; ++t) {
                float a0 = uu[t], a1 = 0.f, a2 = 0.f, a3 = 0.f;
#pragma unroll
                for (int q = 0; q * 4 < t; ++q) { const f32x4 m = *(const LAS f32x4*)(GF + t * 36 + 4 * q), n = *(const LAS f32x4*)(GF + t * 36 + 16 + 4 * q);
#pragma unroll
                    for (int e = 0; e < 4; ++e) if (4 * q + e < t) { if (e & 1) { a1 = fmaf(uu[4 * q + e], m[e], a1); a3 = fmaf(vq[4 * q + e], n[e], a3); } else { a0 = fmaf(uu[4 * q + e], m[e], a0); a2 = fmaf(vq[4 * q + e], n[e], a2); } } }
                uu[t] = (a0 + a1) + (a2 + a3);
            }
            u32x4 w0, w1;
            w0[0] = cvt_pk_bf16(uu[0], uu[1]); w0[1] = cvt_pk_bf16(uu[2], uu[3]); w0[2] = cvt_pk_bf16(uu[4], uu[5]); w0[3] = cvt_pk_bf16(uu[6], uu[7]);
            w1[0] = cvt_pk_bf16(uu[8], uu[9]); w1[1] = cvt_pk_bf16(uu[10], uu[11]); w1[2] = cvt_pk_bf16(uu[12], uu[13]); w1[3] = cvt_pk_bf16(uu[14], uu[15]);
            *(LAS u32x4*)(UV + v * 40) = w0; *(LAS u32x4*)(UV + v * 40 + 8) = w1;
        } else if (wid == 4) {
            const int ln = opaque(tid0) & 63; const int t = ln >> 2, jq = (ln & 3) * 8;
            const f32x4 g0 = *(const LAS f32x4*)(GF + (16 + t) * 36 + jq), g1 = *(const LAS f32x4*)(GF + (16 + t) * 36 + jq + 4);
            float x[8] = {g0[0], g0[1], g0[2], g0[3], g1[0], g1[1], g1[2], g1[3]};
#pragma unroll
            for (int e = 0; e < 8; ++e) { const int i = (jq + e) & 15; if (i > t) x[e] = 0.f; }
            u32x4 w; w[0] = cvt_pk_bf16(x[0], x[1]); w[1] = cvt_pk_bf16(x[2], x[3]); w[2] = cvt_pk_bf16(x[4], x[5]); w[3] = cvt_pk_bf16(x[6], x[7]);
            *(LAS u32x4*)(PP + t * 40 + jq) = w;
        } else if (c + 1 < NCH) {
            const int w6 = (wid < 3) ? wid : wid - 2;
            const int s0 = w6 * 64 + (opaque(tid0) & 63);
            LAS bf16_t* EZn = EZ0 + (pb ^ 1) * (64 * 40); LAS bf16_t* UVn = UV0 + (pb ^ 1) * (64 * 40); LAS float* DCn = DC0 + (pb ^ 1) * 64;
            ck_images(RAW, XA, ZB, EZn, UVn, DCn, s0);
            if (s0 < 128) ck_images(RAW, XA, ZB, EZn, UVn, DCn, s0 + 384);
        }
        __syncthreads();
        if (wid < 4) {
            const int ln = opaque(tid0) & 63, r32 = ln & 31, hi = ln >> 5;
            const float dc = DC[kt * 32 + r32];
#pragma unroll
            for (int r = 0; r < 16; ++r) S[r] *= dc;
#pragma unroll
            for (int js = 0; js < 2; ++js) { const bf16x8 a = *(const LAS bf16x8*)(UV + (vt * 32 + r32) * 40 + js * 16 + hi * 8), b = *(const LAS bf16x8*)(EZ + (kt * 32 + r32) * 40 + js * 16 + hi * 8);
                S = __builtin_amdgcn_mfma_f32_32x32x16_bf16(a, b, S, 0, 0, 0); }
            asm volatile("s_nop 15\n\ts_nop 7" : "+v"(S));
#pragma unroll
            for (int r = 0; r < 16; r += 2) { const unsigned pk = cvt_pk_bf16(S[r], S[r + 1]);
                S0[(vt * 32 + crow(r, hi)) * 72 + kt * 32 + r32] = (bf16_t)(pk & 0xffffu); S0[(vt * 32 + crow(r + 1, hi)) * 72 + kt * 32 + r32] = (bf16_t)(pk >> 16); }
        } else if ((wid == 5 || wid == 6) && ((c >= CTX / 16) || (l == 0))) {
            const int ln = opaque(tid0) & 63, r32 = ln & 31, hi = ln >> 5;
            const int v0 = (wid - 5) * 32;
            f32x16 acc;
#pragma unroll
            for (int r = 0; r < 16; ++r) acc[r] = (r32 < 16) ? R0[(v0 + crow(r, hi)) * 36 + 16 + r32] : 0.f;
#pragma unroll
            for (int js = 0; js < 2; ++js) { const bf16x8 a = *(const LAS bf16x8*)(UV + (v0 + r32) * 40 + js * 16 + hi * 8), b = *(const LAS bf16x8*)(PP + r32 * 40 + js * 16 + hi * 8);
                acc = __builtin_amdgcn_mfma_f32_32x32x16_bf16(a, b, acc, 0, 0, 0); }
            if (r32 < 16) { float* yp = C.YS + (size_t)dir * ARR + hd * 64 + (size_t)scan_row(c * 16 + r32, dir, bl) * 256 + v0 + 4 * hi;
#pragma unroll
                for (int q = 0; q < 4; ++q) *(f32x4*)(yp + 8 * q) = (f32x4){acc[4 * q], acc[4 * q + 1], acc[4 * q + 2], acc[4 * q + 3]}; }
        }
        __syncthreads();
    }
#undef CK_LOAD
#undef CK_STORE
}

#define KSWZ(row, colB) ((row) * 256 + ((colB) ^ (((row) & 7) << 4)))
#define SBAR() __builtin_amdgcn_sched_barrier(0)
constexpr int SHM_KV = 64 * 128 * 2;
constexpr float ATT_THR = 11.5f;
__device__ __forceinline__ int v_st(int k, int c) { const int kk = (k & ~0xC) | ((k & 4) << 1) | ((k & 8) >> 1); return ((kk >> 3) * 4 + (c >> 5)) * 512 + ((kk & 7) * 32 + (c & 31)) * 2; }
__device__ __forceinline__ int v_rd_base(int lane) { return ((lane & 3) << 3) | (((lane >> 2) & 3) << 6) | (((lane >> 4) & 1) << 5) | (((lane >> 5) & 1) << 8); }
constexpr int v_rd_off(int d0, int ks, int half) { return d0 * 512 + ks * 4096 + half * 2048; }
template <int OFF> __device__ __forceinline__ s16x4 tr_read(int vb) { s16x4 r; asm volatile("ds_read_b64_tr_b16 %0, %1 offset:%2" : "=&v"(r) : "v"(vb), "i"(OFF) : "memory"); return r; }
struct VFrag { s16x4 l0, h0, l1, h1, l2, h2, l3, h3; };
template <int D0> __device__ __forceinline__ void v_reads(VFrag& f, int vb) {
    f.l0 = tr_read<v_rd_off(D0, 0, 0)>(vb); f.h0 = tr_read<v_rd_off(D0, 0, 1)>(vb); f.l1 = tr_read<v_rd_off(D0, 1, 0)>(vb); f.h1 = tr_read<v_rd_off(D0, 1, 1)>(vb);
    f.l2 = tr_read<v_rd_off(D0, 2, 0)>(vb); f.h2 = tr_read<v_rd_off(D0, 2, 1)>(vb); f.l3 = tr_read<v_rd_off(D0, 3, 0)>(vb); f.h3 = tr_read<v_rd_off(D0, 3, 1)>(vb);
}
__device__ __forceinline__ void pv_mma(f32x16& od, const VFrag& f, bf16x8 pa0, bf16x8 pa1, bf16x8 pa2, bf16x8 pa3) {
#define PKV(L, H) (bf16x8){L[0], L[1], L[2], L[3], H[0], H[1], H[2], H[3]}
    od = __builtin_amdgcn_mfma_f32_32x32x16_bf16(pa0, PKV(f.l0, f.h0), od, 0, 0, 0);
    od = __builtin_amdgcn_mfma_f32_32x32x16_bf16(pa1, PKV(f.l1, f.h1), od, 0, 0, 0);
    od = __builtin_amdgcn_mfma_f32_32x32x16_bf16(pa2, PKV(f.l2, f.h2), od, 0, 0, 0);
    od = __builtin_amdgcn_mfma_f32_32x32x16_bf16(pa3, PKV(f.l3, f.h3), od, 0, 0, 0);
#undef PKV
}
template <int KS> __device__ __forceinline__ void v_reads_ks(s16x4 (&l)[4], s16x4 (&h)[4], int vb) {
    l[0] = tr_read<v_rd_off(0, KS, 0)>(vb); h[0] = tr_read<v_rd_off(0, KS, 1)>(vb); l[1] = tr_read<v_rd_off(1, KS, 0)>(vb); h[1] = tr_read<v_rd_off(1, KS, 1)>(vb);
    l[2] = tr_read<v_rd_off(2, KS, 0)>(vb); h[2] = tr_read<v_rd_off(2, KS, 1)>(vb); l[3] = tr_read<v_rd_off(3, KS, 0)>(vb); h[3] = tr_read<v_rd_off(3, KS, 1)>(vb);
}
__device__ __forceinline__ void pv_mma_ks(f32x16 (&o)[4], const s16x4 (&l)[4], const s16x4 (&h)[4], bf16x8 pa) {
#define PKV(L, H) (bf16x8){L[0], L[1], L[2], L[3], H[0], H[1], H[2], H[3]}
    __builtin_amdgcn_s_setprio(1);
    o[0] = __builtin_amdgcn_mfma_f32_32x32x16_bf16(pa, PKV(l[0], h[0]), o[0], 0, 0, 0);
    o[1] = __builtin_amdgcn_mfma_f32_32x32x16_bf16(pa, PKV(l[1], h[1]), o[1], 0, 0, 0);
    o[2] = __builtin_amdgcn_mfma_f32_32x32x16_bf16(pa, PKV(l[2], h[2]), o[2], 0, 0, 0);
    o[3] = __builtin_amdgcn_mfma_f32_32x32x16_bf16(pa, PKV(l[3], h[3]), o[3], 0, 0, 0);
    __builtin_amdgcn_s_setprio(0);
#undef PKV
}
__device__ __forceinline__ void pv_all(f32x16 (&o)[4], int vb, bf16x8 pa0, bf16x8 pa1, bf16x8 pa2, bf16x8 pa3) {
    s16x4 l[4], h[4];
    v_reads_ks<0>(l, h, vb); asm volatile("s_waitcnt lgkmcnt(0)" ::: "memory"); SBAR(); pv_mma_ks(o, l, h, pa0);
    v_reads_ks<1>(l, h, vb); asm volatile("s_waitcnt lgkmcnt(0)" ::: "memory"); SBAR(); pv_mma_ks(o, l, h, pa1);
    v_reads_ks<2>(l, h, vb); asm volatile("s_waitcnt lgkmcnt(0)" ::: "memory"); SBAR(); pv_mma_ks(o, l, h, pa2);
    v_reads_ks<3>(l, h, vb); asm volatile("s_waitcnt lgkmcnt(0)" ::: "memory"); SBAR(); pv_mma_ks(o, l, h, pa3);
}
__device__ __forceinline__ void qk_tile(f32x16& p0, f32x16& p1, const bf16x8* qr, const char* Ks, int cb0, int r32, int hi) {
    bf16x8 kf[8];
#pragma unroll
    for (int d0 = 0; d0 < 4; ++d0) { const int cb = cb0 + (d0 * 16 + hi * 8) * 2; kf[2 * d0] = *(const bf16x8*)(Ks + KSWZ(r32, cb)); kf[2 * d0 + 1] = *(const bf16x8*)(Ks + KSWZ(32 + r32, cb)); }
    p0 = f32x16{}; p1 = f32x16{};
    __builtin_amdgcn_s_setprio(1);
#pragma unroll
    for (int d0 = 0; d0 < 4; ++d0) {
        p0 = __builtin_amdgcn_mfma_f32_32x32x16_bf16(kf[2 * d0], qr[d0], p0, 0, 0, 0);
        p1 = __builtin_amdgcn_mfma_f32_32x32x16_bf16(kf[2 * d0 + 1], qr[d0], p1, 0, 0, 0); }
    __builtin_amdgcn_s_setprio(0);
}
__device__ __forceinline__ void sm_pv(f32x16 (&o)[4], f32x16& p0, f32x16& p1, float& m_reg, float& l_reg, int vb, float* al_l, int r32, int hi) {
    float pmax;
    { float m0 = fmaxf(p0[0], p1[0]), m1 = fmaxf(p0[1], p1[1]), m2 = fmaxf(p0[2], p1[2]), m3 = fmaxf(p0[3], p1[3]);
#pragma unroll
      for (int r = 4; r < 16; r += 4) { m0 = fmaxf(fmaxf(m0, p0[r]), p1[r]); m1 = fmaxf(fmaxf(m1, p0[r + 1]), p1[r + 1]); m2 = fmaxf(fmaxf(m2, p0[r + 2]), p1[r + 2]); m3 = fmaxf(fmaxf(m3, p0[r + 3]), p1[r + 3]); }
      pmax = fmaxf(fmaxf(m0, m1), fmaxf(m2, m3)); }
    { auto rr = __builtin_amdgcn_permlane32_swap(__float_as_uint(pmax), __float_as_uint(pmax), false, false); pmax = fmaxf(__uint_as_float(rr[0]), __uint_as_float(rr[1])); }
    float mn, alpha;
    if (__builtin_expect(__all(pmax - m_reg <= ATT_THR), 1)) { mn = m_reg; alpha = 1.f; }
    else { mn = fmaxf(m_reg, pmax); alpha = fexp2(m_reg - mn); m_reg = mn; }
#pragma unroll
    for (int r = 0; r < 16; ++r) { p0[r] = fexp2(p0[r] - mn); p1[r] = fexp2(p1[r] - mn); }
    float ps;
    { float s0 = p0[0] + p1[0], s1 = p0[1] + p1[1], s2 = p0[2] + p1[2], s3 = p0[3] + p1[3];
#pragma unroll
      for (int r = 4; r < 16; r += 4) { s0 += p0[r] + p1[r]; s1 += p0[r + 1] + p1[r + 1]; s2 += p0[r + 2] + p1[r + 2]; s3 += p0[r + 3] + p1[r + 3]; }
      ps = (s0 + s1) + (s2 + s3); }
    { auto rr = __builtin_amdgcn_permlane32_swap(__float_as_uint(ps), __float_as_uint(ps), false, false); ps = __uint_as_float(rr[0]) + __uint_as_float(rr[1]); }
    l_reg = l_reg * alpha + ps;
    if (__any(alpha < 1.f)) { if (hi == 0) al_l[r32] = alpha; asm volatile("s_waitcnt lgkmcnt(0)" ::: "memory");
#pragma unroll
        for (int d = 0; d < 4; ++d)
#pragma unroll
            for (int r = 0; r < 16; ++r) o[d][r] *= al_l[crow(r, hi)]; }
    bf16x8 pa0, pa1, pa2, pa3;
#define PK4(P, BASE, OUT) do { unsigned a0 = cvt_pk_bf16(P[BASE + 0], P[BASE + 1]), a1 = cvt_pk_bf16(P[BASE + 2], P[BASE + 3]); \
        unsigned b0 = cvt_pk_bf16(P[BASE + 4], P[BASE + 5]), b1 = cvt_pk_bf16(P[BASE + 6], P[BASE + 7]); \
        auto r0 = __builtin_amdgcn_permlane32_swap(a0, b0, false, false); auto r1 = __builtin_amdgcn_permlane32_swap(a1, b1, false, false); \
        u32x4 w = {r0[0], r1[0], r0[1], r1[1]}; OUT = __builtin_bit_cast(bf16x8, w); } while (0)
    PK4(p0, 0, pa0); PK4(p0, 8, pa1); PK4(p1, 0, pa2); PK4(p1, 8, pa3);
#undef PK4
    pv_all(o, vb, pa0, pa1, pa2, pa3);
}
__device__ __forceinline__ void attn_unit(const Ctx& C, int l, int hd, int qrow0, int latbase, int ctxbase, int nlat, int NT, float lam, char* lds) {
    const int tid = opaque(threadIdx.x), wid = __builtin_amdgcn_readfirstlane(tid >> 6), lane = tid & 63, r32 = lane & 31, hi = lane >> 5, g = wid & 3, sj = wid >> 2;
    char* V_lds = lds; char* K_lds = lds + 2 * SHM_KV;
    float* wsf = (float*)(lds + 5 * SHM_KV) + wid * 64; float* al_l = wsf; float* li_l = wsf + 32;
    const bf16_t* Qw = C.P + (size_t)(qrow0 + g * 32 + r32) * DIN + C_AQ + hd * 128 + sj * 64 + hi * 8;
    bf16x8 qr[4];
#pragma unroll
    for (int d0 = 0; d0 < 4; ++d0) qr[d0] = __builtin_nontemporal_load((const bf16x8*)(Qw + d0 * 16));
    const int sr = tid >> 4, sc = (tid & 15) * 8, vst0 = v_st(sr, sc), vst1 = v_st(32 + sr, sc);
    const int vb0 = (int)(uintptr_t)V_lds + v_rd_base(lane);
    const bf16_t* Kc = C.P + C_AK + hd * 128 + sc; const bf16_t* Vc = C.P + C_AV + hd * 128 + sc;
    bf16x8 vs0, vs1, ks0, ks1;
#define TROW(t) ((t) < nlat ? latbase + (t) * 64 : ctxbase + ((t) - nlat) * 64)
#define LOADK(t) do { const size_t rb_ = (size_t)TROW(t); ks0 = *(const bf16x8*)(Kc + (rb_ + sr) * DIN); ks1 = *(const bf16x8*)(Kc + (rb_ + 32 + sr) * DIN); } while (0)
#define LOADV(t) do { const size_t rb_ = (size_t)TROW(t); vs0 = *(const bf16x8*)(Vc + (rb_ + sr) * DIN); vs1 = *(const bf16x8*)(Vc + (rb_ + 32 + sr) * DIN); } while (0)
#define WRITEK(b) do { *(bf16x8*)(K_lds + (b) * SHM_KV + KSWZ(sr, sc * 2)) = ks0; *(bf16x8*)(K_lds + (b) * SHM_KV + KSWZ(32 + sr, sc * 2)) = ks1; } while (0)
#define WRITEV(b) do { *(bf16x8*)(V_lds + (b) * SHM_KV + vst0) = vs0; *(bf16x8*)(V_lds + (b) * SHM_KV + vst1) = vs1; } while (0)
    float m_reg = -1e30f, l_reg = 0.f;
    f32x16 o[4] = {};
    f32x16 pA0, pA1, pB0, pB1;
    LOADK(0); LOADV(0); WRITEK(0); WRITEV(0); LOADK(1); WRITEK(1); __syncthreads();
    qk_tile(pA0, pA1, qr, K_lds, sj * 128, r32, hi);
    int kb1 = 1, kb2 = 2;
#define ATT_STEP(PC0, PC1, PN0, PN1, jj) do { \
        if ((jj) + 2 < NT) LOADK((jj) + 2); if ((jj) + 1 < NT) LOADV((jj) + 1); \
        if ((jj) + 1 < NT) qk_tile(PN0, PN1, qr, K_lds + kb1 * SHM_KV, sj * 128, r32, hi); \
        sm_pv(o, PC0, PC1, m_reg, l_reg, vb0 + ((jj) & 1) * SHM_KV, al_l, r32, hi); \
        if ((jj) + 2 < NT) WRITEK(kb2); if ((jj) + 1 < NT) WRITEV(((jj) + 1) & 1); \
        kb1 = kb2; kb2 = (kb2 == 2) ? 0 : kb2 + 1; \
        __syncthreads(); } while (0)
#pragma unroll 1
    for (int j = 0; j < NT; j += 2) {
        ATT_STEP(pA0, pA1, pB0, pB1, j);
        ATT_STEP(pB0, pB1, pA0, pA1, j + 1);
    }
#undef ATT_STEP
#undef TROW
#undef LOADK
#undef LOADV
#undef WRITEK
#undef WRITEV
    if (hi == 0) li_l[r32] = (sj ? lam : 1.f) * frcp(l_reg);
    asm volatile("s_waitcnt lgkmcnt(0)" ::: "memory");
    float* xb = (float*)lds + g * 4096 + lane;
    if (sj == 1) {
#pragma unroll
        for (int r = 0; r < 16; ++r) { const float a = li_l[crow(r, hi)];
#pragma unroll
            for (int d = 0; d < 4; ++d) xb[(d * 16 + r) * 64] = o[d][r] * a; }
    }
    __syncthreads();
    if (sj == 0) {
        const float lam1m = (l == 0) ? 0.8f : (1.f - 0.35550906759f);
        float g4[4];
#pragma unroll
        for (int d = 0; d < 4; ++d) g4[d] = C.subg[l * 128 + d * 32 + r32] * lam1m;
#pragma unroll
        for (int r = 0; r < 16; ++r) { const int rw = crow(r, hi); const float a = li_l[rw];
            float ss = 0.f; float v4[4];
#pragma unroll
            for (int d = 0; d < 4; ++d) { const float v = o[d][r] * a - xb[(d * 16 + r) * 64]; v4[d] = v; ss += v * v; }
            ss = sum32(ss);
            const float rstd = __builtin_amdgcn_rsqf(ss * (1.f / 128.f) + NORM_EPS);
            const size_t row = (size_t)(qrow0 + g * 32 + rw);
            const bf16_t* zp = C.P + row * DIN + C_AZ + hd * 128 + r32; bf16_t* op = C.H + row * DM + 512 + hd * 128 + r32;
#pragma unroll
            for (int d = 0; d < 4; ++d) { const float z = bf2f(zp[d * 32]); const float v = v4[d] * rstd * g4[d] * siluf_(z);
                op[d * 32] = (bf16_t)(cvt_pk_bf16(v, 0.f) & 0xffffu); } }
    }
    __syncthreads();
}

__device__ __forceinline__ void readout_row(const Ctx& C, int l, int lr, int lane_in) {
    const int lane = opaque(lane_in);
    constexpr size_t ARR = (size_t)MH * 256;
    const int j = 4 * lane; const size_t off = (size_t)lr * 256 + j;
    f32x4 y = __builtin_nontemporal_load((const f32x4*)(C.YS + off)) + __builtin_nontemporal_load((const f32x4*)(C.YS + ARR + off));
    float s = (y[0] + y[1]) + (y[2] + y[3]);
    s = sum16(s);
    const float mu = s * (1.f / 64.f);
    y = y - mu;
    float q = (y[0] * y[0] + y[1] * y[1]) + (y[2] * y[2] + y[3] * y[3]);
    q = sum16(q);
    const float rstd = __builtin_amdgcn_rsqf(q * (1.f / 64.f) + GN_EPS);
    const f32x4 lg = *(const f32x4*)(C.ln_g + l * 256 + j), lb = *(const f32x4*)(C.ln_b + l * 256 + j), rk = *(const f32x4*)(C.r_k + l * 256 + j);
    const bf16_t* pr = C.P + (size_t)lr * DIN;
    const f32x4 r = ld_bf4_nt(pr + C_R + j), v = ld_bf4_nt(pr + C_V + j), z = ld_bf4_nt(pr + C_ZR + j);
    const bf16_t* sb16 = (const bf16_t*)(C.SC + 2 * ARR);
    const f32x4 ks = ld_bf4_nt(sb16 + off) + ld_bf4_nt(sb16 + ARR + off);
    const f32x4 t = r * ks * rk;
    float bs = (t[0] + t[1]) + (t[2] + t[3]);
    bs = sum16(bs);
    f32x4 o = y * rstd * lg + lb + bs * v;
    o[0] *= siluf_(z[0]); o[1] *= siluf_(z[1]); o[2] *= siluf_(z[2]); o[3] *= siluf_(z[3]);
    st_bf4(C.H + (size_t)lr * DM + j, o);
}

#define XB_TMO      128
#define XB_XCNT(j)  (256  + 64 * (j))
#define XB_XSUB(j)  (1280 + 64 * (j))
#define XB_XGEN(j)  (2304 + 64 * (j))
#define XB_TOP      3328
#define XB_TOPGEN   3392
#define XCD_BAR_WORDS 3456
#define XB_SPIN_CAP (1u << 20)
__device__ __forceinline__ unsigned xb_ld(unsigned* p)              { return __hip_atomic_load(p, __ATOMIC_RELAXED, __HIP_MEMORY_SCOPE_AGENT); }
__device__ __forceinline__ unsigned xb_add(unsigned* p, unsigned v) { return __hip_atomic_fetch_add(p, v, __ATOMIC_RELAXED, __HIP_MEMORY_SCOPE_AGENT); }
__device__ __forceinline__ unsigned xb_xcc_id() { return (unsigned)__builtin_amdgcn_s_getreg((3 << 11) | 20) & 0xFu; }
#define XB_SPIN(cond, bar) do { unsigned _sp = 0; while (cond) { __builtin_amdgcn_s_sleep(1); \
    if ((++_sp & 255u) == 0u) { if (xb_ld(&(bar)[XB_TMO])) break; if (_sp > XB_SPIN_CAP) { atomicAdd(&(bar)[XB_TMO], 1u); break; } } } } while (0)
struct XcdBarrier { unsigned* bar; unsigned x; volatile LAS unsigned* st; };
__device__ __forceinline__ XcdBarrier xcd_barrier_post(unsigned* bar, volatile LAS unsigned* st) {
    XcdBarrier b; b.bar = bar; b.x = xb_xcc_id(); b.st = st;
    if (threadIdx.x == 0) (void)xb_add(&bar[XB_XCNT(b.x)], 1u);
    return b;
}
__device__ __forceinline__ void xcd_barrier_complete(unsigned* bar, unsigned x, unsigned& nloc, unsigned& nx) {
    const unsigned G = gridDim.x * gridDim.y * gridDim.z;
    unsigned sum, cnt, mine, sp = 0u;
    for (;;) {
        sum = 0u; cnt = 0u; mine = 0u;
#pragma unroll
        for (unsigned j = 0; j < 16; ++j) { const unsigned c = xb_ld(&bar[XB_XCNT(j)]); sum += c; cnt += (c > 0u) ? 1u : 0u; mine = (j == x) ? c : mine; }
        if (sum == G) break;
        __builtin_amdgcn_s_sleep(1);
        if ((++sp & 255u) == 0u) { if (xb_ld(&bar[XB_TMO])) break; if (sp > XB_SPIN_CAP) { atomicAdd(&bar[XB_TMO], 1u); break; } }
    }
    nloc = mine > 0u ? mine : 1u; nx = cnt > 0u ? cnt : 1u;
}
__device__ __forceinline__ void xcd_barrier(const XcdBarrier& b) {
    asm volatile("s_waitcnt vmcnt(0)" ::: "memory");
    __syncthreads();
    if (threadIdx.x == 0) {
        unsigned* bar = b.bar;
        __builtin_amdgcn_s_waitcnt(0);
        unsigned nloc = b.st[0], nx = b.st[1];
        if (nloc == 0u) { xcd_barrier_complete(bar, b.x, nloc, nx); b.st[0] = nloc; b.st[1] = nx; }
        const unsigned old = xb_add(&bar[XB_XSUB(b.x)], 1u);
        const unsigned gen = old / nloc;
        if (old + 1u == (gen + 1u) * nloc) {
            __builtin_amdgcn_fence(__ATOMIC_RELEASE, "agent");
            asm volatile("s_waitcnt vmcnt(0)" ::: "memory");
            const unsigned og = xb_add(&bar[XB_TOP], 1u);
            const unsigned tg = og / nx;
            if (og + 1u == (tg + 1u) * nx) xb_add(&bar[XB_TOPGEN], 1u);
            else XB_SPIN(xb_ld(&bar[XB_TOPGEN]) == tg, bar);
            __builtin_amdgcn_fence(__ATOMIC_ACQUIRE, "agent");
            xb_add(&bar[XB_XGEN(b.x)], 1u);
            asm volatile("s_waitcnt vmcnt(0)" ::: "memory");
        } else {
            XB_SPIN(xb_ld(&bar[XB_XGEN(b.x)]) == gen, bar);
            __builtin_amdgcn_fence(__ATOMIC_ACQUIRE, "agent");
            asm volatile("s_waitcnt vmcnt(0)" ::: "memory");
        }
    }
    __syncthreads();
}

#ifndef REP_ATT
#define REP_ATT 1
#endif
#ifndef REP_SCAN
#define REP_SCAN 1
#endif
#ifndef REP_G1
#define REP_G1 1
#endif
#ifndef REP_P3
#define REP_P3 1
#endif
#ifndef REP_RD
#define REP_RD 1
#endif
#ifndef REP_G0
#define REP_G0 1
#endif
#ifndef REP_P1
#define REP_P1 1
#endif
#ifndef REP_SYNC
#define REP_SYNC 1
#endif
#ifndef REP_G2
#define REP_G2 1
#endif
#ifndef REP_FIN
#define REP_FIN 1
#endif
struct Args { const float* in[22]; float* out; unsigned char* ws; };
__global__ void __launch_bounds__(512, 2) mk_fwd(Args a) {
    extern __shared__ __attribute__((aligned(16))) unsigned char lds_raw[];
    cg::grid_group grid = cg::this_grid();
    LAS unsigned char* lds = (LAS unsigned char*)lds_raw;
    Ctx C;
    C.x = a.in[0]; C.c = a.in[1]; C.ctx = a.in[2]; C.c_ctx = a.in[3]; C.mod_w = a.in[4]; C.mod_b = a.in[5]; C.pre_g = a.in[6]; C.post_g = a.in[7]; C.w_in = a.in[8]; C.w_out = a.in[9];
    C.w0 = a.in[10]; C.w_up = a.in[11]; C.a0 = a.in[12]; C.a_up = a.in[13]; C.k_k = a.in[14]; C.k_a = a.in[15]; C.r_k = a.in[16]; C.ln_g = a.in[17]; C.ln_b = a.in[18]; C.conv_w = a.in[19];
    C.dlam = a.in[20]; C.subg = a.in[21]; C.out = a.out;
    unsigned char* ws = a.ws;
    C.WinT = (bf16_t*)(ws + WS_WIN); C.WoutT = (bf16_t*)(ws + WS_WOUT); C.WupT = (bf16_t*)(ws + WS_WUP); C.mod = (float*)(ws + WS_MOD); C.rope = (float*)(ws + WS_ROPE);
    C.xc1 = (float*)(ws + WS_XC1); C.H = (bf16_t*)(ws + WS_H); C.P = (bf16_t*)(ws + WS_P); C.Y = (bf16_t*)(ws + WS_P); C.SC = (float*)(ws + WS_SC); C.YS = (float*)(ws + WS_YS);
    const int tid = threadIdx.x, wid = __builtin_amdgcn_readfirstlane(tid >> 6), G = gridDim.x, bx = blockIdx.x;
#define lane (opaque(tid) & 63)
    const int gw0 = bx * 8 + wid, ngw = G * 8;
#define gw opaque_s(gw0)

    if (bx == 0) for (int i = tid; i < 4096; i += 512) ((unsigned*)ws)[i] = 0u;
    if (tid < 2) ((volatile LAS unsigned*)(lds + 131072 + 1024))[tid] = 0u;
    __syncthreads();
#ifdef PROBE_A
    unsigned long long tprev = __builtin_amdgcn_s_memrealtime(); float tacc[9] = {0.f, 0.f, 0.f, 0.f, 0.f, 0.f, 0.f, 0.f, 0.f};
#define STAMP(k) do { const unsigned long long tn_ = __builtin_amdgcn_s_memrealtime(); tacc[k] += (float)(tn_ - tprev) * 0.01f; tprev = tn_; } while (0)
#else
#define STAMP(k) do { } while (0)
#endif
#ifndef NO_G0
    for (int rep = 0; rep < REP_G0; ++rep) g0_prologue(C, lds);
#endif
    grid.sync(); STAMP(0);
    const XcdBarrier xbar = xcd_barrier_post((unsigned*)ws, (volatile LAS unsigned*)(lds + 131072 + 1024));
#define GSYNC() xcd_barrier(xbar)
#pragma unroll 1
    for (int hf = 0; hf < 2; ++hf) {
#pragma unroll 1
        for (int l = 0; l < 2; ++l) {
#ifndef NO_NORM
            for (int rep = 0; rep < REP_P1; ++rep) { if (l == 0) norm_phase<0>(C, hf, gw, ngw, lane); else norm_phase<1>(C, hf, gw, ngw, lane); }
#endif
            for (int rep = 0; rep < REP_SYNC; ++rep) GSYNC();
            STAMP(1);
            { pg8::Gemm g{C.H, C.WinT + (size_t)l * DIN * DM, MH, DIN, DM}; pg8::StaticOrder S; S.init(MH, DIN, G, bx);
#ifndef NO_GEMM1
              pg8::EpiBf16 E{C.P, DIN}; for (int rep = 0; rep < REP_G1; ++rep) pg8::gemm_phase<pg8::EpiBf16, true>(lds, g, S, E);
#endif
            }
            GSYNC(); STAMP(2);
#ifndef NO_PREP
            for (int rep = 0; rep < REP_P3; ++rep) for (int t = bx; t < MH / 64; t += G) prep_block(C, l, t, lds);
#endif
            for (int r4 = gw; r4 < MH / 4; r4 += ngw) { const bool do_conv = (l == 0) || (r4 < LATH / 4); if (do_conv || r4 < LATH / 4) rowpass4(C, l, r4 * 4, lane, do_conv); }
            GSYNC(); STAMP(3);
#ifndef NO_SCAN
            unsigned* sdone = (unsigned*)ws + 3840 + (hf * 2 + l) * 64;
            { unsigned nscan = 0;
              if (G == 256) { if (((bx >> 3) & 1) == 0) { scan_chunked(C, l, (bx >> 4) * 8 + (bx & 7), lds); nscan = 1; } } else { for (int u = bx; u < 128; u += G) { scan_chunked(C, l, u, lds); ++nscan; } }
              if (nscan) { asm volatile("s_waitcnt vmcnt(0)" ::: "memory"); __syncthreads();
                  if (tid == 0) { __builtin_amdgcn_fence(__ATOMIC_RELEASE, "agent"); asm volatile("s_waitcnt vmcnt(0)" ::: "memory");
                                  (void)__hip_atomic_fetch_add(sdone, nscan, __ATOMIC_RELAXED, __HIP_MEMORY_SCOPE_AGENT); } } }
#endif
            STAMP(4);
#ifndef NO_ATT
            {
                float lam;
                { const int ln = opaque(lane); const float* dl = C.dlam + l * 256; const float sa = wave_sum_dpp(dl[ln] * dl[64 + ln]), sb = wave_sum_dpp(dl[128 + ln] * dl[192 + ln]);
                  lam = fexp2(1.4426950408889634f * sa) - fexp2(1.4426950408889634f * sb) + ((l == 0) ? 0.2f : 0.35550906759f); }
                unsigned* qctr = (unsigned*)ws + 3584 + (hf * 2 + l) * 64;
                volatile LAS unsigned* qslot = (volatile LAS unsigned*)(lds + 131072 + 1024 + 64);
                const int nunits = (l == 0) ? 1024 + 128 : 1024;
                for (;;) {
                    if (tid == 0) qslot[0] = __hip_atomic_fetch_add(qctr, 1u, __ATOMIC_RELAXED, __HIP_MEMORY_SCOPE_AGENT);
                    __syncthreads();
                    const int u = (int)qslot[0];
                    __syncthreads();
                    if (u >= nunits) break;
                    if (u < 1024) { const int bl = u >> 6, hd = (u >> 4) & 3, qb = u & 15;
                        attn_unit(C, l, hd, bl * SEQ + qb * 128, bl * SEQ, LATH + bl * CTX, 32, 36, lam, (char*)lds_raw); }
                    else { const int v = u - 1024; const int bl = v >> 3, hd = (v >> 1) & 3, qb = v & 1;
                        attn_unit(C, l, hd, LATH + bl * CTX + qb * 128, 0, LATH + bl * CTX, 0, 4, lam, (char*)lds_raw); }
                }
            }
#endif
            STAMP(5);
            {
                volatile LAS unsigned* qslot = (volatile LAS unsigned*)(lds + 131072 + 1024 + 64);
                if (tid == 0) { unsigned sp = 0;
                    while (__hip_atomic_load(sdone, __ATOMIC_RELAXED, __HIP_MEMORY_SCOPE_AGENT) < 128u) { __builtin_amdgcn_s_sleep(4); if (++sp > (1u << 22)) break; }
                    __builtin_amdgcn_fence(__ATOMIC_ACQUIRE, "agent"); asm volatile("s_waitcnt vmcnt(0)" ::: "memory"); }
                __syncthreads();
                unsigned* rq = sdone + 16;
                const int nch = ((l == 0) ? MH : LATH) / 64;
                for (;;) {
                    if (tid == 0) qslot[0] = __hip_atomic_fetch_add(rq, 1u, __ATOMIC_RELAXED, __HIP_MEMORY_SCOPE_AGENT);
                    __syncthreads();
                    const int ch = (int)qslot[0];
                    __syncthreads();
                    if (ch >= nch) break;
#pragma unroll 1
                    for (int i = 0; i < 4; ++i) { const int r = ch * 64 + wid * 8 + i * 2; readout_row(C, l, r, lane); readout_row(C, l, r + 1, lane); }
                }
            }
            GSYNC(); STAMP(6);
            { const int M5 = (l == 0) ? MH : LATH; pg8::Gemm g{C.H, C.WoutT + (size_t)l * DM * DM, M5, DM, DM}; pg8::StaticOrder S; S.init(M5, DM, G, bx);
#ifndef NO_GEMM2
              pg8::EpiBf16 E{C.Y, DM}; for (int rep = 0; rep < REP_G2; ++rep) pg8::gemm_phase<pg8::EpiBf16, true>(lds, g, S, E);
#endif
            }
            GSYNC(); STAMP(7);
        }
#ifdef PROBE_A
        norm_phase<2>(C, hf, gw, ngw, lane, 2e-3f * tacc[PROBE_A], 1e-3f * tacc[PROBE_B]); STAMP(8);
#else
        norm_phase<2>(C, hf, gw, ngw, lane);
#endif
    }
#undef gw
#undef lane
}

extern "C" void kernel_launch(void* const* d_in, const int* in_sizes, int n_in, void* d_out, int out_size, void* d_ws, size_t ws_size, hipStream_t stream) {
    static int grid = 0;
    if (grid == 0) {
        if (n_in != 22 || ws_size < WS_END) { fprintf(stderr, "kernel_launch: unexpected n_in %d / ws %zu\n", n_in, ws_size); grid = -1; return; }
        int dev = 0, cus = 0, per_cu = 0;
        hipGetDevice(&dev); hipDeviceGetAttribute(&cus, hipDeviceAttributeMultiprocessorCount, dev);
        if (hipFuncSetAttribute((const void*)mk_fwd, hipFuncAttributeMaxDynamicSharedMemorySize, LDS_BYTES) != hipSuccess) { fprintf(stderr, "kernel_launch: hipFuncSetAttribute failed\n"); grid = -1; return; }
        if (hipOccupancyMaxActiveBlocksPerMultiprocessor(&per_cu, (const void*)mk_fwd, 512, LDS_BYTES) != hipSuccess || per_cu < 1) { fprintf(stderr, "kernel_launch: occupancy query says %d\n", per_cu); per_cu = 1; }
        (void)hipGetLastError();
        grid = cus * 1;
    }
    if (grid < 0) return;
    Args a{};
    for (int i = 0; i < 22; ++i) a.in[i] = (const float*)d_in[i];
    a.out = (float*)d_out; a.ws = (unsigned char*)d_ws;
    void* args[] = {&a};
    hipError_t e = hipLaunchCooperativeKernel((const void*)mk_fwd, dim3(grid), dim3(512), args, LDS_BYTES, stream);
    if (e != hipSuccess) fprintf(stderr, "cooperative launch failed: %s (grid %d)\n", hipGetErrorString(e), grid);
}
```

```cpp
#include <hip/hip_runtime.h>
#include <hip/hip_cooperative_groups.h>
#include <cstdio>
#include <cstdint>
namespace cg = cooperative_groups;

#define LAS __attribute__((address_space(3)))
typedef unsigned short bf16_t;
typedef short bf16x8 __attribute__((ext_vector_type(8)));
typedef short s16x4 __attribute__((ext_vector_type(4)));
typedef float f32x2 __attribute__((ext_vector_type(2)));
typedef float f32x4 __attribute__((ext_vector_type(4)));
typedef float f32x16 __attribute__((ext_vector_type(16)));
typedef unsigned u32x2 __attribute__((ext_vector_type(2)));
typedef unsigned u32x4 __attribute__((ext_vector_type(4)));

constexpr int DM = 1024, SEQ = 2048, CTX = 256, DIN = 4352;
constexpr int HB = 16;
constexpr int LATH = HB * SEQ;
constexpr int CTXH = HB * CTX;
constexpr int MH = LATH + CTXH;
constexpr int C_R = 0, C_K = 256, C_V = 512, C_LWF = 768, C_LWB = 832, C_LAF = 896, C_LAB = 960, C_ZR = 1024,
              C_CB = 1280, C_CC = 1536, C_CH = 1792, C_CZ = 2048, C_AQ = 2304, C_AK = 2816, C_AV = 3328, C_AZ = 3840;
constexpr float C2 = 0.125f * 1.4426950408889634f;
constexpr float NORM_EPS = 1e-6f, GN_EPS = 64e-5f;

constexpr size_t MiB = 1u << 20;
constexpr size_t WS_WIN = 1 * MiB, WS_WOUT = 18 * MiB, WS_WUP = 22 * MiB, WS_MOD = 23 * MiB, WS_ROPE = 24 * MiB, WS_XC1 = 25 * MiB,
                 WS_H = 57 * MiB, WS_P = 129 * MiB, WS_SC = 435 * MiB, WS_YS = 687 * MiB, WS_END = 759 * MiB;
static_assert(WS_WIN + 2ull * DIN * DM * 2 <= WS_WOUT && WS_H + (size_t)MH * DM * 2 <= WS_P && WS_P + (size_t)MH * DIN * 2 <= WS_SC &&
              WS_SC + 7ull * MH * 256 * 4 <= WS_YS && WS_YS + 2ull * MH * 256 * 4 <= WS_END, "ws map");
constexpr int LDS_BYTES = 131072 + 2048;

struct Ctx {
    const float *x, *c, *ctx, *c_ctx, *mod_w, *mod_b, *pre_g, *post_g, *w_in, *w_out, *w0, *w_up, *a0, *a_up, *k_k, *k_a, *r_k, *ln_g, *ln_b, *conv_w, *dlam, *subg;
    float* out;
    bf16_t *WinT, *WoutT, *WupT; float *mod, *rope, *xc1; bf16_t *H, *P, *Y; float *SC, *YS;
};

__device__ __forceinline__ unsigned cvt_pk_bf16(float lo, float hi) { unsigned r; asm volatile("v_cvt_pk_bf16_f32 %0, %1, %2" : "=v"(r) : "v"(lo), "v"(hi)); return r; }
__device__ __forceinline__ float bf_lo(unsigned w) { return __uint_as_float(w << 16); }
__device__ __forceinline__ float bf_hi(unsigned w) { return __uint_as_float(w & 0xffff0000u); }
__device__ __forceinline__ float bf2f(bf16_t b) { return __uint_as_float((unsigned)b << 16); }
__device__ __forceinline__ f32x4 ld_bf4(const bf16_t* p) { const u32x2 w = *(const u32x2*)p; return (f32x4){bf_lo(w.x), bf_hi(w.x), bf_lo(w.y), bf_hi(w.y)}; }
__device__ __forceinline__ f32x4 ld_bf4_nt(const bf16_t* p) { const u32x2 w = __builtin_nontemporal_load((const u32x2*)p); return (f32x4){bf_lo(w.x), bf_hi(w.x), bf_lo(w.y), bf_hi(w.y)}; }
__device__ __forceinline__ void st_bf4(bf16_t* p, f32x4 v) { u32x2 w; w.x = cvt_pk_bf16(v[0], v[1]); w.y = cvt_pk_bf16(v[2], v[3]); *(u32x2*)p = w; }
__device__ __forceinline__ int opaque(int v) { asm volatile("" : "+v"(v)); return v; }
__device__ __forceinline__ int opaque_s(int v) { asm volatile("" : "+s"(v)); return v; }
__device__ __forceinline__ float fexp2(float x) { return __builtin_amdgcn_exp2f(x); }
__device__ __forceinline__ float frcp(float x) { return __builtin_amdgcn_rcpf(x); }
__device__ __forceinline__ float sigmoidf_(float x) { return frcp(1.f + fexp2(-1.4426950408889634f * x)); }
__device__ __forceinline__ float siluf_(float x) { return x * sigmoidf_(x); }
__device__ __forceinline__ float sum16(float v) {
    v += __int_as_float(__builtin_amdgcn_update_dpp(0, __float_as_int(v), 0xB1, 0xF, 0xF, true));
    v += __int_as_float(__builtin_amdgcn_update_dpp(0, __float_as_int(v), 0x4E, 0xF, 0xF, true));
    v += __int_as_float(__builtin_amdgcn_update_dpp(0, __float_as_int(v), 0x141, 0xF, 0xF, true));
    v += __int_as_float(__builtin_amdgcn_update_dpp(0, __float_as_int(v), 0x140, 0xF, 0xF, true));
    return v;
}
__device__ __forceinline__ float wave_sum(float v) {
    const int ri = __float_as_int(sum16(v));
    return (__int_as_float(__builtin_amdgcn_readlane(ri, 0)) + __int_as_float(__builtin_amdgcn_readlane(ri, 16))) + (__int_as_float(__builtin_amdgcn_readlane(ri, 32)) + __int_as_float(__builtin_amdgcn_readlane(ri, 48)));
}
__device__ __forceinline__ float wave_sum_dpp(float v) {
    const int ri = __float_as_int(sum16(v));
    return (__int_as_float(__builtin_amdgcn_readlane(ri, 0)) + __int_as_float(__builtin_amdgcn_readlane(ri, 16))) + (__int_as_float(__builtin_amdgcn_readlane(ri, 32)) + __int_as_float(__builtin_amdgcn_readlane(ri, 48)));
}
__device__ __forceinline__ float sum32(float v) {
    const float r = sum16(v);
    return r + __int_as_float(__builtin_amdgcn_ds_swizzle(__float_as_int(r), 0x401f));
}

namespace pg8 {
constexpr int BM = 256, BK = 64, HALF = 128, HTB = HALF * BK * 2, STAGE_BYTES = 8 * HTB, NXCD = 8, WGM = 8;
__host__ __device__ __forceinline__ int lds_byte(int r, int c) { const int st = (r >> 4) * 2 + (c >> 5), rr = r & 15, cc = c & 31, ob = rr * 64 + cc * 2; return st * 1024 + (ob ^ (((ob >> 9) & 1) << 5)); }
__host__ __device__ __forceinline__ void stage_rc(int b, int& R, int& C) { const int st = b / 1024, sb = b % 1024, swz = sb ^ (((sb >> 9) & 1) << 5); R = (st >> 1) * 16 + swz / 64; C = (st & 1) * 32 + (swz % 64) / 2; }
__host__ __device__ __forceinline__ int perm32(int rho) { const int n = rho >> 4, i = rho & 15; return 8 * (i >> 2) + 4 * n + (i & 3); }
struct Unit { int pm, pn; };
struct Gemm { const bf16_t* A; const bf16_t* Bt; int M, N, K; };
struct StaticOrder {
    int nM, nN, nwg, G, c;
    __host__ __device__ void init(int M, int N, int G_, int c_) { nM = M / BM; nN = N / BM; nwg = nM * nN; G = G_; c = c_; }
    __host__ __device__ bool next(int i, Unit& u) const {
        const long L = (long)i * G + c; if (L >= nwg) return false;
        int wgid = (int)L; { const int q = nwg / NXCD, r = nwg % NXCD, xcd = wgid % NXCD, off = wgid / NXCD; wgid = (xcd < r ? xcd * (q + 1) : r * (q + 1) + (xcd - r) * q) + off; }
        const int nig = WGM * nN, gid = wgid / nig, fm = gid * WGM, gsz = (nM - fm) < WGM ? (nM - fm) : WGM;
        u.pm = fm + ((wgid % nig) % gsz); u.pn = (wgid % nig) / gsz; return true;
    }
};
struct EpiBf16 {
    static constexpr bool PERM = true;
    bf16_t* O; int ldc;
    __device__ __forceinline__ void operator()(const f32x4 (&acc)[2][2][4][2], const Unit& u, int wr, int wc, int fr, int fq) const {
        const int row0 = u.pm * BM + wr * 64 + fr, col0 = u.pn * BM + wc * 32 + 8 * fq;
        int ld = ldc; asm volatile("" : "+s"(ld));
#pragma unroll
        for (int ai = 0; ai < 2; ++ai)
#pragma unroll
            for (int m = 0; m < 4; ++m) { bf16_t* rowp = O + (size_t)(row0 + ai * HALF + m * 16) * ld + col0;
#pragma unroll
                for (int bj = 0; bj < 2; ++bj) { const f32x4 v0 = acc[ai][bj][m][0], v1 = acc[ai][bj][m][1];
                    u32x4 w; w.x = cvt_pk_bf16(v0[0], v0[1]); w.y = cvt_pk_bf16(v0[2], v0[3]); w.z = cvt_pk_bf16(v1[0], v1[1]); w.w = cvt_pk_bf16(v1[2], v1[3]);
                    *(u32x4*)(rowp + bj * HALF) = w; } }
    }
};
template <class Epi, bool ALIGN_EPI = true>
__device__ __forceinline__ void gemm_phase(LAS unsigned char* lds, const Gemm g, const StaticOrder& S, const Epi& E) {
    const int tid = opaque(threadIdx.x), wid = __builtin_amdgcn_readfirstlane(tid >> 6), lane = tid & 63, wr = wid >> 2, wc = wid & 3, fr = lane & 15, fq = lane >> 4;
    const int K = g.K, nt = K / BK;
    unsigned voffA[2], voffB[2];
#pragma unroll
    for (int i = 0; i < 2; ++i) { int R, C; stage_rc(tid * 16 + i * 8192, R, C); const int Rb = Epi::PERM ? ((R & ~31) + perm32(R & 31)) : R;
        voffA[i] = (unsigned)(R * K + C) * 2u; voffB[i] = (unsigned)(Rb * K + C) * 2u; }
    const size_t kstep = (size_t)(BK * 2);
    const size_t hstep = (size_t)HALF * K * 2;
    const size_t tstep = 2 * hstep;
    const unsigned ldsw = (unsigned)wid * 1024u;
    const int aoff = lds_byte(wr * 64 + fr, fq * 8), boff = lds_byte(wc * 32 + fr, fq * 8);
#define PG8_SA(b, h) (((b) * 2 + (h)) * HTB)
#define PG8_SB(b, h) ((4 + (b) * 2 + (h)) * HTB)
#define PG8_STAGE(bufoff, gbase, voff) do { _Pragma("unroll") for (int _i = 0; _i < 2; ++_i) \
        __builtin_amdgcn_global_load_lds((const unsigned*)((const char*)(gbase) + (voff)[_i]), (LAS unsigned*)(lds + (bufoff) + ldsw + _i * 8192), 16, 0, 0); } while (0)
#define PG8_LDA(dst, b, h) do { _Pragma("unroll") for (int m = 0; m < 4; ++m) _Pragma("unroll") for (int k = 0; k < 2; ++k) dst[m][k] = *(const LAS bf16x8*)(lds + PG8_SA(b, h) + aoff + m * 2048 + k * 1024); } while (0)
#define PG8_LDB(dst, b, h) do { _Pragma("unroll") for (int n = 0; n < 2; ++n) _Pragma("unroll") for (int k = 0; k < 2; ++k) dst[n][k] = *(const LAS bf16x8*)(lds + PG8_SB(b, h) + boff + n * 2048 + k * 1024); } while (0)
#define PG8_MMA(ai, bj, At, Bt) do { __builtin_amdgcn_s_setprio(1); _Pragma("unroll") for (int m = 0; m < 4; ++m) _Pragma("unroll") for (int n = 0; n < 2; ++n) _Pragma("unroll") for (int k = 0; k < 2; ++k) \
        acc[ai][bj][m][n] = __builtin_amdgcn_mfma_f32_16x16x32_bf16(Bt[n][k], At[m][k], acc[ai][bj][m][n], 0, 0, 0); __builtin_amdgcn_s_setprio(0); } while (0)
#define PG8_WAIT_V(n) asm volatile("s_waitcnt vmcnt(" #n ")" ::: "memory")
#define PG8_WAIT_L(n) asm volatile("s_waitcnt lgkmcnt(" #n ")" ::: "memory")
#define PG8_BAR __builtin_amdgcn_s_barrier()
#define PG8_SCHED __builtin_amdgcn_sched_barrier(0)
    Unit cur, nxt; int ui = 0;
    if (!S.next(0, cur)) return;
    f32x4 acc[2][2][4][2];
#pragma unroll
    for (int a = 0; a < 2; ++a)
#pragma unroll
        for (int b = 0; b < 2; ++b)
#pragma unroll
            for (int m = 0; m < 4; ++m)
#pragma unroll
                for (int n = 0; n < 2; ++n) acc[a][b][m][n] = (f32x4){0.f, 0.f, 0.f, 0.f};
    bf16x8 At[4][2], B0[2][2], B1[2][2];
    const char* cA = (const char*)g.A + (size_t)cur.pm * tstep; const char* cB = (const char*)g.Bt + (size_t)cur.pn * tstep;
    PG8_STAGE(PG8_SB(0, 0), cB, voffB); PG8_STAGE(PG8_SB(0, 1), cB + hstep, voffB); PG8_STAGE(PG8_SA(0, 0), cA, voffA); PG8_STAGE(PG8_SA(0, 1), cA + hstep, voffA);
    if (wr == 1) PG8_BAR;
    PG8_WAIT_V(2); PG8_BAR;
    PG8_STAGE(PG8_SB(1, 0), cB + kstep, voffB); PG8_STAGE(PG8_SA(1, 0), cA + kstep, voffA); PG8_STAGE(PG8_SB(1, 1), cB + hstep + kstep, voffB);
    PG8_WAIT_V(6); PG8_BAR;
    for (;;) {
        const bool has_next = S.next(ui + 1, nxt);
        const char* nA = has_next ? (const char*)g.A + (size_t)nxt.pm * tstep : cA; const char* nB = has_next ? (const char*)g.Bt + (size_t)nxt.pn * tstep : cB;
        for (int t = 0; t < nt; t += 2) {
            const bool last = (t == nt - 2);
            const char* a1 = cA + (size_t)(t + 1) * kstep;
            const char* a2 = last ? nA : cA + (size_t)(t + 2) * kstep; const char* b2 = last ? nB : cB + (size_t)(t + 2) * kstep;
            const char* a3 = a2 + kstep; const char* b3 = b2 + kstep;
            PG8_LDB(B0, 0, 0); PG8_LDB(B1, 0, 1); PG8_SCHED; PG8_LDA(At, 0, 0); PG8_STAGE(PG8_SA(1, 1), a1 + hstep, voffA);
            PG8_WAIT_V(8); PG8_WAIT_L(0); PG8_BAR; PG8_MMA(0, 0, At, B0); PG8_MMA(0, 1, At, B1); PG8_BAR; PG8_SCHED;
            PG8_LDA(At, 0, 1); PG8_STAGE(PG8_SB(0, 0), b2, voffB); PG8_STAGE(PG8_SB(0, 1), b2 + hstep, voffB); PG8_STAGE(PG8_SA(0, 0), a2, voffA);
            PG8_WAIT_V(8); PG8_WAIT_L(0); PG8_BAR; PG8_MMA(1, 0, At, B0); PG8_MMA(1, 1, At, B1); PG8_BAR; PG8_SCHED;
            PG8_LDB(B0, 1, 0); PG8_LDB(B1, 1, 1); PG8_SCHED; PG8_LDA(At, 1, 0); PG8_STAGE(PG8_SA(0, 1), a2 + hstep, voffA);
            PG8_WAIT_V(8); PG8_WAIT_L(0); PG8_BAR; PG8_MMA(0, 0, At, B0); PG8_MMA(0, 1, At, B1); PG8_BAR; PG8_SCHED;
            PG8_LDA(At, 1, 1); PG8_STAGE(PG8_SB(1, 0), b3, voffB); PG8_STAGE(PG8_SB(1, 1), b3 + hstep, voffB); PG8_STAGE(PG8_SA(1, 0), a3, voffA);
            PG8_WAIT_V(8); PG8_WAIT_L(0); PG8_BAR; PG8_MMA(1, 0, At, B0); PG8_MMA(1, 1, At, B1); PG8_BAR; PG8_SCHED;
        }
        if constexpr (ALIGN_EPI) { if (wr == 0) PG8_BAR; }
        E(acc, cur, wr, wc, fr, fq);
        if (!has_next) break;
#pragma unroll
        for (int a = 0; a < 2; ++a)
#pragma unroll
            for (int b = 0; b < 2; ++b)
#pragma unroll
                for (int m = 0; m < 4; ++m)
#pragma unroll
                    for (int n = 0; n < 2; ++n) acc[a][b][m][n] = (f32x4){0.f, 0.f, 0.f, 0.f};
        cur = nxt; cA = nA; cB = nB; ++ui;
        if constexpr (ALIGN_EPI) { if (wr == 1) PG8_BAR; }
    }
    PG8_WAIT_V(0);
    if constexpr (!ALIGN_EPI) { if (wr == 0) PG8_BAR; }
    PG8_BAR;
#undef PG8_SA
#undef PG8_SB
#undef PG8_STAGE
#undef PG8_LDA
#undef PG8_LDB
#undef PG8_MMA
#undef PG8_WAIT_V
#undef PG8_WAIT_L
#undef PG8_BAR
#undef PG8_SCHED
}
}

__device__ __forceinline__ void transpose_item(const float* W, int K, int N, bf16_t* WT, LAS float* scr, int item, int lane, bool qscale) {
    const int nblk = N / 32, kb = item / nblk, nb = item % nblk, k0 = 64 * kb, n0 = 32 * nb;
    const float wsc = (qscale && n0 >= C_AQ && n0 < C_AK) ? C2 : 1.f;
#pragma unroll 8
    for (int i = 0; i < 32; ++i) { const int kk = 2 * i + (lane >> 5); scr[kk * 33 + (lane & 31)] = wsc * W[(size_t)(k0 + kk) * N + n0 + (lane & 31)]; }
    asm volatile("s_waitcnt lgkmcnt(0)" ::: "memory");
    const int c = lane & 7;
#pragma unroll
    for (int j = 0; j < 4; ++j) { const int n = (lane >> 3) + 8 * j; const LAS float* s = scr + (8 * c) * 33 + n;
        u32x4 o; o.x = cvt_pk_bf16(s[0 * 33], s[1 * 33]); o.y = cvt_pk_bf16(s[2 * 33], s[3 * 33]); o.z = cvt_pk_bf16(s[4 * 33], s[5 * 33]); o.w = cvt_pk_bf16(s[6 * 33], s[7 * 33]);
        *(u32x4*)(WT + (size_t)(n0 + n) * K + k0 + 8 * c) = o; }
    asm volatile("s_waitcnt lgkmcnt(0)" ::: "memory");
}
__device__ __forceinline__ void sincos_d(double x, float& s, float& c) {
    const double q = __builtin_rint(x * 0.63661977236758134308); const double r = x - q * 1.57079632679489661923; const int qi = (int)q & 3;
    const double r2 = r * r;
    const double sp = r * (1.0 + r2 * (-1.0 / 6 + r2 * (1.0 / 120 + r2 * (-1.0 / 5040 + r2 * (1.0 / 362880 + r2 * (-1.0 / 39916800 + r2 * (1.0 / 6227020800.0)))))));
    const double cp = 1.0 + r2 * (-0.5 + r2 * (1.0 / 24 + r2 * (-1.0 / 720 + r2 * (1.0 / 40320 + r2 * (-1.0 / 3628800 + r2 * (1.0 / 479001600.0))))));
    const double ss = (qi == 0) ? sp : (qi == 1) ? cp : (qi == 2) ? -sp : -cp;
    const double cc = (qi == 0) ? cp : (qi == 1) ? -sp : (qi == 2) ? -cp : sp;
    s = (float)ss; c = (float)cc;
}
__device__ __forceinline__ void g0_prologue(const Ctx& C, LAS unsigned char* lds) {
    const int tid = opaque(threadIdx.x), lane = tid & 63, wid = tid >> 6, G = gridDim.x, bx = blockIdx.x;
    if (bx == G - 1) {
        for (int e = tid; e < 1024; e += 512) { const int pos = e >> 4, i = e & 15;
            const float invf = fexp2(-(float)i * 0.83048202372f);
            const float ang = (float)pos * invf; float s, c; sincos_d((double)ang, s, c);
            C.rope[e * 2] = c; C.rope[e * 2 + 1] = s; }
    }
    constexpr int NMODT = 2 * 48;
    const int nmodb = (G >= 2 * NMODT) ? NMODT : G;
    if (bx < nmodb) {
        LAS float* sl = (LAS float*)lds + wid * (33 * 64);
        for (int task = bx; task < NMODT; task += nmodb) {
            const int l = task / 48, cb = task % 48, col = cb * 64 + lane;
            const float* W = C.mod_w + (size_t)l * DM * 3072;
            float acc[33];
#pragma unroll
            for (int r = 0; r < 33; ++r) acc[r] = 0.f;
            for (int kc = 0; kc < 2; ++kc) {
                const int k0 = wid * 128 + kc * 64;
#pragma unroll
                for (int r = 0; r < 33; ++r) { const float v = (r < 32) ? C.c[r * DM + k0 + lane] : C.c_ctx[k0 + lane]; sl[r * 64 + lane] = siluf_(v); }
                asm volatile("s_waitcnt lgkmcnt(0)" ::: "memory");
                for (int k4 = 0; k4 < 16; ++k4) {
                    const float w0 = W[(size_t)(k0 + 4 * k4 + 0) * 3072 + col], w1 = W[(size_t)(k0 + 4 * k4 + 1) * 3072 + col],
                                w2 = W[(size_t)(k0 + 4 * k4 + 2) * 3072 + col], w3 = W[(size_t)(k0 + 4 * k4 + 3) * 3072 + col];
#pragma unroll
                    for (int r = 0; r < 33; ++r) { const f32x4 sv = *(const LAS f32x4*)(sl + r * 64 + 4 * k4); acc[r] += sv[0] * w0 + sv[1] * w1 + sv[2] * w2 + sv[3] * w3; }
                }
                asm volatile("s_waitcnt lgkmcnt(0)" ::: "memory");
            }
            __syncthreads();
#pragma unroll
            for (int r = 0; r < 33; ++r) sl[r * 64 + lane] = acc[r];
            __syncthreads();
            for (int e = tid; e < 33 * 64; e += 512) { float s = 0.f;
#pragma unroll
                for (int w = 0; w < 8; ++w) s += ((LAS float*)lds)[w * (33 * 64) + e];
                const int r = e >> 6, cc = cb * 64 + (e & 63);
                C.mod[((size_t)l * 33 + r) * 3072 + cc] = s + C.mod_b[l * 3072 + cc]; }
            __syncthreads();
        }
    }
    {
        const bool all = (nmodb == G);
        if (all || bx >= nmodb) {
            const int nb = all ? G : G - nmodb, b0 = all ? bx : bx - nmodb;
            LAS float* scr = (LAS float*)lds + wid * (64 * 33 + 16);
            constexpr int I_IN = 16 * (DIN / 32), I_OUT = 16 * 32, I_UP = 8;
            constexpr int NITEMS = 2 * I_IN + 2 * I_OUT + 16 * I_UP;
            for (int it = b0 * 8 + wid; it < NITEMS; it += nb * 8) {
                int r = it;
                if (r < 2 * I_IN) { const int l = r / I_IN; transpose_item(C.w_in + (size_t)l * DM * DIN, DM, DIN, C.WinT + (size_t)l * DIN * DM, scr, r % I_IN, lane, true); continue; } r -= 2 * I_IN;
                if (r < 2 * I_OUT) { const int l = r / I_OUT; transpose_item(C.w_out + (size_t)l * DM * DM, DM, DM, C.WoutT + (size_t)l * DM * DM, scr, r % I_OUT, lane, false); continue; } r -= 2 * I_OUT;
                { const int mi = r / I_UP, l = mi >> 2, m = mi & 3, d = m & 1;
                  const float* src = ((m < 2) ? C.w_up : C.a_up) + (size_t)(l * 2 + d) * 64 * 256;
                  transpose_item(src, 64, 256, C.WupT + (size_t)(l * 4 + m) * 256 * 64, scr, r % I_UP, lane, false); }
            }
        }
    }
}

template <int MODE>
__device__ __forceinline__ void norm_phase(const Ctx& C, int hf, int gw, int ngw, int lane_in, float pe1 = 0.f, float pe2 = 0.f) {
    const int lane = opaque(lane_in);
    const int nrows = (MODE == 2) ? LATH : MH;
    for (int lr0 = gw * 2; lr0 < nrows; lr0 += ngw * 2) {
        const bool lat = lr0 < LATH;
        int mrow; const float* xin; float* x1p;
        if (lat) { const size_t g = (size_t)hf * LATH + lr0; mrow = hf * HB + lr0 / SEQ; xin = C.x + g * DM; x1p = C.out + g * DM; }
        else { const size_t g = (size_t)hf * CTXH + (lr0 - LATH); mrow = 32; xin = C.ctx + g * DM; x1p = C.xc1 + g * DM; }
        f32x4 v[2][4];
        const float* base = (MODE == 2) ? x1p : xin;
#pragma unroll
        for (int rr = 0; rr < 2; ++rr)
#pragma unroll
            for (int j = 0; j < 4; ++j) v[rr][j] = __builtin_nontemporal_load((const f32x4*)(base + rr * DM + 4 * lane + 256 * j));
        if (MODE >= 1) {
            const float* gate = C.mod + ((size_t)(MODE - 1) * 33 + mrow) * 3072 + 2048;
            const float* pg = C.post_g + (MODE - 1) * DM;
            const bf16_t* yr = C.Y + (size_t)lr0 * DM;
            f32x4 y[2][4]; float ss[2];
#pragma unroll
            for (int rr = 0; rr < 2; ++rr) { ss[rr] = 0.f;
#pragma unroll
                for (int j = 0; j < 4; ++j) { { const u32x2 yw_ = __builtin_nontemporal_load((const u32x2*)(yr + rr * DM + 4 * lane + 256 * j)); y[rr][j] = (f32x4){bf_lo(yw_.x), bf_hi(yw_.x), bf_lo(yw_.y), bf_hi(yw_.y)}; } ss[rr] += (y[rr][j][0] * y[rr][j][0] + y[rr][j][1] * y[rr][j][1]) + (y[rr][j][2] * y[rr][j][2] + y[rr][j][3] * y[rr][j][3]); } }
            const float rstd0 = __builtin_amdgcn_rsqf(wave_sum(ss[0]) * (1.f / DM) + NORM_EPS), rstd1 = __builtin_amdgcn_rsqf(wave_sum(ss[1]) * (1.f / DM) + NORM_EPS);
#pragma unroll
            for (int j = 0; j < 4; ++j) { const f32x4 gt = *(const f32x4*)(gate + 4 * lane + 256 * j), pgv = *(const f32x4*)(pg + 4 * lane + 256 * j);
#pragma unroll
                for (int rr = 0; rr < 2; ++rr) {
                    v[rr][j] = v[rr][j] + gt * (y[rr][j] * (rr ? rstd1 : rstd0) * pgv);
#ifdef PROBE_A
                    if (MODE == 2 && hf == 1 && lr0 + rr < 1024) { v[rr][j] = v[rr][j] + pe2; if (lr0 + rr == 0 && lane == 0 && j == 0) v[rr][j][0] += pe1; }
#endif
                    __builtin_nontemporal_store(v[rr][j], (f32x4*)(x1p + rr * DM + 4 * lane + 256 * j)); } }
        }
        if (MODE <= 1) {
            const float* md = C.mod + ((size_t)MODE * 33 + mrow) * 3072;
            const float* pre = C.pre_g + MODE * DM;
            float ss[2];
#pragma unroll
            for (int rr = 0; rr < 2; ++rr) { ss[rr] = 0.f;
#pragma unroll
                for (int j = 0; j < 4; ++j) ss[rr] += (v[rr][j][0] * v[rr][j][0] + v[rr][j][1] * v[rr][j][1]) + (v[rr][j][2] * v[rr][j][2] + v[rr][j][3] * v[rr][j][3]); }
            const float rstd0 = __builtin_amdgcn_rsqf(wave_sum(ss[0]) * (1.f / DM) + NORM_EPS), rstd1 = __builtin_amdgcn_rsqf(wave_sum(ss[1]) * (1.f / DM) + NORM_EPS);
            bf16_t* hr = C.H + (size_t)lr0 * DM;
#pragma unroll
            for (int j = 0; j < 4; ++j) { const f32x4 sh = *(const f32x4*)(md + 4 * lane + 256 * j), scl = *(const f32x4*)(md + 1024 + 4 * lane + 256 * j), pv = *(const f32x4*)(pre + 4 * lane + 256 * j);
#pragma unroll
                for (int rr = 0; rr < 2; ++rr) st_bf4(hr + rr * DM + 4 * lane + 256 * j, (v[rr][j] * (rr ? rstd1 : rstd0) * pv) * (1.f + scl) + sh); }
        }
    }
}

__device__ __forceinline__ int crow(int r, int hi) { return (r & 3) + 8 * (r >> 2) + 4 * hi; }
__device__ __forceinline__ bf16x8 tanh8(bf16x8 x) {
    const u32x4 w = __builtin_bit_cast(u32x4, x); u32x4 o;
#pragma unroll
    for (int i = 0; i < 4; ++i) { const float a = bf_lo(w[i]), b = bf_hi(w[i]);
        const float ta = 1.f - 2.f * frcp(1.f + fexp2(2.885390081777927f * a)), tb = 1.f - 2.f * frcp(1.f + fexp2(2.885390081777927f * b));
        o[i] = cvt_pk_bf16(ta, tb); }
    return __builtin_bit_cast(bf16x8, o);
}
__device__ __forceinline__ void prep_block(const Ctx& C, int l, int task, LAS unsigned char* lds) {
    const int tid = opaque(threadIdx.x), lane = tid & 63, wid = __builtin_amdgcn_readfirstlane(tid >> 6);
    const int r32 = lane & 31, hi = lane >> 5, lr0 = task * 64;
    constexpr int PST = 520;
    LAS bf16_t* xs = (LAS bf16_t*)lds;
#pragma unroll
    for (int i = 0; i < 8; ++i) { const int idx = tid + 512 * i, row = idx >> 6, ch = idx & 63;
        const u32x4 v = __builtin_nontemporal_load((const u32x4*)(C.P + (size_t)(lr0 + row) * DIN + (ch < 32 ? C_K + ch * 8 : C_LWF + (ch - 32) * 8)));
        *(LAS u32x4*)(xs + row * PST + ch * 8) = v; }
    __syncthreads();
    const int tg = wid & 1, q = wid >> 1, lrw = lr0 + tg * 32;
    const LAS bf16_t* xrow = xs + (tg * 32 + r32) * PST + hi * 8;
    const LAS bf16_t* xcol = xs + (tg * 32) * PST;
    const bf16_t* WT = C.WupT + (size_t)l * 4 * 256 * 64;
    constexpr size_t ARR = (size_t)MH * 256;
#pragma unroll 1
    for (int d = 0; d < 2; ++d) {
        bf16x8 xf[4];
#pragma unroll
        for (int i0 = 0; i0 < 4; ++i0) xf[i0] = tanh8(*(const LAS bf16x8*)(xrow + 256 + d * 64 + i0 * 16));
        const bf16_t* wt = WT + (size_t)d * 256 * 64;
        const float* w0 = C.w0 + (l * 2 + d) * 256;
        float* dst = C.SC + (size_t)d * ARR;
#pragma unroll 1
        for (int jb = 2 * q; jb < 2 * q + 2; ++jb) {
            const int j = jb * 32 + r32;
            f32x16 acc = {};
#pragma unroll
            for (int i0 = 0; i0 < 4; ++i0) { const bf16x8 wf = *(const bf16x8*)(wt + (size_t)j * 64 + i0 * 16 + hi * 8); acc = __builtin_amdgcn_mfma_f32_32x32x16_bf16(xf[i0], wf, acc, 0, 0, 0); }
            const float w0j = w0[j];
#pragma unroll
            for (int r = 0; r < 16; ++r) { const int row = lrw + crow(r, hi);
                const float sg = sigmoidf_(acc[r] + w0j);
                dst[(size_t)row * 256 + j] = fexp2(-0.8750429636f * sg); }
        }
    }
    {
        const int hd = q;
        float rn[16];
        { const float kk0 = C.k_k[l * 256 + hd * 64 + r32], kk1 = C.k_k[l * 256 + hd * 64 + 32 + r32];
#pragma unroll
          for (int r = 0; r < 16; ++r) { const LAS bf16_t* kp = xcol + crow(r, hi) * PST + hd * 64 + r32;
              const float a = bf2f(kp[0]) * kk0, b = bf2f(kp[32]) * kk1; const float s = sum32(a * a + b * b);
              rn[r] = frcp(fmaxf(__builtin_sqrtf(s), 1e-12f)); } }
#pragma unroll 1
        for (int jd = 0; jd < 4; ++jd) {
            const int jb2 = jd >> 1, d = jd & 1;
            const int j = hd * 64 + jb2 * 32 + r32;
            const float kkj = C.k_k[l * 256 + j], kaj = C.k_a[l * 256 + j];
            const bf16_t* wt = WT + (size_t)(2 + d) * 256 * 64;
            f32x16 acc = {};
#pragma unroll
            for (int i0 = 0; i0 < 4; ++i0) { const bf16x8 xf = *(const LAS bf16x8*)(xrow + 384 + d * 64 + i0 * 16);
                const bf16x8 wf = *(const bf16x8*)(wt + (size_t)j * 64 + i0 * 16 + hi * 8); acc = __builtin_amdgcn_mfma_f32_32x32x16_bf16(xf, wf, acc, 0, 0, 0); }
            const float a0j = C.a0[(l * 2 + d) * 256 + j];
            bf16_t* sb16 = (bf16_t*)(C.SC + 2 * ARR);
            bf16_t* dkm = sb16 + (size_t)d * ARR; bf16_t* dbb = sb16 + (size_t)(2 + d) * ARR; bf16_t* daa = sb16 + 4 * ARR;
#pragma unroll
            for (int r = 0; r < 16; ++r) { const int cr = crow(r, hi); const size_t off = (size_t)(lrw + cr) * 256 + j;
                const float k = bf2f(xcol[cr * PST + j]);
                const float a = sigmoidf_(acc[r] + a0j), kkn = k * kkj * rn[r];
                const unsigned pk_ = cvt_pk_bf16(k * (1.f + (a - 1.f) * kaj), kkn * a);
                dkm[off] = (bf16_t)(pk_ & 0xffffu); dbb[off] = (bf16_t)(pk_ >> 16); if (d == 0) daa[off] = (bf16_t)(cvt_pk_bf16(-kkn, 0.f) & 0xffffu); }
        }
    }
    __syncthreads();
}
__device__ __forceinline__ void rowpass4(const Ctx& C, int l, int r0, int lane_in, bool do_conv) {
    const int lane = opaque(lane_in);
    const bool lat = r0 < LATH; const int t0 = lat ? (r0 & (SEQ - 1)) : ((r0 - LATH) & (CTX - 1)), len = lat ? SEQ : CTX;
    const bf16_t* pr = C.P + (size_t)r0 * DIN; const int c = 4 * lane;
    u32x4 qw[4], kw[4];
    if (lat) {
#pragma unroll
        for (int i = 0; i < 4; ++i) { qw[i] = *(const u32x4*)(pr + (size_t)i * DIN + C_AQ + 8 * lane); kw[i] = *(const u32x4*)(pr + (size_t)i * DIN + C_AK + 8 * lane); }
    }
    if (do_conv) {
        f32x4 u[6], bg[4], z[4];
#pragma unroll
        for (int i = 0; i < 6; ++i) { const bool ok = (i == 0) ? (t0 > 0) : (i == 5) ? (t0 + 4 < len) : true;
            const bf16_t* p = pr + (long)(i - 1) * DIN;
            u[i] = ok ? ld_bf4_nt(p + C_CC + c) * ld_bf4_nt(p + C_CH + c) : (f32x4){0.f, 0.f, 0.f, 0.f}; }
#pragma unroll
        for (int i = 0; i < 4; ++i) { bg[i] = ld_bf4_nt(pr + (size_t)i * DIN + C_CB + c); z[i] = ld_bf4_nt(pr + (size_t)i * DIN + C_CZ + c); }
        const float* cw = C.conv_w + l * 3 * 256 + c;
        const f32x4 w0 = *(const f32x4*)cw, w1 = *(const f32x4*)(cw + 256), w2 = *(const f32x4*)(cw + 512);
#pragma unroll
        for (int i = 0; i < 4; ++i) { const f32x4 y = u[i] * w0 + u[i + 1] * w1 + u[i + 2] * w2;
            f32x4 o; o[0] = bg[i][0] * y[0] * siluf_(z[i][0]); o[1] = bg[i][1] * y[1] * siluf_(z[i][1]); o[2] = bg[i][2] * y[2] * siluf_(z[i][2]); o[3] = bg[i][3] * y[3] * siluf_(z[i][3]);
            st_bf4(C.H + (size_t)(r0 + i) * DM + 256 + c, o); }
    }
    if (lat) {
        const float sg = (lane & 2) ? 1.f : -1.f;
#pragma unroll
        for (int i = 0; i < 4; ++i) {
            const int t = t0 + i; const int pos = ((lane >> 2) & 1) ? (t & 63) : (t >> 6);
            const f32x4* rp = (const f32x4*)(C.rope + (pos * 16 + 8 * (lane & 1)) * 2);
            const f32x4 c0 = rp[0], c1 = rp[1], c2 = rp[2], c3 = rp[3];
#pragma unroll
            for (int which = 0; which < 2; ++which) {
                const u32x4 w = which ? kw[i] : qw[i]; u32x4 pw;
#pragma unroll
                for (int e = 0; e < 4; ++e) pw[e] = (unsigned)__builtin_amdgcn_update_dpp(0, (int)w[e], 0x4E, 0xF, 0xF, true);
                u32x4 o;
                o[0] = cvt_pk_bf16(bf_lo(w[0]) * c0[0] + sg * bf_lo(pw[0]) * c0[1], bf_hi(w[0]) * c0[2] + sg * bf_hi(pw[0]) * c0[3]);
                o[1] = cvt_pk_bf16(bf_lo(w[1]) * c1[0] + sg * bf_lo(pw[1]) * c1[1], bf_hi(w[1]) * c1[2] + sg * bf_hi(pw[1]) * c1[3]);
                o[2] = cvt_pk_bf16(bf_lo(w[2]) * c2[0] + sg * bf_lo(pw[2]) * c2[1], bf_hi(w[2]) * c2[2] + sg * bf_hi(pw[2]) * c2[3]);
                o[3] = cvt_pk_bf16(bf_lo(w[3]) * c3[0] + sg * bf_lo(pw[3]) * c3[1], bf_hi(w[3]) * c3[2] + sg * bf_hi(pw[3]) * c3[3]);
                *(u32x4*)(C.P + (size_t)(r0 + i) * DIN + (which ? C_AK : C_AQ) + 8 * lane) = o;
            }
        }
    }
}
__device__ __forceinline__ void conv_row(const Ctx& C, int l, int lr, int lane_in) {
    const int lane = opaque(lane_in);
    const bool lat = lr < LATH; const int t = lat ? (lr & (SEQ - 1)) : ((lr - LATH) & (CTX - 1)), len = lat ? SEQ : CTX;
    const bf16_t* pr = C.P + (size_t)lr * DIN; const int c = 4 * lane;
    const float* cw = C.conv_w + l * 3 * 256 + c;
    const f32x4 w0 = *(const f32x4*)cw, w1 = *(const f32x4*)(cw + 256), w2 = *(const f32x4*)(cw + 512);
    f32x4 y = (ld_bf4(pr + C_CC + c) * ld_bf4(pr + C_CH + c)) * w1;
    if (t > 0) y = y + (ld_bf4(pr - DIN + C_CC + c) * ld_bf4(pr - DIN + C_CH + c)) * w0;
    if (t < len - 1) y = y + (ld_bf4(pr + DIN + C_CC + c) * ld_bf4(pr + DIN + C_CH + c)) * w2;
    const f32x4 bg = ld_bf4(pr + C_CB + c), z = ld_bf4(pr + C_CZ + c);
    f32x4 o; o[0] = bg[0] * y[0] * siluf_(z[0]); o[1] = bg[1] * y[1] * siluf_(z[1]); o[2] = bg[2] * y[2] * siluf_(z[2]); o[3] = bg[3] * y[3] * siluf_(z[3]);
    st_bf4(C.H + (size_t)lr * DM + 256 + c, o);
}

__device__ __forceinline__ void rope_row(const Ctx& C, int lr, int lane_in) {
    const int lane = opaque(lane_in);
    const int t = lr & (SEQ - 1); const int pos = ((lane >> 2) & 1) ? (t & 63) : (t >> 6);
    const f32x4* rp = (const f32x4*)(C.rope + (pos * 16 + 8 * (lane & 1)) * 2);
    const f32x4 c0 = rp[0], c1 = rp[1], c2 = rp[2], c3 = rp[3];
    const float sg = (lane & 2) ? 1.f : -1.f;
#pragma unroll
    for (int which = 0; which < 2; ++which) {
        bf16_t* p = C.P + (size_t)lr * DIN + (which ? C_AK : C_AQ) + 8 * lane;
        const u32x4 w = *(const u32x4*)p; u32x4 pw;
#pragma unroll
        for (int i = 0; i < 4; ++i) pw[i] = (unsigned)__builtin_amdgcn_update_dpp(0, (int)w[i], 0x4E, 0xF, 0xF, true);
        u32x4 o;
        o[0] = cvt_pk_bf16(bf_lo(w[0]) * c0[0] + sg * bf_lo(pw[0]) * c0[1], bf_hi(w[0]) * c0[2] + sg * bf_hi(pw[0]) * c0[3]);
        o[1] = cvt_pk_bf16(bf_lo(w[1]) * c1[0] + sg * bf_lo(pw[1]) * c1[1], bf_hi(w[1]) * c1[2] + sg * bf_hi(pw[1]) * c1[3]);
        o[2] = cvt_pk_bf16(bf_lo(w[2]) * c2[0] + sg * bf_lo(pw[2]) * c2[1], bf_hi(w[2]) * c2[2] + sg * bf_hi(pw[2]) * c2[3]);
        o[3] = cvt_pk_bf16(bf_lo(w[3]) * c3[0] + sg * bf_lo(pw[3]) * c3[1], bf_hi(w[3]) * c3[2] + sg * bf_hi(pw[3]) * c3[3]);
        *(u32x4*)p = o;
    }
}

__device__ __forceinline__ int scan_row(int s, int dir, int bl) {
    if (s < CTX) { const int t = dir ? (CTX - 1 - s) : s; return LATH + bl * CTX + t; }
    const int t0 = s - CTX; const int t = dir ? (SEQ - 1 - t0) : t0; return bl * SEQ + t;
}
__device__ __forceinline__ void scan_unit(const Ctx& C, int l, int u, LAS unsigned char* lds) {
    const int bl = u >> 3, hd = (u >> 1) & 3, dir = u & 1;
    const int tid = opaque(threadIdx.x), lane = tid & 63, wid = __builtin_amdgcn_readfirstlane(tid >> 6);
    constexpr size_t ARR = (size_t)MH * 256;
    constexpr int CHF = 32 * 6 * 64;
    constexpr int YB0 = 2 * CHF;
    const int lst = tid >> 4, q4 = tid & 15;
    const float* a_dec = C.SC + (size_t)dir * ARR + hd * 64 + q4 * 4;
    const bf16_t* sb16 = (const bf16_t*)(C.SC + 2 * ARR);
    const bf16_t* a_km = sb16 + (size_t)dir * ARR + hd * 64 + q4 * 4;
    const bf16_t* a_bb = sb16 + (size_t)(2 + dir) * ARR + hd * 64 + q4 * 4;
    const bf16_t* a_aa = sb16 + 4 * ARR + hd * 64 + q4 * 4;
    const bf16_t* a_r = C.P + C_R + hd * 64 + q4 * 4;
    const bf16_t* a_v = C.P + C_V + hd * 64 + q4 * 4;
    float* a_y = C.YS + (size_t)dir * ARR + hd * 64 + q4 * 4;
    f32x4 g0, g1, g2, g3, g4, g5;
#define SC_LOAD(c) do { const size_t row_ = (size_t)scan_row((c) * 32 + lst, dir, bl); \
        g0 = *(const f32x4*)(a_dec + row_ * 256); g1 = ld_bf4(a_km + row_ * 256); g2 = ld_bf4(a_aa + row_ * 256); g3 = ld_bf4(a_bb + row_ * 256); \
        g4 = ld_bf4(a_r + row_ * DIN); g5 = ld_bf4(a_v + row_ * DIN); } while (0)
#define SC_WRITE(b) do { LAS float* d_ = (LAS float*)lds + (b) * CHF + lst * 384 + q4 * 4; \
        *(LAS f32x4*)(d_) = g0; *(LAS f32x4*)(d_ + 64) = g1; *(LAS f32x4*)(d_ + 128) = g2; *(LAS f32x4*)(d_ + 192) = g3; *(LAS f32x4*)(d_ + 256) = g4; *(LAS f32x4*)(d_ + 320) = g5; } while (0)
    f32x4 S0 = {0.f, 0.f, 0.f, 0.f}, S1 = {0.f, 0.f, 0.f, 0.f};
    const int vq = lane >> 4, k16 = lane & 15;
    const int rloc = 8 * wid + 2 * vq;
    SC_LOAD(0); SC_WRITE(0); __syncthreads();
    constexpr int NCH = (CTX + SEQ) / 32;
#pragma unroll 1
    for (int c = 0; c < NCH; ++c) {
        if (c > 0 && ((c - 1 >= CTX / 32) || (l == 0))) {
            const f32x4 yv = *(const LAS f32x4*)((const LAS float*)lds + YB0 + ((c - 1) & 1) * 2048 + lst * 64 + q4 * 4);
            *(f32x4*)(a_y + (size_t)scan_row((c - 1) * 32 + lst, dir, bl) * 256) = yv;
        }
        if (c + 1 < NCH) SC_LOAD(c + 1);
        {
            const LAS float* cb = (const LAS float*)lds + (c & 1) * CHF + k16 * 4;
            const LAS float* vbp = (const LAS float*)lds + (c & 1) * CHF + 320 + rloc;
            LAS float* yb = (LAS float*)lds + YB0 + (c & 1) * 2048 + rloc + (k16 & 1);
            const bool wout = (c >= CTX / 32) || (l == 0);
            f32x4 wA, kA, aA, bA, rA, wB, kB, aB, bB, rB; f32x2 vA, vB;
#define SC_RD(W, K, A, B, R, V, s) do { const LAS float* sb_ = cb + (s) * 384; W = *(const LAS f32x4*)(sb_); K = *(const LAS f32x4*)(sb_ + 64); A = *(const LAS f32x4*)(sb_ + 128); \
        B = *(const LAS f32x4*)(sb_ + 192); R = *(const LAS f32x4*)(sb_ + 256); V = *(const LAS f32x2*)(vbp + (s) * 384); } while (0)
#define SC_STEP(W, K, A, B, R, V, DOST, s) do { \
        float sa0 = fmaf(S0[3], A[3], fmaf(S0[2], A[2], fmaf(S0[1], A[1], S0[0] * A[0]))); \
        float sa1 = fmaf(S1[3], A[3], fmaf(S1[2], A[2], fmaf(S1[1], A[1], S1[0] * A[0]))); \
        sa0 = sum16(sa0); sa1 = sum16(sa1); \
        S0 = S0 * W + sa0 * B + V[0] * K; S1 = S1 * W + sa1 * B + V[1] * K; \
        if (DOST) { \
        float y0 = fmaf(S0[3], R[3], fmaf(S0[2], R[2], fmaf(S0[1], R[1], S0[0] * R[0]))); \
        float y1 = fmaf(S1[3], R[3], fmaf(S1[2], R[2], fmaf(S1[1], R[1], S1[0] * R[0]))); \
        y0 = sum16(y0); y1 = sum16(y1); \
        yb[(s) * 64] = (k16 & 1) ? y1 : y0; } } while (0)
            SC_RD(wA, kA, aA, bA, rA, vA, 0);
            if (wout) {
#pragma unroll 2
                for (int s = 0; s < 32; s += 2) { SC_RD(wB, kB, aB, bB, rB, vB, s + 1); SC_STEP(wA, kA, aA, bA, rA, vA, true, s);
                                                  SC_RD(wA, kA, aA, bA, rA, vA, s + 2); SC_STEP(wB, kB, aB, bB, rB, vB, true, s + 1); }
            } else {
#pragma unroll 2
                for (int s = 0; s < 32; s += 2) { SC_RD(wB, kB, aB, bB, rB, vB, s + 1); SC_STEP(wA, kA, aA, bA, rA, vA, false, s);
                                                  SC_RD(wA, kA, aA, bA, rA, vA, s + 2); SC_STEP(wB, kB, aB, bB, rB, vB, false, s + 1); }
            }
#undef SC_RD
#undef SC_STEP
        }
        if (c + 1 < NCH) SC_WRITE((c + 1) & 1);
        __syncthreads();
    }
    { const f32x4 yv = *(const LAS f32x4*)((const LAS float*)lds + YB0 + ((NCH - 1) & 1) * 2048 + lst * 64 + q4 * 4);
      *(f32x4*)(a_y + (size_t)scan_row((NCH - 1) * 32 + lst, dir, bl) * 256) = yv; }
    __syncthreads();
#undef SC_LOAD
#undef SC_WRITE
}

constexpr int CK_RAW = 0, CK_XA = 24576, CK_ZB = 29184, CK_EZ = 33792  , CK_UV = 44032  , CK_PP = 54272, CK_S0 = 56832, CK_GF = 66048, CK_R0 = 70656, CK_DC = 79872  , CK_END = 80384;
__device__ __forceinline__ void ck_images(LAS float* RAW, LAS bf16_t* XA, LAS bf16_t* ZB, LAS bf16_t* EZ, LAS bf16_t* UV, LAS float* DC, int s) {
    const int lt = s >> 5, kp = (s & 31) * 2;
    float c0 = 1.f, c1 = 1.f, cp0 = 1.f, cp1 = 1.f, ct0 = 1.f, ct1 = 1.f;
#pragma unroll
    for (int j = 0; j < 16; ++j) { const f32x2 w = *(const LAS f32x2*)(RAW + j * 64 + kp); if (j == lt) { cp0 = c0; cp1 = c1; } c0 *= w[0]; c1 *= w[1]; if (j == lt) { ct0 = c0; ct1 = c1; } }
    const f32x2 aa = *(const LAS f32x2*)(RAW + 1024 + lt * 64 + kp), bb = *(const LAS f32x2*)(RAW + 2048 + lt * 64 + kp), km = *(const LAS f32x2*)(RAW + 3072 + lt * 64 + kp),
                rr = *(const LAS f32x2*)(RAW + 4096 + lt * 64 + kp), vv = *(const LAS f32x2*)(RAW + 5120 + lt * 64 + kp);
    const float en0 = frcp(ct0), en1 = frcp(ct1), ee0 = c0 * en0, ee1 = c1 * en1;
    *(LAS unsigned*)(XA + lt * 72 + kp) = cvt_pk_bf16(aa[0] * cp0, aa[1] * cp1);
    *(LAS unsigned*)(XA + (16 + lt) * 72 + kp) = cvt_pk_bf16(rr[0] * ct0, rr[1] * ct1);
    *(LAS unsigned*)(ZB + lt * 72 + kp) = cvt_pk_bf16(bb[0] * en0, bb[1] * en1);
    *(LAS unsigned*)(ZB + (16 + lt) * 72 + kp) = cvt_pk_bf16(km[0] * en0, km[1] * en1);
    const unsigned eb = cvt_pk_bf16(bb[0] * ee0, bb[1] * ee1), ek = cvt_pk_bf16(km[0] * ee0, km[1] * ee1), ev = cvt_pk_bf16(vv[0], vv[1]);
    EZ[kp * 40 + lt] = (bf16_t)(eb & 0xffffu); EZ[(kp + 1) * 40 + lt] = (bf16_t)(eb >> 16);
    EZ[kp * 40 + 16 + lt] = (bf16_t)(ek & 0xffffu); EZ[(kp + 1) * 40 + 16 + lt] = (bf16_t)(ek >> 16);
    UV[kp * 40 + 16 + lt] = (bf16_t)(ev & 0xffffu); UV[(kp + 1) * 40 + 16 + lt] = (bf16_t)(ev >> 16);
    if (lt == 0) *(LAS f32x2*)(DC + kp) = (f32x2){c0, c1};
}
__device__ __forceinline__ void scan_chunked(const Ctx& C, int l, int u, LAS unsigned char* lds) {
    const int bl = u >> 3, hd = (u >> 1) & 3, dir = u & 1;
    const int tid0 = opaque(threadIdx.x), wid = __builtin_amdgcn_readfirstlane(tid0 >> 6);
    constexpr size_t ARR = (size_t)MH * 256;
    LAS float* RAW = (LAS float*)(lds + CK_RAW);
    LAS bf16_t* XA = (LAS bf16_t*)(lds + CK_XA);
    LAS bf16_t* ZB = (LAS bf16_t*)(lds + CK_ZB);
    LAS bf16_t* EZ0 = (LAS bf16_t*)(lds + CK_EZ);
    LAS bf16_t* UV0 = (LAS bf16_t*)(lds + CK_UV);
    LAS bf16_t* PP = (LAS bf16_t*)(lds + CK_PP);
    LAS bf16_t* S0 = (LAS bf16_t*)(lds + CK_S0);
    LAS float* GF = (LAS float*)(lds + CK_GF);
    LAS float* R0 = (LAS float*)(lds + CK_R0);
    LAS float* DC0 = (LAS float*)(lds + CK_DC);
    const bf16_t* sb16 = (const bf16_t*)(C.SC + 2 * ARR);
    f32x2 ld_w; unsigned ld_km, ld_bb, ld_aa, ld_r, ld_v;
#define CK_LOAD(c) do { const int tl_ = opaque(tid0); const size_t row_ = (size_t)scan_row((c) * 16 + (tl_ >> 5), dir, bl); const size_t o2_ = row_ * 256 + hd * 64 + (tl_ & 31) * 2, op_ = row_ * DIN + hd * 64 + (tl_ & 31) * 2; \
        ld_w = __builtin_nontemporal_load((const f32x2*)(C.SC + (size_t)dir * ARR + o2_)); ld_km = __builtin_nontemporal_load((const unsigned*)(sb16 + (size_t)dir * ARR + o2_)); \
        ld_bb = __builtin_nontemporal_load((const unsigned*)(sb16 + (size_t)(2 + dir) * ARR + o2_)); ld_aa = __builtin_nontemporal_load((const unsigned*)(sb16 + 4 * ARR + o2_)); ld_r = __builtin_nontemporal_load((const unsigned*)(C.P + C_R + op_)); ld_v = __builtin_nontemporal_load((const unsigned*)(C.P + C_V + op_)); } while (0)
#define CK_STORE() do { const int ts_ = opaque(tid0); LAS float* q_ = RAW + (ts_ >> 5) * 64 + (ts_ & 31) * 2; \
        *(LAS f32x2*)(q_) = ld_w; *(LAS f32x2*)(q_ + 1024) = (f32x2){bf_lo(ld_aa), bf_hi(ld_aa)}; \
        *(LAS f32x2*)(q_ + 2048) = (f32x2){bf_lo(ld_bb), bf_hi(ld_bb)}; *(LAS f32x2*)(q_ + 3072) = (f32x2){bf_lo(ld_km), bf_hi(ld_km)}; \
        *(LAS f32x2*)(q_ + 4096) = (f32x2){bf_lo(ld_r), bf_hi(ld_r)}; *(LAS f32x2*)(q_ + 5120) = (f32x2){bf_lo(ld_v), bf_hi(ld_v)}; } while (0)
    for (int e = tid0; e < CK_END / 4; e += 512) ((LAS unsigned*)lds)[e] = 0u;
    __syncthreads();
    f32x16 S = {};
    const int vt = (wid >> 1) & 1, kt = wid & 1;
    constexpr int NCH = (CTX + SEQ) / 16;
    CK_LOAD(0); CK_STORE(); __syncthreads();
    ck_images(RAW, XA, ZB, EZ0, UV0, DC0, opaque(tid0));
    CK_LOAD(1);
    __syncthreads();
#pragma unroll 1
    for (int c = 0; c < NCH; ++c) {
        const int pb = c & 1;
        LAS bf16_t* EZ = EZ0 + pb * (64 * 40); LAS bf16_t* UV = UV0 + pb * (64 * 40); LAS float* DC = DC0 + pb * 64;
        if (c + 1 < NCH) CK_STORE();
        if (c + 2 < NCH) CK_LOAD(c + 2);
        if (wid == 0) {
            const int ln = opaque(tid0) & 63, r32 = ln & 31, hi = ln >> 5;
            f32x16 acc = {};
#pragma unroll
            for (int d0 = 0; d0 < 4; ++d0) { const bf16x8 a = *(const LAS bf16x8*)(XA + r32 * 72 + d0 * 16 + hi * 8), b = *(const LAS bf16x8*)(ZB + r32 * 72 + d0 * 16 + hi * 8);
                acc = __builtin_amdgcn_mfma_f32_32x32x16_bf16(a, b, acc, 0, 0, 0); }
#pragma unroll
            for (int r = 0; r < 16; ++r) GF[crow(r, hi) * 36 + r32] = acc[r];
        } else if (wid <= 2) {
            const int ln = opaque(tid0) & 63, r32 = ln & 31, hi = ln >> 5;
            const int v0 = (wid - 1) * 32;
            f32x16 acc = {};
#pragma unroll
            for (int d0 = 0; d0 < 4; ++d0) { const bf16x8 a = *(const LAS bf16x8*)(S0 + (v0 + r32) * 72 + d0 * 16 + hi * 8), b = *(const LAS bf16x8*)(XA + r32 * 72 + d0 * 16 + hi * 8);
                acc = __builtin_amdgcn_mfma_f32_32x32x16_bf16(a, b, acc, 0, 0, 0); }
#pragma unroll
            for (int r = 0; r < 16; ++r) R0[(v0 + crow(r, hi)) * 36 + r32] = acc[r];
        }
        __syncthreads();
        if (wid == 3) {
            const int v = opaque(tid0) & 63;
            float uu[16], vq[16];
#pragma unroll
            for (int q = 0; q < 4; ++q) { const f32x4 x = *(const LAS f32x4*)(R0 + v * 36 + 4 * q); uu[4 * q] = x[0]; uu[4 * q + 1] = x[1]; uu[4 * q + 2] = x[2]; uu[4 * q + 3] = x[3]; }
#pragma unroll
            for (int q = 0; q < 2; ++q) { const u32x4 x = *(const LAS u32x4*)(UV + v * 40 + 16 + 8 * q);
#pragma unroll
                for (int e = 0; e < 4; ++e) { vq[8 * q + 2 * e] = bf_lo(x[e]); vq[8 * q + 2 * e + 1] = bf_hi(x[e]); } }
#pragma unroll
            for (int t = 1; t < 16; ++t) {
                float a0 = uu[t], a1 = 0.f, a2 = 0.f, a3 = 0.f;
#pragma unroll
                for (int q = 0; q * 4 < t; ++q) { const f32x4 m = *(const LAS f32x4*)(GF + t * 36 + 4 * q), n = *(const LAS f32x4*)(GF + t * 36 + 16 + 4 * q);
#pragma unroll
                    for (int e = 0; e < 4; ++e) if (4 * q + e < t) { if (e & 1) { a1 = fmaf(uu[4 * q + e], m[e], a1); a3 = fmaf(vq[4 * q + e], n[e], a3); } else { a0 = fmaf(uu[4 * q + e], m[e], a0); a2 = fmaf(vq[4 * q + e], n[e], a2); } } }
                uu[t] = (a0 + a1) + (a2 + a3);
            }
            u32x4 w0, w1;
            w0[0] = cvt_pk_bf16(uu[0], uu[1]); w0[1] = cvt_pk_bf16(uu[2], uu[3]); w0[2] = cvt_pk_bf16(uu[4], uu[5]); w0[3] = cvt_pk_bf16(uu[6], uu[7]);
            w1[0] = cvt_pk_bf16(uu[8], uu[9]); w1[1] = cvt_pk_bf16(uu[10], uu[11]); w1[2] = cvt_pk_bf16(uu[12], uu[13]); w1[3] = cvt_pk_bf16(uu[14], uu[15]);
            *(LAS u32x4*)(UV + v * 40) = w0; *(LAS u32x4*)(UV + v * 40 + 8) = w1;
        } else if (wid == 4) {
            const int ln = opaque(tid0) & 63; const int t = ln >> 2, jq = (ln & 3) * 8;
            const f32x4 g0 = *(const LAS f32x4*)(GF + (16 + t) * 36 + jq), g1 = *(const LAS f32x4*)(GF + (16 + t) * 36 + jq + 4);
            float x[8] = {g0[0], g0[1], g0[2], g0[3], g1[0], g1[1], g1[2], g1[3]};
#pragma unroll
            for (int e = 0; e < 8; ++e) { const int i = (jq + e) & 15; if (i > t) x[e] = 0.f; }
            u32x4 w; w[0] = cvt_pk_bf16(x[0], x[1]); w[1] = cvt_pk_bf16(x[2], x[3]); w[2] = cvt_pk_bf16(x[4], x[5]); w[3] = cvt_pk_bf16(x[6], x[7]);
            *(LAS u32x4*)(PP + t * 40 + jq) = w;
        } else if (c + 1 < NCH) {
            const int w6 = (wid < 3) ? wid : wid - 2;
            const int s0 = w6 * 64 + (opaque(tid0) & 63);
            LAS bf16_t* EZn = EZ0 + (pb ^ 1) * (64 * 40); LAS bf16_t* UVn = UV0 + (pb ^ 1) * (64 * 40); LAS float* DCn = DC0 + (pb ^ 1) * 64;
            ck_images(RAW, XA, ZB, EZn, UVn, DCn, s0);
            if (s0 < 128) ck_images(RAW, XA, ZB, EZn, UVn, DCn, s0 + 384);
        }
        __syncthreads();
        if (wid < 4) {
            const int ln = opaque(tid0) & 63, r32 = ln & 31, hi = ln >> 5;
            const float dc = DC[kt * 32 + r32];
#pragma unroll
            for (int r = 0; r < 16; ++r) S[r] *= dc;
#pragma unroll
            for (int js = 0; js < 2; ++js) { const bf16x8 a = *(const LAS bf16x8*)(UV + (vt * 32 + r32) * 40 + js * 16 + hi * 8), b = *(const LAS bf16x8*)(EZ + (kt * 32 + r32) * 40 + js * 16 + hi * 8);
                S = __builtin_amdgcn_mfma_f32_32x32x16_bf16(a, b, S, 0, 0, 0); }
            asm volatile("s_nop 15\n\ts_nop 7" : "+v"(S));
#pragma unroll
            for (int r = 0; r < 16; r += 2) { const unsigned pk = cvt_pk_bf16(S[r], S[r + 1]);
                S0[(vt * 32 + crow(r, hi)) * 72 + kt * 32 + r32] = (bf16_t)(pk & 0xffffu); S0[(vt * 32 + crow(r + 1, hi)) * 72 + kt * 32 + r32] = (bf16_t)(pk >> 16); }
        } else if ((wid == 5 || wid == 6) && ((c >= CTX / 16) || (l == 0))) {
            const int ln = opaque(tid0) & 63, r32 = ln & 31, hi = ln >> 5;
            const int v0 = (wid - 5) * 32;
            f32x16 acc;
#pragma unroll
            for (int r = 0; r < 16; ++r) acc[r] = (r32 < 16) ? R0[(v0 + crow(r, hi)) * 36 + 16 + r32] : 0.f;
#pragma unroll
            for (int js = 0; js < 2; ++js) { const bf16x8 a = *(const LAS bf16x8*)(UV + (v0 + r32) * 40 + js * 16 + hi * 8), b = *(const LAS bf16x8*)(PP + r32 * 40 + js * 16 + hi * 8);
                acc = __builtin_amdgcn_mfma_f32_32x32x16_bf16(a, b, acc, 0, 0, 0); }
            if (r32 < 16) { float* yp = C.YS + (size_t)dir * ARR + hd * 64 + (size_t)scan_row(c * 16 + r32, dir, bl) * 256 + v0 + 4 * hi;
#pragma unroll
                for (int q = 0; q < 4; ++q) *(f32x4*)(yp + 8 * q) = (f32x4){acc[4 * q], acc[4 * q + 1], acc[4 * q + 2], acc[4 * q + 3]}; }
        }
        __syncthreads();
    }
#undef CK_LOAD
#undef CK_STORE
}

#define KSWZ(row, colB) ((row) * 256 + ((colB) ^ (((row) & 7) << 4)))
#define SBAR() __builtin_amdgcn_sched_barrier(0)
constexpr int SHM_KV = 64 * 128 * 2;
constexpr float ATT_THR = 11.5f;
__device__ __forceinline__ int v_st(int k, int c) { const int kk = (k & ~0xC) | ((k & 4) << 1) | ((k & 8) >> 1); return ((kk >> 3) * 4 + (c >> 5)) * 512 + ((kk & 7) * 32 + (c & 31)) * 2; }
__device__ __forceinline__ int v_rd_base(int lane) { return ((lane & 3) << 3) | (((lane >> 2) & 3) << 6) | (((lane >> 4) & 1) << 5) | (((lane >> 5) & 1) << 8); }
constexpr int v_rd_off(int d0, int ks, int half) { return d0 * 512 + ks * 4096 + half * 2048; }
template <int OFF> __device__ __forceinline__ s16x4 tr_read(int vb) { s16x4 r; asm volatile("ds_read_b64_tr_b16 %0, %1 offset:%2" : "=&v"(r) : "v"(vb), "i"(OFF) : "memory"); return r; }
struct VFrag { s16x4 l0, h0, l1, h1, l2, h2, l3, h3; };
template <int D0> __device__ __forceinline__ void v_reads(VFrag& f, int vb) {
    f.l0 = tr_read<v_rd_off(D0, 0, 0)>(vb); f.h0 = tr_read<v_rd_off(D0, 0, 1)>(vb); f.l1 = tr_read<v_rd_off(D0, 1, 0)>(vb); f.h1 = tr_read<v_rd_off(D0, 1, 1)>(vb);
    f.l2 = tr_read<v_rd_off(D0, 2, 0)>(vb); f.h2 = tr_read<v_rd_off(D0, 2, 1)>(vb); f.l3 = tr_read<v_rd_off(D0, 3, 0)>(vb); f.h3 = tr_read<v_rd_off(D0, 3, 1)>(vb);
}
__device__ __forceinline__ void pv_mma(f32x16& od, const VFrag& f, bf16x8 pa0, bf16x8 pa1, bf16x8 pa2, bf16x8 pa3) {
#define PKV(L, H) (bf16x8){L[0], L[1], L[2], L[3], H[0], H[1], H[2], H[3]}
    od = __builtin_amdgcn_mfma_f32_32x32x16_bf16(pa0, PKV(f.l0, f.h0), od, 0, 0, 0);
    od = __builtin_amdgcn_mfma_f32_32x32x16_bf16(pa1, PKV(f.l1, f.h1), od, 0, 0, 0);
    od = __builtin_amdgcn_mfma_f32_32x32x16_bf16(pa2, PKV(f.l2, f.h2), od, 0, 0, 0);
    od = __builtin_amdgcn_mfma_f32_32x32x16_bf16(pa3, PKV(f.l3, f.h3), od, 0, 0, 0);
#undef PKV
}
template <int KS> __device__ __forceinline__ void v_reads_ks(s16x4 (&l)[4], s16x4 (&h)[4], int vb) {
    l[0] = tr_read<v_rd_off(0, KS, 0)>(vb); h[0] = tr_read<v_rd_off(0, KS, 1)>(vb); l[1] = tr_read<v_rd_off(1, KS, 0)>(vb); h[1] = tr_read<v_rd_off(1, KS, 1)>(vb);
    l[2] = tr_read<v_rd_off(2, KS, 0)>(vb); h[2] = tr_read<v_rd_off(2, KS, 1)>(vb); l[3] = tr_read<v_rd_off(3, KS, 0)>(vb); h[3] = tr_read<v_rd_off(3, KS, 1)>(vb);
}
__device__ __forceinline__ void pv_mma_ks(f32x16 (&o)[4], const s16x4 (&l)[4], const s16x4 (&h)[4], bf16x8 pa) {
#define PKV(L, H) (bf16x8){L[0], L[1], L[2], L[3], H[0], H[1], H[2], H[3]}
    __builtin_amdgcn_s_setprio(1);
    o[0] = __builtin_amdgcn_mfma_f32_32x32x16_bf16(pa, PKV(l[0], h[0]), o[0], 0, 0, 0);
    o[1] = __builtin_amdgcn_mfma_f32_32x32x16_bf16(pa, PKV(l[1], h[1]), o[1], 0, 0, 0);
    o[2] = __builtin_amdgcn_mfma_f32_32x32x16_bf16(pa, PKV(l[2], h[2]), o[2], 0, 0, 0);
    o[3] = __builtin_amdgcn_mfma_f32_32x32x16_bf16(pa, PKV(l[3], h[3]), o[3], 0, 0, 0);
    __builtin_amdgcn_s_setprio(0);
#undef PKV
}
__device__ __forceinline__ void pv_all(f32x16 (&o)[4], int vb, bf16x8 pa0, bf16x8 pa1, bf16x8 pa2, bf16x8 pa3) {
    s16x4 l[4], h[4];
    v_reads_ks<0>(l, h, vb); asm volatile("s_waitcnt lgkmcnt(0)" ::: "memory"); SBAR(); pv_mma_ks(o, l, h, pa0);
    v_reads_ks<1>(l, h, vb); asm volatile("s_waitcnt lgkmcnt(0)" ::: "memory"); SBAR(); pv_mma_ks(o, l, h, pa1);
    v_reads_ks<2>(l, h, vb); asm volatile("s_waitcnt lgkmcnt(0)" ::: "memory"); SBAR(); pv_mma_ks(o, l, h, pa2);
    v_reads_ks<3>(l, h, vb); asm volatile("s_waitcnt lgkmcnt(0)" ::: "memory"); SBAR(); pv_mma_ks(o, l, h, pa3);
}
__device__ __forceinline__ void qk_tile(f32x16& p0, f32x16& p1, const bf16x8* qr, const char* Ks, int cb0, int r32, int hi) {
    bf16x8 kf[8];
#pragma unroll
    for (int d0 = 0; d0 < 4; ++d0) { const int cb = cb0 + (d0 * 16 + hi * 8) * 2; kf[2 * d0] = *(const bf16x8*)(Ks + KSWZ(r32, cb)); kf[2 * d0 + 1] = *(const bf16x8*)(Ks + KSWZ(32 + r32, cb)); }
    p0 = f32x16{}; p1 = f32x16{};
    __builtin_amdgcn_s_setprio(1);
#pragma unroll
    for (int d0 = 0; d0 < 4; ++d0) {
        p0 = __builtin_amdgcn_mfma_f32_32x32x16_bf16(kf[2 * d0], qr[d0], p0, 0, 0, 0);
        p1 = __builtin_amdgcn_mfma_f32_32x32x16_bf16(kf[2 * d0 + 1], qr[d0], p1, 0, 0, 0); }
    __builtin_amdgcn_s_setprio(0);
}
__device__ __forceinline__ void sm_pv(f32x16 (&o)[4], f32x16& p0, f32x16& p1, float& m_reg, float& l_reg, int vb, float* al_l, int r32, int hi) {
    float pmax;
    { float m0 = fmaxf(p0[0], p1[0]), m1 = fmaxf(p0[1], p1[1]), m2 = fmaxf(p0[2], p1[2]), m3 = fmaxf(p0[3], p1[3]);
#pragma unroll
      for (int r = 4; r < 16; r += 4) { m0 = fmaxf(fmaxf(m0, p0[r]), p1[r]); m1 = fmaxf(fmaxf(m1, p0[r + 1]), p1[r + 1]); m2 = fmaxf(fmaxf(m2, p0[r + 2]), p1[r + 2]); m3 = fmaxf(fmaxf(m3, p0[r + 3]), p1[r + 3]); }
      pmax = fmaxf(fmaxf(m0, m1), fmaxf(m2, m3)); }
    { auto rr = __builtin_amdgcn_permlane32_swap(__float_as_uint(pmax), __float_as_uint(pmax), false, false); pmax = fmaxf(__uint_as_float(rr[0]), __uint_as_float(rr[1])); }
    float mn, alpha;
    if (__builtin_expect(__all(pmax - m_reg <= ATT_THR), 1)) { mn = m_reg; alpha = 1.f; }
    else { mn = fmaxf(m_reg, pmax); alpha = fexp2(m_reg - mn); m_reg = mn; }
#pragma unroll
    for (int r = 0; r < 16; ++r) { p0[r] = fexp2(p0[r] - mn); p1[r] = fexp2(p1[r] - mn); }
    float ps;
    { float s0 = p0[0] + p1[0], s1 = p0[1] + p1[1], s2 = p0[2] + p1[2], s3 = p0[3] + p1[3];
#pragma unroll
      for (int r = 4; r < 16; r += 4) { s0 += p0[r] + p1[r]; s1 += p0[r + 1] + p1[r + 1]; s2 += p0[r + 2] + p1[r + 2]; s3 += p0[r + 3] + p1[r + 3]; }
      ps = (s0 + s1) + (s2 + s3); }
    { auto rr = __builtin_amdgcn_permlane32_swap(__float_as_uint(ps), __float_as_uint(ps), false, false); ps = __uint_as_float(rr[0]) + __uint_as_float(rr[1]); }
    l_reg = l_reg * alpha + ps;
    if (__any(alpha < 1.f)) { if (hi == 0) al_l[r32] = alpha; asm volatile("s_waitcnt lgkmcnt(0)" ::: "memory");
#pragma unroll
        for (int d = 0; d < 4; ++d)
#pragma unroll
            for (int r = 0; r < 16; ++r) o[d][r] *= al_l[crow(r, hi)]; }
    bf16x8 pa0, pa1, pa2, pa3;
#define PK4(P, BASE, OUT) do { unsigned a0 = cvt_pk_bf16(P[BASE + 0], P[BASE + 1]), a1 = cvt_pk_bf16(P[BASE + 2], P[BASE + 3]); \
        unsigned b0 = cvt_pk_bf16(P[BASE + 4], P[BASE + 5]), b1 = cvt_pk_bf16(P[BASE + 6], P[BASE + 7]); \
        auto r0 = __builtin_amdgcn_permlane32_swap(a0, b0, false, false); auto r1 = __builtin_amdgcn_permlane32_swap(a1, b1, false, false); \
        u32x4 w = {r0[0], r1[0], r0[1], r1[1]}; OUT = __builtin_bit_cast(bf16x8, w); } while (0)
    PK4(p0, 0, pa0); PK4(p0, 8, pa1); PK4(p1, 0, pa2); PK4(p1, 8, pa3);
#undef PK4
    pv_all(o, vb, pa0, pa1, pa2, pa3);
}
__device__ __forceinline__ void attn_unit(const Ctx& C, int l, int hd, int qrow0, int latbase, int ctxbase, int nlat, int NT, float lam, char* lds) {
    const int tid = opaque(threadIdx.x), wid = __builtin_amdgcn_readfirstlane(tid >> 6), lane = tid & 63, r32 = lane & 31, hi = lane >> 5, g = wid & 3, sj = wid >> 2;
    char* V_lds = lds; char* K_lds = lds + 2 * SHM_KV;
    float* wsf = (float*)(lds + 5 * SHM_KV) + wid * 64; float* al_l = wsf; float* li_l = wsf + 32;
    const bf16_t* Qw = C.P + (size_t)(qrow0 + g * 32 + r32) * DIN + C_AQ + hd * 128 + sj * 64 + hi * 8;
    bf16x8 qr[4];
#pragma unroll
    for (int d0 = 0; d0 < 4; ++d0) qr[d0] = __builtin_nontemporal_load((const bf16x8*)(Qw + d0 * 16));
    const int sr = tid >> 4, sc = (tid & 15) * 8, vst0 = v_st(sr, sc), vst1 = v_st(32 + sr, sc);
    const int vb0 = (int)(uintptr_t)V_lds + v_rd_base(lane);
    const bf16_t* Kc = C.P + C_AK + hd * 128 + sc; const bf16_t* Vc = C.P + C_AV + hd * 128 + sc;
    bf16x8 vs0, vs1, ks0, ks1;
#define TROW(t) ((t) < nlat ? latbase + (t) * 64 : ctxbase + ((t) - nlat) * 64)
#define LOADK(t) do { const size_t rb_ = (size_t)TROW(t); ks0 = *(const bf16x8*)(Kc + (rb_ + sr) * DIN); ks1 = *(const bf16x8*)(Kc + (rb_ + 32 + sr) * DIN); } while (0)
#define LOADV(t) do { const size_t rb_ = (size_t)TROW(t); vs0 = *(const bf16x8*)(Vc + (rb_ + sr) * DIN); vs1 = *(const bf16x8*)(Vc + (rb_ + 32 + sr) * DIN); } while (0)
#define WRITEK(b) do { *(bf16x8*)(K_lds + (b) * SHM_KV + KSWZ(sr, sc * 2)) = ks0; *(bf16x8*)(K_lds + (b) * SHM_KV + KSWZ(32 + sr, sc * 2)) = ks1; } while (0)
#define WRITEV(b) do { *(bf16x8*)(V_lds + (b) * SHM_KV + vst0) = vs0; *(bf16x8*)(V_lds + (b) * SHM_KV + vst1) = vs1; } while (0)
    float m_reg = -1e30f, l_reg = 0.f;
    f32x16 o[4] = {};
    f32x16 pA0, pA1, pB0, pB1;
    LOADK(0); LOADV(0); WRITEK(0); WRITEV(0); LOADK(1); WRITEK(1); __syncthreads();
    qk_tile(pA0, pA1, qr, K_lds, sj * 128, r32, hi);
    int kb1 = 1, kb2 = 2;
#define ATT_STEP(PC0, PC1, PN0, PN1, jj) do { \
        if ((jj) + 2 < NT) LOADK((jj) + 2); if ((jj) + 1 < NT) LOADV((jj) + 1); \
        if ((jj) + 1 < NT) qk_tile(PN0, PN1, qr, K_lds + kb1 * SHM_KV, sj * 128, r32, hi); \
        sm_pv(o, PC0, PC1, m_reg, l_reg, vb0 + ((jj) & 1) * SHM_KV, al_l, r32, hi); \
        if ((jj) + 2 < NT) WRITEK(kb2); if ((jj) + 1 < NT) WRITEV(((jj) + 1) & 1); \
        kb1 = kb2; kb2 = (kb2 == 2) ? 0 : kb2 + 1; \
        __syncthreads(); } while (0)
#pragma unroll 1
    for (int j = 0; j < NT; j += 2) {
        ATT_STEP(pA0, pA1, pB0, pB1, j);
        ATT_STEP(pB0, pB1, pA0, pA1, j + 1);
    }
#undef ATT_STEP
#undef TROW
#undef LOADK
#undef LOADV
#undef WRITEK
#undef WRITEV
    if (hi == 0) li_l[r32] = (sj ? lam : 1.f) * frcp(l_reg);
    asm volatile("s_waitcnt lgkmcnt(0)" ::: "memory");
    float* xb = (float*)lds + g * 4096 + lane;
    if (sj == 1) {
#pragma unroll
        for (int r = 0; r < 16; ++r) { const float a = li_l[crow(r, hi)];
#pragma unroll
            for (int d = 0; d < 4; ++d) xb[(d * 16 + r) * 64] = o[d][r] * a; }
    }
    __syncthreads();
    if (sj == 0) {
        const float lam1m = (l == 0) ? 0.8f : (1.f - 0.35550906759f);
        float g4[4];
#pragma unroll
        for (int d = 0; d < 4; ++d) g4[d] = C.subg[l * 128 + d * 32 + r32] * lam1m;
#pragma unroll
        for (int r = 0; r < 16; ++r) { const int rw = crow(r, hi); const float a = li_l[rw];
            float ss = 0.f; float v4[4];
#pragma unroll
            for (int d = 0; d < 4; ++d) { const float v = o[d][r] * a - xb[(d * 16 + r) * 64]; v4[d] = v; ss += v * v; }
            ss = sum32(ss);
            const float rstd = __builtin_amdgcn_rsqf(ss * (1.f / 128.f) + NORM_EPS);
            const size_t row = (size_t)(qrow0 + g * 32 + rw);
            const bf16_t* zp = C.P + row * DIN + C_AZ + hd * 128 + r32; bf16_t* op = C.H + row * DM + 512 + hd * 128 + r32;
#pragma unroll
            for (int d = 0; d < 4; ++d) { const float z = bf2f(zp[d * 32]); const float v = v4[d] * rstd * g4[d] * siluf_(z);
                op[d * 32] = (bf16_t)(cvt_pk_bf16(v, 0.f) & 0xffffu); } }
    }
    __syncthreads();
}

__device__ __forceinline__ void readout_row(const Ctx& C, int l, int lr, int lane_in) {
    const int lane = opaque(lane_in);
    constexpr size_t ARR = (size_t)MH * 256;
    const int j = 4 * lane; const size_t off = (size_t)lr * 256 + j;
    f32x4 y = __builtin_nontemporal_load((const f32x4*)(C.YS + off)) + __builtin_nontemporal_load((const f32x4*)(C.YS + ARR + off));
    float s = (y[0] + y[1]) + (y[2] + y[3]);
    s = sum16(s);
    const float mu = s * (1.f / 64.f);
    y = y - mu;
    float q = (y[0] * y[0] + y[1] * y[1]) + (y[2] * y[2] + y[3] * y[3]);
    q = sum16(q);
    const float rstd = __builtin_amdgcn_rsqf(q * (1.f / 64.f) + GN_EPS);
    const f32x4 lg = *(const f32x4*)(C.ln_g + l * 256 + j), lb = *(const f32x4*)(C.ln_b + l * 256 + j), rk = *(const f32x4*)(C.r_k + l * 256 + j);
    const bf16_t* pr = C.P + (size_t)lr * DIN;
    const f32x4 r = ld_bf4_nt(pr + C_R + j), v = ld_bf4_nt(pr + C_V + j), z = ld_bf4_nt(pr + C_ZR + j);
    const bf16_t* sb16 = (const bf16_t*)(C.SC + 2 * ARR);
    const f32x4 ks = ld_bf4_nt(sb16 + off) + ld_bf4_nt(sb16 + ARR + off);
    const f32x4 t = r * ks * rk;
    float bs = (t[0] + t[1]) + (t[2] + t[3]);
    bs = sum16(bs);
    f32x4 o = y * rstd * lg + lb + bs * v;
    o[0] *= siluf_(z[0]); o[1] *= siluf_(z[1]); o[2] *= siluf_(z[2]); o[3] *= siluf_(z[3]);
    st_bf4(C.H + (size_t)lr * DM + j, o);
}

#define XB_TMO      128
#define XB_XCNT(j)  (256  + 64 * (j))
#define XB_XSUB(j)  (1280 + 64 * (j))
#define XB_XGEN(j)  (2304 + 64 * (j))
#define XB_TOP      3328
#define XB_TOPGEN   3392
#define XCD_BAR_WORDS 3456
#define XB_SPIN_CAP (1u << 20)
__device__ __forceinline__ unsigned xb_ld(unsigned* p)              { return __hip_atomic_load(p, __ATOMIC_RELAXED, __HIP_MEMORY_SCOPE_AGENT); }
__device__ __forceinline__ unsigned xb_add(unsigned* p, unsigned v) { return __hip_atomic_fetch_add(p, v, __ATOMIC_RELAXED, __HIP_MEMORY_SCOPE_AGENT); }
__device__ __forceinline__ unsigned xb_xcc_id() { return (unsigned)__builtin_amdgcn_s_getreg((3 << 11) | 20) & 0xFu; }
#define XB_SPIN(cond, bar) do { unsigned _sp = 0; while (cond) { __builtin_amdgcn_s_sleep(1); \
    if ((++_sp & 255u) == 0u) { if (xb_ld(&(bar)[XB_TMO])) break; if (_sp > XB_SPIN_CAP) { atomicAdd(&(bar)[XB_TMO], 1u); break; } } } } while (0)
struct XcdBarrier { unsigned* bar; unsigned x; volatile LAS unsigned* st; };
__device__ __forceinline__ XcdBarrier xcd_barrier_post(unsigned* bar, volatile LAS unsigned* st) {
    XcdBarrier b; b.bar = bar; b.x = xb_xcc_id(); b.st = st;
    if (threadIdx.x == 0) (void)xb_add(&bar[XB_XCNT(b.x)], 1u);
    return b;
}
__device__ __forceinline__ void xcd_barrier_complete(unsigned* bar, unsigned x, unsigned& nloc, unsigned& nx) {
    const unsigned G = gridDim.x * gridDim.y * gridDim.z;
    unsigned sum, cnt, mine, sp = 0u;
    for (;;) {
        sum = 0u; cnt = 0u; mine = 0u;
#pragma unroll
        for (unsigned j = 0; j < 16; ++j) { const unsigned c = xb_ld(&bar[XB_XCNT(j)]); sum += c; cnt += (c > 0u) ? 1u : 0u; mine = (j == x) ? c : mine; }
        if (sum == G) break;
        __builtin_amdgcn_s_sleep(1);
        if ((++sp & 255u) == 0u) { if (xb_ld(&bar[XB_TMO])) break; if (sp > XB_SPIN_CAP) { atomicAdd(&bar[XB_TMO], 1u); break; } }
    }
    nloc = mine > 0u ? mine : 1u; nx = cnt > 0u ? cnt : 1u;
}
__device__ __forceinline__ void xcd_barrier(const XcdBarrier& b) {
    asm volatile("s_waitcnt vmcnt(0)" ::: "memory");
    __syncthreads();
    if (threadIdx.x == 0) {
        unsigned* bar = b.bar;
        __builtin_amdgcn_s_waitcnt(0);
        unsigned nloc = b.st[0], nx = b.st[1];
        if (nloc == 0u) { xcd_barrier_complete(bar, b.x, nloc, nx); b.st[0] = nloc; b.st[1] = nx; }
        const unsigned old = xb_add(&bar[XB_XSUB(b.x)], 1u);
        const unsigned gen = old / nloc;
        if (old + 1u == (gen + 1u) * nloc) {
            __builtin_amdgcn_fence(__ATOMIC_RELEASE, "agent");
            asm volatile("s_waitcnt vmcnt(0)" ::: "memory");
            const unsigned og = xb_add(&bar[XB_TOP], 1u);
            const unsigned tg = og / nx;
            if (og + 1u == (tg + 1u) * nx) xb_add(&bar[XB_TOPGEN], 1u);
            else XB_SPIN(xb_ld(&bar[XB_TOPGEN]) == tg, bar);
            __builtin_amdgcn_fence(__ATOMIC_ACQUIRE, "agent");
            xb_add(&bar[XB_XGEN(b.x)], 1u);
            asm volatile("s_waitcnt vmcnt(0)" ::: "memory");
        } else {
            XB_SPIN(xb_ld(&bar[XB_XGEN(b.x)]) == gen, bar);
            __builtin_amdgcn_fence(__ATOMIC_ACQUIRE, "agent");
            asm volatile("s_waitcnt vmcnt(0)" ::: "memory");
        }
    }
    __syncthreads();
}

#ifndef REP_ATT
#define REP_ATT 1
#endif
#ifndef REP_SCAN
#define REP_SCAN 1
#endif
#ifndef REP_G1
#define REP_G1 1
#endif
#ifndef REP_P3
#define REP_P3 1
#endif
#ifndef REP_RD
#define REP_RD 1
#endif
#ifndef REP_G0
#define REP_G0 1
#endif
#ifndef REP_P1
#define REP_P1 1
#endif
#ifndef REP_SYNC
#define REP_SYNC 1
#endif
#ifndef REP_G2
#define REP_G2 1
#endif
#ifndef REP_FIN
#define REP_FIN 1
#endif
struct Args { const float* in[22]; float* out; unsigned char* ws; };
__global__ void __launch_bounds__(512, 2) mk_fwd(Args a) {
    extern __shared__ __attribute__((aligned(16))) unsigned char lds_raw[];
    cg::grid_group grid = cg::this_grid();
    LAS unsigned char* lds = (LAS unsigned char*)lds_raw;
    Ctx C;
    C.x = a.in[0]; C.c = a.in[1]; C.ctx = a.in[2]; C.c_ctx = a.in[3]; C.mod_w = a.in[4]; C.mod_b = a.in[5]; C.pre_g = a.in[6]; C.post_g = a.in[7]; C.w_in = a.in[8]; C.w_out = a.in[9];
    C.w0 = a.in[10]; C.w_up = a.in[11]; C.a0 = a.in[12]; C.a_up = a.in[13]; C.k_k = a.in[14]; C.k_a = a.in[15]; C.r_k = a.in[16]; C.ln_g = a.in[17]; C.ln_b = a.in[18]; C.conv_w = a.in[19];
    C.dlam = a.in[20]; C.subg = a.in[21]; C.out = a.out;
    unsigned char* ws = a.ws;
    C.WinT = (bf16_t*)(ws + WS_WIN); C.WoutT = (bf16_t*)(ws + WS_WOUT); C.WupT = (bf16_t*)(ws + WS_WUP); C.mod = (float*)(ws + WS_MOD); C.rope = (float*)(ws + WS_ROPE);
    C.xc1 = (float*)(ws + WS_XC1); C.H = (bf16_t*)(ws + WS_H); C.P = (bf16_t*)(ws + WS_P); C.Y = (bf16_t*)(ws + WS_P); C.SC = (float*)(ws + WS_SC); C.YS = (float*)(ws + WS_YS);
    const int tid = threadIdx.x, wid = __builtin_amdgcn_readfirstlane(tid >> 6), G = gridDim.x, bx = blockIdx.x;
#define lane (opaque(tid) & 63)
    const int gw0 = bx * 8 + wid, ngw = G * 8;
#define gw opaque_s(gw0)

    if (bx == 0) for (int i = tid; i < 4096; i += 512) ((unsigned*)ws)[i] = 0u;
    if (tid < 2) ((volatile LAS unsigned*)(lds + 131072 + 1024))[tid] = 0u;
    __syncthreads();
#ifdef PROBE_A
    unsigned long long tprev = __builtin_amdgcn_s_memrealtime(); float tacc[9] = {0.f, 0.f, 0.f, 0.f, 0.f, 0.f, 0.f, 0.f, 0.f};
#define STAMP(k) do { const unsigned long long tn_ = __builtin_amdgcn_s_memrealtime(); tacc[k] += (float)(tn_ - tprev) * 0.01f; tprev = tn_; } while (0)
#else
#define STAMP(k) do { } while (0)
#endif
#ifndef NO_G0
    for (int rep = 0; rep < REP_G0; ++rep) g0_prologue(C, lds);
#endif
    grid.sync(); STAMP(0);
    const XcdBarrier xbar = xcd_barrier_post((unsigned*)ws, (volatile LAS unsigned*)(lds + 131072 + 1024));
#define GSYNC() xcd_barrier(xbar)
#pragma unroll 1
    for (int hf = 0; hf < 2; ++hf) {
#pragma unroll 1
        for (int l = 0; l < 2; ++l) {
#ifndef NO_NORM
            for (int rep = 0; rep < REP_P1; ++rep) { if (l == 0) norm_phase<0>(C, hf, gw, ngw, lane); else norm_phase<1>(C, hf, gw, ngw, lane); }
#endif
            for (int rep = 0; rep < REP_SYNC; ++rep) GSYNC();
            STAMP(1);
            { pg8::Gemm g{C.H, C.WinT + (size_t)l * DIN * DM, MH, DIN, DM}; pg8::StaticOrder S; S.init(MH, DIN, G, bx);
#ifndef NO_GEMM1
              pg8::EpiBf16 E{C.P, DIN}; for (int rep = 0; rep < REP_G1; ++rep) pg8::gemm_phase<pg8::EpiBf16, true>(lds, g, S, E);
#endif
            }
            GSYNC(); STAMP(2);
#ifndef NO_PREP
            for (int rep = 0; rep < REP_P3; ++rep) for (int t = bx; t < MH / 64; t += G) prep_block(C, l, t, lds);
#endif
            for (int r4 = gw; r4 < MH / 4; r4 += ngw) { const bool do_conv = (l == 0) || (r4 < LATH / 4); if (do_conv || r4 < LATH / 4) rowpass4(C, l, r4 * 4, lane, do_conv); }
            GSYNC(); STAMP(3);
#ifndef NO_SCAN
            unsigned* sdone = (unsigned*)ws + 3840 + (hf * 2 + l) * 64;
            { unsigned nscan = 0;
              if (G == 256) { if (((bx >> 3) & 1) == 0) { scan_chunked(C, l, (bx >> 4) * 8 + (bx & 7), lds); nscan = 1; } } else { for (int u = bx; u < 128; u += G) { scan_chunked(C, l, u, lds); ++nscan; } }
              if (nscan) { asm volatile("s_waitcnt vmcnt(0)" ::: "memory"); __syncthreads();
                  if (tid == 0) { __builtin_amdgcn_fence(__ATOMIC_RELEASE, "agent"); asm volatile("s_waitcnt vmcnt(0)" ::: "memory");
                                  (void)__hip_atomic_fetch_add(sdone, nscan, __ATOMIC_RELAXED, __HIP_MEMORY_SCOPE_AGENT); } } }
#endif
            STAMP(4);
#ifndef NO_ATT
            {
                float lam;
                { const int ln = opaque(lane); const float* dl = C.dlam + l * 256; const float sa = wave_sum_dpp(dl[ln] * dl[64 + ln]), sb = wave_sum_dpp(dl[128 + ln] * dl[192 + ln]);
                  lam = fexp2(1.4426950408889634f * sa) - fexp2(1.4426950408889634f * sb) + ((l == 0) ? 0.2f : 0.35550906759f); }
                unsigned* qctr = (unsigned*)ws + 3584 + (hf * 2 + l) * 64;
                volatile LAS unsigned* qslot = (volatile LAS unsigned*)(lds + 131072 + 1024 + 64);
                const int nunits = (l == 0) ? 1024 + 128 : 1024;
                for (;;) {
                    if (tid == 0) qslot[0] = __hip_atomic_fetch_add(qctr, 1u, __ATOMIC_RELAXED, __HIP_MEMORY_SCOPE_AGENT);
                    __syncthreads();
                    const int u = (int)qslot[0];
                    __syncthreads();
                    if (u >= nunits) break;
                    if (u < 1024) { const int bl = u >> 6, hd = (u >> 4) & 3, qb = u & 15;
                        attn_unit(C, l, hd, bl * SEQ + qb * 128, bl * SEQ, LATH + bl * CTX, 32, 36, lam, (char*)lds_raw); }
                    else { const int v = u - 1024; const int bl = v >> 3, hd = (v >> 1) & 3, qb = v & 1;
                        attn_unit(C, l, hd, LATH + bl * CTX + qb * 128, 0, LATH + bl * CTX, 0, 4, lam, (char*)lds_raw); }
                }
            }
#endif
            STAMP(5);
            {
                volatile LAS unsigned* qslot = (volatile LAS unsigned*)(lds + 131072 + 1024 + 64);
                if (tid == 0) { unsigned sp = 0;
                    while (__hip_atomic_load(sdone, __ATOMIC_RELAXED, __HIP_MEMORY_SCOPE_AGENT) < 128u) { __builtin_amdgcn_s_sleep(4); if (++sp > (1u << 22)) break; }
                    __builtin_amdgcn_fence(__ATOMIC_ACQUIRE, "agent"); asm volatile("s_waitcnt vmcnt(0)" ::: "memory"); }
                __syncthreads();
                unsigned* rq = sdone + 16;
                const int nch = ((l == 0) ? MH : LATH) / 64;
                for (;;) {
                    if (tid == 0) qslot[0] = __hip_atomic_fetch_add(rq, 1u, __ATOMIC_RELAXED, __HIP_MEMORY_SCOPE_AGENT);
                    __syncthreads();
                    const int ch = (int)qslot[0];
                    __syncthreads();
                    if (ch >= nch) break;
#pragma unroll 1
                    for (int i = 0; i < 4; ++i) { const int r = ch * 64 + wid * 8 + i * 2; readout_row(C, l, r, lane); readout_row(C, l, r + 1, lane); }
                }
            }
            GSYNC(); STAMP(6);
            { const int M5 = (l == 0) ? MH : LATH; pg8::Gemm g{C.H, C.WoutT + (size_t)l * DM * DM, M5, DM, DM}; pg8::StaticOrder S; S.init(M5, DM, G, bx);
#ifndef NO_GEMM2
              pg8::EpiBf16 E{C.Y, DM}; for (int rep = 0; rep < REP_G2; ++rep) pg8::gemm_phase<pg8::EpiBf16, true>(lds, g, S, E);
#endif
            }
            GSYNC(); STAMP(7);
        }
#ifdef PROBE_A
        norm_phase<2>(C, hf, gw, ngw, lane, 2e-3f * tacc[PROBE_A], 1e-3f * tacc[PROBE_B]); STAMP(8);
#else
        norm_phase<2>(C, hf, gw, ngw, lane);
#endif
    }
#undef gw
#undef lane
}

extern "C" void kernel_launch(void* const* d_in, const int* in_sizes, int n_in, void* d_out, int out_size, void* d_ws, size_t ws_size, hipStream_t stream) {
    static int grid = 0;
    if (grid == 0) {
        if (n_in != 22 || ws_size < WS_END) { fprintf(stderr, "kernel_launch: unexpected n_in %d / ws %zu\n", n_in, ws_size); grid = -1; return; }
        int dev = 0, cus = 0, per_cu = 0;
        hipGetDevice(&dev); hipDeviceGetAttribute(&cus, hipDeviceAttributeMultiprocessorCount, dev);
        if (hipFuncSetAttribute((const void*)mk_fwd, hipFuncAttributeMaxDynamicSharedMemorySize, LDS_BYTES) != hipSuccess) { fprintf(stderr, "kernel_launch: hipFuncSetAttribute failed\n"); grid = -1; return; }
        if (hipOccupancyMaxActiveBlocksPerMultiprocessor(&per_cu, (const void*)mk_fwd, 512, LDS_BYTES) != hipSuccess || per_cu < 1) { fprintf(stderr, "kernel_launch: occupancy query says %d\n", per_cu); per_cu = 1; }
        (void)hipGetLastError();
        grid = cus * 1;
    }
    if (grid < 0) return;
    Args a{};
    for (int i = 0; i < 22; ++i) a.in[i] = (const float*)d_in[i];
    a.out = (float*)d_out; a.ws = (unsigned char*)d_ws;
    void* args[] = {&a};
    hipError_t e = hipLaunchCooperativeKernel((const void*)mk_fwd, dim3(grid), dim3(512), args, LDS_BYTES, stream);
    if (e != hipSuccess) fprintf(stderr, "cooperative launch failed: %s (grid %d)\n", hipGetErrorString(e), grid);
}
```

```cpp
#include <hip/hip_runtime.h>
#include <hip/hip_cooperative_groups.h>
#include <cstdio>
#include <cstdint>
namespace cg = cooperative_groups;

#define LAS __attribute__((address_space(3)))
typedef unsigned short bf16_t;
typedef short bf16x8 __attribute__((ext_vector_type(8)));
typedef short s16x4 __attribute__((ext_vector_type(4)));
typedef float f32x2 __attribute__((ext_vector_type(2)));
typedef float f32x4 __attribute__((ext_vector_type(4)));
typedef float f32x16 __attribute__((ext_vector_type(16)));
typedef unsigned u32x2 __attribute__((ext_vector_type(2)));
typedef unsigned u32x4 __attribute__((ext_vector_type(4)));

constexpr int DM = 1024, SEQ = 2048, CTX = 256, DIN = 4352;
constexpr int HB = 16;
constexpr int LATH = HB * SEQ;
constexpr int CTXH = HB * CTX;
constexpr int MH = LATH + CTXH;
constexpr int C_R = 0, C_K = 256, C_V = 512, C_LWF = 768, C_LWB = 832, C_LAF = 896, C_LAB = 960, C_ZR = 1024,
              C_CB = 1280, C_CC = 1536, C_CH = 1792, C_CZ = 2048, C_AQ = 2304, C_AK = 2816, C_AV = 3328, C_AZ = 3840;
constexpr float C2 = 0.125f * 1.4426950408889634f;
constexpr float NORM_EPS = 1e-6f, GN_EPS = 64e-5f;

constexpr size_t MiB = 1u << 20;
constexpr size_t WS_WIN = 1 * MiB, WS_WOUT = 18 * MiB, WS_WUP = 22 * MiB, WS_MOD = 23 * MiB, WS_ROPE = 24 * MiB, WS_XC1 = 25 * MiB,
                 WS_H = 57 * MiB, WS_P = 129 * MiB, WS_SC = 435 * MiB, WS_YS = 687 * MiB, WS_END = 759 * MiB;
static_assert(WS_WIN + 2ull * DIN * DM * 2 <= WS_WOUT && WS_H + (size_t)MH * DM * 2 <= WS_P && WS_P + (size_t)MH * DIN * 2 <= WS_SC &&
              WS_SC + 7ull * MH * 256 * 4 <= WS_YS && WS_YS + 2ull * MH * 256 * 4 <= WS_END, "ws map");
constexpr int LDS_BYTES = 131072 + 2048;

struct Ctx {
    const float *x, *c, *ctx, *c_ctx, *mod_w, *mod_b, *pre_g, *post_g, *w_in, *w_out, *w0, *w_up, *a0, *a_up, *k_k, *k_a, *r_k, *ln_g, *ln_b, *conv_w, *dlam, *subg;
    float* out;
    bf16_t *WinT, *WoutT, *WupT; float *mod, *rope, *xc1; bf16_t *H, *P, *Y; float *SC, *YS;
};

__device__ __forceinline__ unsigned cvt_pk_bf16(float lo, float hi) { unsigned r; asm volatile("v_cvt_pk_bf16_f32 %0, %1, %2" : "=v"(r) : "v"(lo), "v"(hi)); return r; }
__device__ __forceinline__ float bf_lo(unsigned w) { return __uint_as_float(w << 16); }
__device__ __forceinline__ float bf_hi(unsigned w) { return __uint_as_float(w & 0xffff0000u); }
__device__ __forceinline__ float bf2f(bf16_t b) { return __uint_as_float((unsigned)b << 16); }
__device__ __forceinline__ f32x4 ld_bf4(const bf16_t* p) { const u32x2 w = *(const u32x2*)p; return (f32x4){bf_lo(w.x), bf_hi(w.x), bf_lo(w.y), bf_hi(w.y)}; }
__device__ __forceinline__ f32x4 ld_bf4_nt(const bf16_t* p) { const u32x2 w = __builtin_nontemporal_load((const u32x2*)p); return (f32x4){bf_lo(w.x), bf_hi(w.x), bf_lo(w.y), bf_hi(w.y)}; }
__device__ __forceinline__ void st_bf4(bf16_t* p, f32x4 v) { u32x2 w; w.x = cvt_pk_bf16(v[0], v[1]); w.y = cvt_pk_bf16(v[2], v[3]); *(u32x2*)p = w; }
__device__ __forceinline__ int opaque(int v) { asm volatile("" : "+v"(v)); return v; }
__device__ __forceinline__ int opaque_s(int v) { asm volatile("" : "+s"(v)); return v; }
__device__ __forceinline__ float fexp2(float x) { return __builtin_amdgcn_exp2f(x); }
__device__ __forceinline__ float frcp(float x) { return __builtin_amdgcn_rcpf(x); }
__device__ __forceinline__ float sigmoidf_(float x) { return frcp(1.f + fexp2(-1.4426950408889634f * x)); }
__device__ __forceinline__ float siluf_(float x) { return x * sigmoidf_(x); }
__device__ __forceinline__ float sum16(float v) {
    v += __int_as_float(__builtin_amdgcn_update_dpp(0, __float_as_int(v), 0xB1, 0xF, 0xF, true));
    v += __int_as_float(__builtin_amdgcn_update_dpp(0, __float_as_int(v), 0x4E, 0xF, 0xF, true));
    v += __int_as_float(__builtin_amdgcn_update_dpp(0, __float_as_int(v), 0x141, 0xF, 0xF, true));
    v += __int_as_float(__builtin_amdgcn_update_dpp(0, __float_as_int(v), 0x140, 0xF, 0xF, true));
    return v;
}
__device__ __forceinline__ float wave_sum(float v) {
    const int ri = __float_as_int(sum16(v));
    return (__int_as_float(__builtin_amdgcn_readlane(ri, 0)) + __int_as_float(__builtin_amdgcn_readlane(ri, 16))) + (__int_as_float(__builtin_amdgcn_readlane(ri, 32)) + __int_as_float(__builtin_amdgcn_readlane(ri, 48)));
}
__device__ __forceinline__ float wave_sum_dpp(float v) {
    const int ri = __float_as_int(sum16(v));
    return (__int_as_float(__builtin_amdgcn_readlane(ri, 0)) + __int_as_float(__builtin_amdgcn_readlane(ri, 16))) + (__int_as_float(__builtin_amdgcn_readlane(ri, 32)) + __int_as_float(__builtin_amdgcn_readlane(ri, 48)));
}
__device__ __forceinline__ float sum32(float v) {
    const float r = sum16(v);
    return r + __int_as_float(__builtin_amdgcn_ds_swizzle(__float_as_int(r), 0x401f));
}

namespace pg8 {
constexpr int BM = 256, BK = 64, HALF = 128, HTB = HALF * BK * 2, STAGE_BYTES = 8 * HTB, NXCD = 8, WGM = 8;
__host__ __device__ __forceinline__ int lds_byte(int r, int c) { const int st = (r >> 4) * 2 + (c >> 5), rr = r & 15, cc = c & 31, ob = rr * 64 + cc * 2; return st * 1024 + (ob ^ (((ob >> 9) & 1) << 5)); }
__host__ __device__ __forceinline__ void stage_rc(int b, int& R, int& C) { const int st = b / 1024, sb = b % 1024, swz = sb ^ (((sb >> 9) & 1) << 5); R = (st >> 1) * 16 + swz / 64; C = (st & 1) * 32 + (swz % 64) / 2; }
__host__ __device__ __forceinline__ int perm32(int rho) { const int n = rho >> 4, i = rho & 15; return 8 * (i >> 2) + 4 * n + (i & 3); }
struct Unit { int pm, pn; };
struct Gemm { const bf16_t* A; const bf16_t* Bt; int M, N, K; };
struct StaticOrder {
    int nM, nN, nwg, G, c, nxt0, nxtra;
    __host__ __device__ void init(int M, int N, int G_, int c_) { nM = M / BM; nN = N / BM; nwg = nM * nN; G = G_; c = c_; nxt0 = 0; nxtra = 0; }
    __host__ __device__ bool next(int i, Unit& u) const {
        const long L = (long)i * G + c;
        if (L >= nwg) { const long x = L - nwg; if (x >= (long)nxtra * 7) return false; const int j = (int)(x % 7); u.pm = nxt0 + (int)(x / 7); u.pn = (j < 3) ? 1 + j : 8 + j; return true; }
        int wgid = (int)L; { const int q = nwg / NXCD, r = nwg % NXCD, xcd = wgid % NXCD, off = wgid / NXCD; wgid = (xcd < r ? xcd * (q + 1) : r * (q + 1) + (xcd - r) * q) + off; }
        const int nig = WGM * nN, gid = wgid / nig, fm = gid * WGM, gsz = (nM - fm) < WGM ? (nM - fm) : WGM;
        u.pm = fm + ((wgid % nig) % gsz); u.pn = (wgid % nig) / gsz; return true;
    }
};
struct EpiBf16 {
    static constexpr bool PERM = true;
    bf16_t* O; int ldc;
    __device__ __forceinline__ void operator()(const f32x4 (&acc)[2][2][4][2], const Unit& u, int wr, int wc, int fr, int fq) const {
        const int row0 = u.pm * BM + wr * 64 + fr, col0 = u.pn * BM + wc * 32 + 8 * fq;
        int ld = ldc; asm volatile("" : "+s"(ld));
#pragma unroll
        for (int ai = 0; ai < 2; ++ai)
#pragma unroll
            for (int m = 0; m < 4; ++m) { bf16_t* rowp = O + (size_t)(row0 + ai * HALF + m * 16) * ld + col0;
#pragma unroll
                for (int bj = 0; bj < 2; ++bj) { const f32x4 v0 = acc[ai][bj][m][0], v1 = acc[ai][bj][m][1];
                    u32x4 w; w.x = cvt_pk_bf16(v0[0], v0[1]); w.y = cvt_pk_bf16(v0[2], v0[3]); w.z = cvt_pk_bf16(v1[0], v1[1]); w.w = cvt_pk_bf16(v1[2], v1[3]);
                    *(u32x4*)(rowp + bj * HALF) = w; } }
    }
};
template <class Epi, bool ALIGN_EPI = true>
__device__ __forceinline__ void gemm_phase(LAS unsigned char* lds, const Gemm g, const StaticOrder& S, const Epi& E) {
    const int tid = opaque(threadIdx.x), wid = __builtin_amdgcn_readfirstlane(tid >> 6), lane = tid & 63, wr = wid >> 2, wc = wid & 3, fr = lane & 15, fq = lane >> 4;
    const int K = g.K, nt = K / BK;
    unsigned voffA[2], voffB[2];
#pragma unroll
    for (int i = 0; i < 2; ++i) { int R, C; stage_rc(tid * 16 + i * 8192, R, C); const int Rb = Epi::PERM ? ((R & ~31) + perm32(R & 31)) : R;
        voffA[i] = (unsigned)(R * K + C) * 2u; voffB[i] = (unsigned)(Rb * K + C) * 2u; }
    const size_t kstep = (size_t)(BK * 2);
    const size_t hstep = (size_t)HALF * K * 2;
    const size_t tstep = 2 * hstep;
    const unsigned ldsw = (unsigned)wid * 1024u;
    const int aoff = lds_byte(wr * 64 + fr, fq * 8), boff = lds_byte(wc * 32 + fr, fq * 8);
#define PG8_SA(b, h) (((b) * 2 + (h)) * HTB)
#define PG8_SB(b, h) ((4 + (b) * 2 + (h)) * HTB)
#define PG8_STAGE(bufoff, gbase, voff) do { _Pragma("unroll") for (int _i = 0; _i < 2; ++_i) \
        __builtin_amdgcn_global_load_lds((const unsigned*)((const char*)(gbase) + (voff)[_i]), (LAS unsigned*)(lds + (bufoff) + ldsw + _i * 8192), 16, 0, 0); } while (0)
#define PG8_LDA(dst, b, h) do { _Pragma("unroll") for (int m = 0; m < 4; ++m) _Pragma("unroll") for (int k = 0; k < 2; ++k) dst[m][k] = *(const LAS bf16x8*)(lds + PG8_SA(b, h) + aoff + m * 2048 + k * 1024); } while (0)
#define PG8_LDB(dst, b, h) do { _Pragma("unroll") for (int n = 0; n < 2; ++n) _Pragma("unroll") for (int k = 0; k < 2; ++k) dst[n][k] = *(const LAS bf16x8*)(lds + PG8_SB(b, h) + boff + n * 2048 + k * 1024); } while (0)
#define PG8_MMA(ai, bj, At, Bt) do { __builtin_amdgcn_s_setprio(1); _Pragma("unroll") for (int m = 0; m < 4; ++m) _Pragma("unroll") for (int n = 0; n < 2; ++n) _Pragma("unroll") for (int k = 0; k < 2; ++k) \
        acc[ai][bj][m][n] = __builtin_amdgcn_mfma_f32_16x16x32_bf16(Bt[n][k], At[m][k], acc[ai][bj][m][n], 0, 0, 0); __builtin_amdgcn_s_setprio(0); } while (0)
#define PG8_WAIT_V(n) asm volatile("s_waitcnt vmcnt(" #n ")" ::: "memory")
#define PG8_WAIT_L(n) asm volatile("s_waitcnt lgkmcnt(" #n ")" ::: "memory")
#define PG8_BAR __builtin_amdgcn_s_barrier()
#define PG8_SCHED __builtin_amdgcn_sched_barrier(0)
    Unit cur, nxt; int ui = 0;
    if (!S.next(0, cur)) return;
    f32x4 acc[2][2][4][2];
#pragma unroll
    for (int a = 0; a < 2; ++a)
#pragma unroll
        for (int b = 0; b < 2; ++b)
#pragma unroll
            for (int m = 0; m < 4; ++m)
#pragma unroll
                for (int n = 0; n < 2; ++n) acc[a][b][m][n] = (f32x4){0.f, 0.f, 0.f, 0.f};
    bf16x8 At[4][2], B0[2][2], B1[2][2];
    const char* cA = (const char*)g.A + (size_t)cur.pm * tstep; const char* cB = (const char*)g.Bt + (size_t)cur.pn * tstep;
    PG8_STAGE(PG8_SB(0, 0), cB, voffB); PG8_STAGE(PG8_SB(0, 1), cB + hstep, voffB); PG8_STAGE(PG8_SA(0, 0), cA, voffA); PG8_STAGE(PG8_SA(0, 1), cA + hstep, voffA);
    if (wr == 1) PG8_BAR;
    PG8_WAIT_V(2); PG8_BAR;
    PG8_STAGE(PG8_SB(1, 0), cB + kstep, voffB); PG8_STAGE(PG8_SA(1, 0), cA + kstep, voffA); PG8_STAGE(PG8_SB(1, 1), cB + hstep + kstep, voffB);
    PG8_WAIT_V(6); PG8_BAR;
    for (;;) {
        const bool has_next = S.next(ui + 1, nxt);
        const char* nA = has_next ? (const char*)g.A + (size_t)nxt.pm * tstep : cA; const char* nB = has_next ? (const char*)g.Bt + (size_t)nxt.pn * tstep : cB;
        for (int t = 0; t < nt; t += 2) {
            const bool last = (t == nt - 2);
            const char* a1 = cA + (size_t)(t + 1) * kstep;
            const char* a2 = last ? nA : cA + (size_t)(t + 2) * kstep; const char* b2 = last ? nB : cB + (size_t)(t + 2) * kstep;
            const char* a3 = a2 + kstep; const char* b3 = b2 + kstep;
            PG8_LDB(B0, 0, 0); PG8_LDB(B1, 0, 1); PG8_SCHED; PG8_LDA(At, 0, 0); PG8_STAGE(PG8_SA(1, 1), a1 + hstep, voffA);
            PG8_WAIT_V(8); PG8_WAIT_L(0); PG8_BAR; PG8_MMA(0, 0, At, B0); PG8_MMA(0, 1, At, B1); PG8_BAR; PG8_SCHED;
            PG8_LDA(At, 0, 1); PG8_STAGE(PG8_SB(0, 0), b2, voffB); PG8_STAGE(PG8_SB(0, 1), b2 + hstep, voffB); PG8_STAGE(PG8_SA(0, 0), a2, voffA);
            PG8_WAIT_V(8); PG8_WAIT_L(0); PG8_BAR; PG8_MMA(1, 0, At, B0); PG8_MMA(1, 1, At, B1); PG8_BAR; PG8_SCHED;
            PG8_LDB(B0, 1, 0); PG8_LDB(B1, 1, 1); PG8_SCHED; PG8_LDA(At, 1, 0); PG8_STAGE(PG8_SA(0, 1), a2 + hstep, voffA);
            PG8_WAIT_V(8); PG8_WAIT_L(0); PG8_BAR; PG8_MMA(0, 0, At, B0); PG8_MMA(0, 1, At, B1); PG8_BAR; PG8_SCHED;
            PG8_LDA(At, 1, 1); PG8_STAGE(PG8_SB(1, 0), b3, voffB); PG8_STAGE(PG8_SB(1, 1), b3 + hstep, voffB); PG8_STAGE(PG8_SA(1, 0), a3, voffA);
            PG8_WAIT_V(8); PG8_WAIT_L(0); PG8_BAR; PG8_MMA(1, 0, At, B0); PG8_MMA(1, 1, At, B1); PG8_BAR; PG8_SCHED;
        }
        if constexpr (ALIGN_EPI) { if (wr == 0) PG8_BAR; }
        E(acc, cur, wr, wc, fr, fq);
        if (!has_next) break;
#pragma unroll
        for (int a = 0; a < 2; ++a)
#pragma unroll
            for (int b = 0; b < 2; ++b)
#pragma unroll
                for (int m = 0; m < 4; ++m)
#pragma unroll
                    for (int n = 0; n < 2; ++n) acc[a][b][m][n] = (f32x4){0.f, 0.f, 0.f, 0.f};
        cur = nxt; cA = nA; cB = nB; ++ui;
        if constexpr (ALIGN_EPI) { if (wr == 1) PG8_BAR; }
    }
    PG8_WAIT_V(0);
    if constexpr (!ALIGN_EPI) { if (wr == 0) PG8_BAR; }
    PG8_BAR;
#undef PG8_SA
#undef PG8_SB
#undef PG8_STAGE
#undef PG8_LDA
#undef PG8_LDB
#undef PG8_MMA
#undef PG8_WAIT_V
#undef PG8_WAIT_L
#undef PG8_BAR
#undef PG8_SCHED
}
}

__device__ __forceinline__ void transpose_item(const float* W, int K, int N, bf16_t* WT, LAS float* scr, int item, int lane, bool qscale) {
    const int nblk = N / 32, kb = item / nblk, nb = item % nblk, k0 = 64 * kb, n0 = 32 * nb;
    const float wsc = (qscale && n0 >= C_AQ && n0 < C_AK) ? C2 : 1.f;
#pragma unroll 8
    for (int i = 0; i < 32; ++i) { const int kk = 2 * i + (lane >> 5); scr[kk * 33 + (lane & 31)] = wsc * W[(size_t)(k0 + kk) * N + n0 + (lane & 31)]; }
    asm volatile("s_waitcnt lgkmcnt(0)" ::: "memory");
    const int c = lane & 7;
#pragma unroll
    for (int j = 0; j < 4; ++j) { const int n = (lane >> 3) + 8 * j; const LAS float* s = scr + (8 * c) * 33 + n;
        u32x4 o; o.x = cvt_pk_bf16(s[0 * 33], s[1 * 33]); o.y = cvt_pk_bf16(s[2 * 33], s[3 * 33]); o.z = cvt_pk_bf16(s[4 * 33], s[5 * 33]); o.w = cvt_pk_bf16(s[6 * 33], s[7 * 33]);
        *(u32x4*)(WT + (size_t)(n0 + n) * K + k0 + 8 * c) = o; }
    asm volatile("s_waitcnt lgkmcnt(0)" ::: "memory");
}
__device__ __forceinline__ void sincos_d(double x, float& s, float& c) {
    const double q = __builtin_rint(x * 0.63661977236758134308); const double r = x - q * 1.57079632679489661923; const int qi = (int)q & 3;
    const double r2 = r * r;
    const double sp = r * (1.0 + r2 * (-1.0 / 6 + r2 * (1.0 / 120 + r2 * (-1.0 / 5040 + r2 * (1.0 / 362880 + r2 * (-1.0 / 39916800 + r2 * (1.0 / 6227020800.0)))))));
    const double cp = 1.0 + r2 * (-0.5 + r2 * (1.0 / 24 + r2 * (-1.0 / 720 + r2 * (1.0 / 40320 + r2 * (-1.0 / 3628800 + r2 * (1.0 / 479001600.0))))));
    const double ss = (qi == 0) ? sp : (qi == 1) ? cp : (qi == 2) ? -sp : -cp;
    const double cc = (qi == 0) ? cp : (qi == 1) ? -sp : (qi == 2) ? -cp : sp;
    s = (float)ss; c = (float)cc;
}
__device__ __forceinline__ void g0_prologue(const Ctx& C, LAS unsigned char* lds) {
    const int tid = opaque(threadIdx.x), lane = tid & 63, wid = tid >> 6, G = gridDim.x, bx = blockIdx.x;
    if (bx == G - 1) {
        for (int e = tid; e < 1024; e += 512) { const int pos = e >> 4, i = e & 15;
            const float invf = fexp2(-(float)i * 0.83048202372f);
            const float ang = (float)pos * invf; float s, c; sincos_d((double)ang, s, c);
            C.rope[e * 2] = c; C.rope[e * 2 + 1] = s; }
    }
    constexpr int NMODT = 2 * 48;
    const int nmodb = (G >= 2 * NMODT) ? NMODT : G;
    if (bx < nmodb) {
        LAS float* sl = (LAS float*)lds + wid * (33 * 64);
        for (int task = bx; task < NMODT; task += nmodb) {
            const int l = task / 48, cb = task % 48, col = cb * 64 + lane;
            const float* W = C.mod_w + (size_t)l * DM * 3072;
            float acc[33];
#pragma unroll
            for (int r = 0; r < 33; ++r) acc[r] = 0.f;
            for (int kc = 0; kc < 2; ++kc) {
                const int k0 = wid * 128 + kc * 64;
#pragma unroll
                for (int r = 0; r < 33; ++r) { const float v = (r < 32) ? C.c[r * DM + k0 + lane] : C.c_ctx[k0 + lane]; sl[r * 64 + lane] = siluf_(v); }
                asm volatile("s_waitcnt lgkmcnt(0)" ::: "memory");
                for (int k4 = 0; k4 < 16; ++k4) {
                    const float w0 = W[(size_t)(k0 + 4 * k4 + 0) * 3072 + col], w1 = W[(size_t)(k0 + 4 * k4 + 1) * 3072 + col],
                                w2 = W[(size_t)(k0 + 4 * k4 + 2) * 3072 + col], w3 = W[(size_t)(k0 + 4 * k4 + 3) * 3072 + col];
#pragma unroll
                    for (int r = 0; r < 33; ++r) { const f32x4 sv = *(const LAS f32x4*)(sl + r * 64 + 4 * k4); acc[r] += sv[0] * w0 + sv[1] * w1 + sv[2] * w2 + sv[3] * w3; }
                }
                asm volatile("s_waitcnt lgkmcnt(0)" ::: "memory");
            }
            __syncthreads();
#pragma unroll
            for (int r = 0; r < 33; ++r) sl[r * 64 + lane] = acc[r];
            __syncthreads();
            for (int e = tid; e < 33 * 64; e += 512) { float s = 0.f;
#pragma unroll
                for (int w = 0; w < 8; ++w) s += ((LAS float*)lds)[w * (33 * 64) + e];
                const int r = e >> 6, cc = cb * 64 + (e & 63);
                C.mod[((size_t)l * 33 + r) * 3072 + cc] = s + C.mod_b[l * 3072 + cc]; }
            __syncthreads();
        }
    }
    {
        const bool all = (nmodb == G);
        if (all || bx >= nmodb) {
            const int nb = all ? G : G - nmodb, b0 = all ? bx : bx - nmodb;
            LAS float* scr = (LAS float*)lds + wid * (64 * 33 + 16);
            constexpr int I_IN = 16 * (DIN / 32), I_OUT = 16 * 32, I_UP = 8;
            constexpr int NITEMS = 2 * I_IN + 2 * I_OUT + 16 * I_UP;
            for (int it = b0 * 8 + wid; it < NITEMS; it += nb * 8) {
                int r = it;
                if (r < 2 * I_IN) { const int l = r / I_IN; transpose_item(C.w_in + (size_t)l * DM * DIN, DM, DIN, C.WinT + (size_t)l * DIN * DM, scr, r % I_IN, lane, true); continue; } r -= 2 * I_IN;
                if (r < 2 * I_OUT) { const int l = r / I_OUT; transpose_item(C.w_out + (size_t)l * DM * DM, DM, DM, C.WoutT + (size_t)l * DM * DM, scr, r % I_OUT, lane, false); continue; } r -= 2 * I_OUT;
                { const int mi = r / I_UP, l = mi >> 2, m = mi & 3, d = m & 1;
                  const float* src = ((m < 2) ? C.w_up : C.a_up) + (size_t)(l * 2 + d) * 64 * 256;
                  transpose_item(src, 64, 256, C.WupT + (size_t)(l * 4 + m) * 256 * 64, scr, r % I_UP, lane, false); }
            }
        }
    }
}

template <int MODE>
__device__ __forceinline__ void norm_phase(const Ctx& C, int hf, int gw, int ngw, int lane_in, float pe1 = 0.f, float pe2 = 0.f) {
    const int lane = opaque(lane_in);
    const int nrows = (MODE == 2) ? LATH : MH;
    for (int lr0 = gw * 2; lr0 < nrows; lr0 += ngw * 2) {
        const bool lat = lr0 < LATH;
        int mrow; const float* xin; float* x1p;
        if (lat) { const size_t g = (size_t)hf * LATH + lr0; mrow = hf * HB + lr0 / SEQ; xin = C.x + g * DM; x1p = C.out + g * DM; }
        else { const size_t g = (size_t)hf * CTXH + (lr0 - LATH); mrow = 32; xin = C.ctx + g * DM; x1p = C.xc1 + g * DM; }
        f32x4 v[2][4];
        const float* base = (MODE == 2) ? x1p : xin;
#pragma unroll
        for (int rr = 0; rr < 2; ++rr)
#pragma unroll
            for (int j = 0; j < 4; ++j) v[rr][j] = __builtin_nontemporal_load((const f32x4*)(base + rr * DM + 4 * lane + 256 * j));
        if (MODE >= 1) {
            const float* gate = C.mod + ((size_t)(MODE - 1) * 33 + mrow) * 3072 + 2048;
            const float* pg = C.post_g + (MODE - 1) * DM;
            const bf16_t* yr = C.Y + (size_t)lr0 * DM;
            f32x4 y[2][4]; float ss[2];
#pragma unroll
            for (int rr = 0; rr < 2; ++rr) { ss[rr] = 0.f;
#pragma unroll
                for (int j = 0; j < 4; ++j) { { const u32x2 yw_ = __builtin_nontemporal_load((const u32x2*)(yr + rr * DM + 4 * lane + 256 * j)); y[rr][j] = (f32x4){bf_lo(yw_.x), bf_hi(yw_.x), bf_lo(yw_.y), bf_hi(yw_.y)}; } ss[rr] += (y[rr][j][0] * y[rr][j][0] + y[rr][j][1] * y[rr][j][1]) + (y[rr][j][2] * y[rr][j][2] + y[rr][j][3] * y[rr][j][3]); } }
            const float rstd0 = __builtin_amdgcn_rsqf(wave_sum(ss[0]) * (1.f / DM) + NORM_EPS), rstd1 = __builtin_amdgcn_rsqf(wave_sum(ss[1]) * (1.f / DM) + NORM_EPS);
#pragma unroll
            for (int j = 0; j < 4; ++j) { const f32x4 gt = *(const f32x4*)(gate + 4 * lane + 256 * j), pgv = *(const f32x4*)(pg + 4 * lane + 256 * j);
#pragma unroll
                for (int rr = 0; rr < 2; ++rr) {
                    v[rr][j] = v[rr][j] + gt * (y[rr][j] * (rr ? rstd1 : rstd0) * pgv);
#ifdef PROBE_A
                    if (MODE == 2 && hf == 1 && lr0 + rr < 1024) { v[rr][j] = v[rr][j] + pe2; if (lr0 + rr == 0 && lane == 0 && j == 0) v[rr][j][0] += pe1; }
#endif
                    __builtin_nontemporal_store(v[rr][j], (f32x4*)(x1p + rr * DM + 4 * lane + 256 * j)); } }
        }
        if (MODE <= 1) {
            const float* md = C.mod + ((size_t)MODE * 33 + mrow) * 3072;
            const float* pre = C.pre_g + MODE * DM;
            float ss[2];
#pragma unroll
            for (int rr = 0; rr < 2; ++rr) { ss[rr] = 0.f;
#pragma unroll
                for (int j = 0; j < 4; ++j) ss[rr] += (v[rr][j][0] * v[rr][j][0] + v[rr][j][1] * v[rr][j][1]) + (v[rr][j][2] * v[rr][j][2] + v[rr][j][3] * v[rr][j][3]); }
            const float rstd0 = __builtin_amdgcn_rsqf(wave_sum(ss[0]) * (1.f / DM) + NORM_EPS), rstd1 = __builtin_amdgcn_rsqf(wave_sum(ss[1]) * (1.f / DM) + NORM_EPS);
            bf16_t* hr = C.H + (size_t)lr0 * DM;
#pragma unroll
            for (int j = 0; j < 4; ++j) { const f32x4 sh = *(const f32x4*)(md + 4 * lane + 256 * j), scl = *(const f32x4*)(md + 1024 + 4 * lane + 256 * j), pv = *(const f32x4*)(pre + 4 * lane + 256 * j);
#pragma unroll
                for (int rr = 0; rr < 2; ++rr) st_bf4(hr + rr * DM + 4 * lane + 256 * j, (v[rr][j] * (rr ? rstd1 : rstd0) * pv) * (1.f + scl) + sh); }
        }
    }
}

__device__ __forceinline__ int crow(int r, int hi) { return (r & 3) + 8 * (r >> 2) + 4 * hi; }
__device__ __forceinline__ bf16x8 tanh8(bf16x8 x) {
    const u32x4 w = __builtin_bit_cast(u32x4, x); u32x4 o;
#pragma unroll
    for (int i = 0; i < 4; ++i) { const float a = bf_lo(w[i]), b = bf_hi(w[i]);
        const float ta = 1.f - 2.f * frcp(1.f + fexp2(2.885390081777927f * a)), tb = 1.f - 2.f * frcp(1.f + fexp2(2.885390081777927f * b));
        o[i] = cvt_pk_bf16(ta, tb); }
    return __builtin_bit_cast(bf16x8, o);
}
__device__ __forceinline__ void prep_block(const Ctx& C, int l, int task, LAS unsigned char* lds) {
    const int tid = opaque(threadIdx.x), lane = tid & 63, wid = __builtin_amdgcn_readfirstlane(tid >> 6);
    const int r32 = lane & 31, hi = lane >> 5, lr0 = task * 64;
    constexpr int PST = 520;
    LAS bf16_t* xs = (LAS bf16_t*)lds;
#pragma unroll
    for (int i = 0; i < 8; ++i) { const int idx = tid + 512 * i, row = idx >> 6, ch = idx & 63;
        const u32x4 v = __builtin_nontemporal_load((const u32x4*)(C.P + (size_t)(lr0 + row) * DIN + (ch < 32 ? C_K + ch * 8 : C_LWF + (ch - 32) * 8)));
        *(LAS u32x4*)(xs + row * PST + ch * 8) = v; }
    __syncthreads();
    const int tg = wid & 1, q = wid >> 1, lrw = lr0 + tg * 32;
    const LAS bf16_t* xrow = xs + (tg * 32 + r32) * PST + hi * 8;
    const LAS bf16_t* xcol = xs + (tg * 32) * PST;
    const bf16_t* WT = C.WupT + (size_t)l * 4 * 256 * 64;
    constexpr size_t ARR = (size_t)MH * 256;
#pragma unroll 1
    for (int d = 0; d < 2; ++d) {
        bf16x8 xf[4];
#pragma unroll
        for (int i0 = 0; i0 < 4; ++i0) xf[i0] = tanh8(*(const LAS bf16x8*)(xrow + 256 + d * 64 + i0 * 16));
        const bf16_t* wt = WT + (size_t)d * 256 * 64;
        const float* w0 = C.w0 + (l * 2 + d) * 256;
        float* dst = C.SC + (size_t)d * ARR;
#pragma unroll 1
        for (int jb = 2 * q; jb < 2 * q + 2; ++jb) {
            const int j = jb * 32 + r32;
            f32x16 acc = {};
#pragma unroll
            for (int i0 = 0; i0 < 4; ++i0) { const bf16x8 wf = *(const bf16x8*)(wt + (size_t)j * 64 + i0 * 16 + hi * 8); acc = __builtin_amdgcn_mfma_f32_32x32x16_bf16(xf[i0], wf, acc, 0, 0, 0); }
            const float w0j = w0[j];
#pragma unroll
            for (int r = 0; r < 16; ++r) { const int row = lrw + crow(r, hi);
                const float sg = sigmoidf_(acc[r] + w0j);
                dst[(size_t)row * 256 + j] = fexp2(-0.8750429636f * sg); }
        }
    }
    {
        const int hd = q;
        float rn[16];
        { const float kk0 = C.k_k[l * 256 + hd * 64 + r32], kk1 = C.k_k[l * 256 + hd * 64 + 32 + r32];
#pragma unroll
          for (int r = 0; r < 16; ++r) { const LAS bf16_t* kp = xcol + crow(r, hi) * PST + hd * 64 + r32;
              const float a = bf2f(kp[0]) * kk0, b = bf2f(kp[32]) * kk1; const float s = sum32(a * a + b * b);
              rn[r] = frcp(fmaxf(__builtin_sqrtf(s), 1e-12f)); } }
#pragma unroll 1
        for (int jd = 0; jd < 4; ++jd) {
            const int jb2 = jd >> 1, d = jd & 1;
            const int j = hd * 64 + jb2 * 32 + r32;
            const float kkj = C.k_k[l * 256 + j], kaj = C.k_a[l * 256 + j];
            const bf16_t* wt = WT + (size_t)(2 + d) * 256 * 64;
            f32x16 acc = {};
#pragma unroll
            for (int i0 = 0; i0 < 4; ++i0) { const bf16x8 xf = *(const LAS bf16x8*)(xrow + 384 + d * 64 + i0 * 16);
                const bf16x8 wf = *(const bf16x8*)(wt + (size_t)j * 64 + i0 * 16 + hi * 8); acc = __builtin_amdgcn_mfma_f32_32x32x16_bf16(xf, wf, acc, 0, 0, 0); }
            const float a0j = C.a0[(l * 2 + d) * 256 + j];
            bf16_t* sb16 = (bf16_t*)(C.SC + 2 * ARR);
            bf16_t* dkm = sb16 + (size_t)d * ARR; bf16_t* dbb = sb16 + (size_t)(2 + d) * ARR; bf16_t* daa = sb16 + 4 * ARR;
#pragma unroll
            for (int r = 0; r < 16; ++r) { const int cr = crow(r, hi); const size_t off = (size_t)(lrw + cr) * 256 + j;
                const float k = bf2f(xcol[cr * PST + j]);
                const float a = sigmoidf_(acc[r] + a0j), kkn = k * kkj * rn[r];
                const unsigned pk_ = cvt_pk_bf16(k * (1.f + (a - 1.f) * kaj), kkn * a);
                dkm[off] = (bf16_t)(pk_ & 0xffffu); dbb[off] = (bf16_t)(pk_ >> 16); if (d == 0) daa[off] = (bf16_t)(cvt_pk_bf16(-kkn, 0.f) & 0xffffu); }
        }
    }
    __syncthreads();
}
__device__ __forceinline__ void rowpass4(const Ctx& C, int l, int r0, int lane_in, bool do_conv) {
    const int lane = opaque(lane_in);
    const bool lat = r0 < LATH; const int t0 = lat ? (r0 & (SEQ - 1)) : ((r0 - LATH) & (CTX - 1)), len = lat ? SEQ : CTX;
    const bf16_t* pr = C.P + (size_t)r0 * DIN; const int c = 4 * lane;
    u32x4 qw[4], kw[4];
    if (lat) {
#pragma unroll
        for (int i = 0; i < 4; ++i) { qw[i] = *(const u32x4*)(pr + (size_t)i * DIN + C_AQ + 8 * lane); kw[i] = *(const u32x4*)(pr + (size_t)i * DIN + C_AK + 8 * lane); }
    }
    if (do_conv) {
        f32x4 u[6], bg[4], z[4];
#pragma unroll
        for (int i = 0; i < 6; ++i) { const bool ok = (i == 0) ? (t0 > 0) : (i == 5) ? (t0 + 4 < len) : true;
            const bf16_t* p = pr + (long)(i - 1) * DIN;
            u[i] = ok ? ld_bf4_nt(p + C_CC + c) * ld_bf4_nt(p + C_CH + c) : (f32x4){0.f, 0.f, 0.f, 0.f}; }
#pragma unroll
        for (int i = 0; i < 4; ++i) { bg[i] = ld_bf4_nt(pr + (size_t)i * DIN + C_CB + c); z[i] = ld_bf4_nt(pr + (size_t)i * DIN + C_CZ + c); }
        const float* cw = C.conv_w + l * 3 * 256 + c;
        const f32x4 w0 = *(const f32x4*)cw, w1 = *(const f32x4*)(cw + 256), w2 = *(const f32x4*)(cw + 512);
#pragma unroll
        for (int i = 0; i < 4; ++i) { const f32x4 y = u[i] * w0 + u[i + 1] * w1 + u[i + 2] * w2;
            f32x4 o; o[0] = bg[i][0] * y[0] * siluf_(z[i][0]); o[1] = bg[i][1] * y[1] * siluf_(z[i][1]); o[2] = bg[i][2] * y[2] * siluf_(z[i][2]); o[3] = bg[i][3] * y[3] * siluf_(z[i][3]);
            st_bf4(C.H + (size_t)(r0 + i) * DM + 256 + c, o); }
    }
    if (lat) {
        const float sg = (lane & 2) ? 1.f : -1.f;
#pragma unroll
        for (int i = 0; i < 4; ++i) {
            const int t = t0 + i; const int pos = ((lane >> 2) & 1) ? (t & 63) : (t >> 6);
            const f32x4* rp = (const f32x4*)(C.rope + (pos * 16 + 8 * (lane & 1)) * 2);
            const f32x4 c0 = rp[0], c1 = rp[1], c2 = rp[2], c3 = rp[3];
#pragma unroll
            for (int which = 0; which < 2; ++which) {
                const u32x4 w = which ? kw[i] : qw[i]; u32x4 pw;
#pragma unroll
                for (int e = 0; e < 4; ++e) pw[e] = (unsigned)__builtin_amdgcn_update_dpp(0, (int)w[e], 0x4E, 0xF, 0xF, true);
                u32x4 o;
                o[0] = cvt_pk_bf16(bf_lo(w[0]) * c0[0] + sg * bf_lo(pw[0]) * c0[1], bf_hi(w[0]) * c0[2] + sg * bf_hi(pw[0]) * c0[3]);
                o[1] = cvt_pk_bf16(bf_lo(w[1]) * c1[0] + sg * bf_lo(pw[1]) * c1[1], bf_hi(w[1]) * c1[2] + sg * bf_hi(pw[1]) * c1[3]);
                o[2] = cvt_pk_bf16(bf_lo(w[2]) * c2[0] + sg * bf_lo(pw[2]) * c2[1], bf_hi(w[2]) * c2[2] + sg * bf_hi(pw[2]) * c2[3]);
                o[3] = cvt_pk_bf16(bf_lo(w[3]) * c3[0] + sg * bf_lo(pw[3]) * c3[1], bf_hi(w[3]) * c3[2] + sg * bf_hi(pw[3]) * c3[3]);
                *(u32x4*)(C.P + (size_t)(r0 + i) * DIN + (which ? C_AK : C_AQ) + 8 * lane) = o;
            }
        }
    }
}
__device__ __forceinline__ void conv_row(const Ctx& C, int l, int lr, int lane_in) {
    const int lane = opaque(lane_in);
    const bool lat = lr < LATH; const int t = lat ? (lr & (SEQ - 1)) : ((lr - LATH) & (CTX - 1)), len = lat ? SEQ : CTX;
    const bf16_t* pr = C.P + (size_t)lr * DIN; const int c = 4 * lane;
    const float* cw = C.conv_w + l * 3 * 256 + c;
    const f32x4 w0 = *(const f32x4*)cw, w1 = *(const f32x4*)(cw + 256), w2 = *(const f32x4*)(cw + 512);
    f32x4 y = (ld_bf4(pr + C_CC + c) * ld_bf4(pr + C_CH + c)) * w1;
    if (t > 0) y = y + (ld_bf4(pr - DIN + C_CC + c) * ld_bf4(pr - DIN + C_CH + c)) * w0;
    if (t < len - 1) y = y + (ld_bf4(pr + DIN + C_CC + c) * ld_bf4(pr + DIN + C_CH + c)) * w2;
    const f32x4 bg = ld_bf4(pr + C_CB + c), z = ld_bf4(pr + C_CZ + c);
    f32x4 o; o[0] = bg[0] * y[0] * siluf_(z[0]); o[1] = bg[1] * y[1] * siluf_(z[1]); o[2] = bg[2] * y[2] * siluf_(z[2]); o[3] = bg[3] * y[3] * siluf_(z[3]);
    st_bf4(C.H + (size_t)lr * DM + 256 + c, o);
}

__device__ __forceinline__ void rope_row(const Ctx& C, int lr, int lane_in) {
    const int lane = opaque(lane_in);
    const int t = lr & (SEQ - 1); const int pos = ((lane >> 2) & 1) ? (t & 63) : (t >> 6);
    const f32x4* rp = (const f32x4*)(C.rope + (pos * 16 + 8 * (lane & 1)) * 2);
    const f32x4 c0 = rp[0], c1 = rp[1], c2 = rp[2], c3 = rp[3];
    const float sg = (lane & 2) ? 1.f : -1.f;
#pragma unroll
    for (int which = 0; which < 2; ++which) {
        bf16_t* p = C.P + (size_t)lr * DIN + (which ? C_AK : C_AQ) + 8 * lane;
        const u32x4 w = *(const u32x4*)p; u32x4 pw;
#pragma unroll
        for (int i = 0; i < 4; ++i) pw[i] = (unsigned)__builtin_amdgcn_update_dpp(0, (int)w[i], 0x4E, 0xF, 0xF, true);
        u32x4 o;
        o[0] = cvt_pk_bf16(bf_lo(w[0]) * c0[0] + sg * bf_lo(pw[0]) * c0[1], bf_hi(w[0]) * c0[2] + sg * bf_hi(pw[0]) * c0[3]);
        o[1] = cvt_pk_bf16(bf_lo(w[1]) * c1[0] + sg * bf_lo(pw[1]) * c1[1], bf_hi(w[1]) * c1[2] + sg * bf_hi(pw[1]) * c1[3]);
        o[2] = cvt_pk_bf16(bf_lo(w[2]) * c2[0] + sg * bf_lo(pw[2]) * c2[1], bf_hi(w[2]) * c2[2] + sg * bf_hi(pw[2]) * c2[3]);
        o[3] = cvt_pk_bf16(bf_lo(w[3]) * c3[0] + sg * bf_lo(pw[3]) * c3[1], bf_hi(w[3]) * c3[2] + sg * bf_hi(pw[3]) * c3[3]);
        *(u32x4*)p = o;
    }
}

__device__ __forceinline__ int scan_row(int s, int dir, int bl) {
    if (s < CTX) { const int t = dir ? (CTX - 1 - s) : s; return LATH + bl * CTX + t; }
    const int t0 = s - CTX; const int t = dir ? (SEQ - 1 - t0) : t0; return bl * SEQ + t;
}
__device__ __forceinline__ void scan_unit(const Ctx& C, int l, int u, LAS unsigned char* lds) {
    const int bl = u >> 3, hd = (u >> 1) & 3, dir = u & 1;
    const int tid = opaque(threadIdx.x), lane = tid & 63, wid = __builtin_amdgcn_readfirstlane(tid >> 6);
    constexpr size_t ARR = (size_t)MH * 256;
    constexpr int CHF = 32 * 6 * 64;
    constexpr int YB0 = 2 * CHF;
    const int lst = tid >> 4, q4 = tid & 15;
    const float* a_dec = C.SC + (size_t)dir * ARR + hd * 64 + q4 * 4;
    const bf16_t* sb16 = (const bf16_t*)(C.SC + 2 * ARR);
    const bf16_t* a_km = sb16 + (size_t)dir * ARR + hd * 64 + q4 * 4;
    const bf16_t* a_bb = sb16 + (size_t)(2 + dir) * ARR + hd * 64 + q4 * 4;
    const bf16_t* a_aa = sb16 + 4 * ARR + hd * 64 + q4 * 4;
    const bf16_t* a_r = C.P + C_R + hd * 64 + q4 * 4;
    const bf16_t* a_v = C.P + C_V + hd * 64 + q4 * 4;
    float* a_y = C.YS + (size_t)dir * ARR + hd * 64 + q4 * 4;
    f32x4 g0, g1, g2, g3, g4, g5;
#define SC_LOAD(c) do { const size_t row_ = (size_t)scan_row((c) * 32 + lst, dir, bl); \
        g0 = *(const f32x4*)(a_dec + row_ * 256); g1 = ld_bf4(a_km + row_ * 256); g2 = ld_bf4(a_aa + row_ * 256); g3 = ld_bf4(a_bb + row_ * 256); \
        g4 = ld_bf4(a_r + row_ * DIN); g5 = ld_bf4(a_v + row_ * DIN); } while (0)
#define SC_WRITE(b) do { LAS float* d_ = (LAS float*)lds + (b) * CHF + lst * 384 + q4 * 4; \
        *(LAS f32x4*)(d_) = g0; *(LAS f32x4*)(d_ + 64) = g1; *(LAS f32x4*)(d_ + 128) = g2; *(LAS f32x4*)(d_ + 192) = g3; *(LAS f32x4*)(d_ + 256) = g4; *(LAS f32x4*)(d_ + 320) = g5; } while (0)
    f32x4 S0 = {0.f, 0.f, 0.f, 0.f}, S1 = {0.f, 0.f, 0.f, 0.f};
    const int vq = lane >> 4, k16 = lane & 15;
    const int rloc = 8 * wid + 2 * vq;
    SC_LOAD(0); SC_WRITE(0); __syncthreads();
    constexpr int NCH = (CTX + SEQ) / 32;
#pragma unroll 1
    for (int c = 0; c < NCH; ++c) {
        if (c > 0 && ((c - 1 >= CTX / 32) || (l == 0))) {
            const f32x4 yv = *(const LAS f32x4*)((const LAS float*)lds + YB0 + ((c - 1) & 1) * 2048 + lst * 64 + q4 * 4);
            *(f32x4*)(a_y + (size_t)scan_row((c - 1) * 32 + lst, dir, bl) * 256) = yv;
        }
        if (c + 1 < NCH) SC_LOAD(c + 1);
        {
            const LAS float* cb = (const LAS float*)lds + (c & 1) * CHF + k16 * 4;
            const LAS float* vbp = (const LAS float*)lds + (c & 1) * CHF + 320 + rloc;
            LAS float* yb = (LAS float*)lds + YB0 + (c & 1) * 2048 + rloc + (k16 & 1);
            const bool wout = (c >= CTX / 32) || (l == 0);
            f32x4 wA, kA, aA, bA, rA, wB, kB, aB, bB, rB; f32x2 vA, vB;
#define SC_RD(W, K, A, B, R, V, s) do { const LAS float* sb_ = cb + (s) * 384; W = *(const LAS f32x4*)(sb_); K = *(const LAS f32x4*)(sb_ + 64); A = *(const LAS f32x4*)(sb_ + 128); \
        B = *(const LAS f32x4*)(sb_ + 192); R = *(const LAS f32x4*)(sb_ + 256); V = *(const LAS f32x2*)(vbp + (s) * 384); } while (0)
#define SC_STEP(W, K, A, B, R, V, DOST, s) do { \
        float sa0 = fmaf(S0[3], A[3], fmaf(S0[2], A[2], fmaf(S0[1], A[1], S0[0] * A[0]))); \
        float sa1 = fmaf(S1[3], A[3], fmaf(S1[2], A[2], fmaf(S1[1], A[1], S1[0] * A[0]))); \
        sa0 = sum16(sa0); sa1 = sum16(sa1); \
        S0 = S0 * W + sa0 * B + V[0] * K; S1 = S1 * W + sa1 * B + V[1] * K; \
        if (DOST) { \
        float y0 = fmaf(S0[3], R[3], fmaf(S0[2], R[2], fmaf(S0[1], R[1], S0[0] * R[0]))); \
        float y1 = fmaf(S1[3], R[3], fmaf(S1[2], R[2], fmaf(S1[1], R[1], S1[0] * R[0]))); \
        y0 = sum16(y0); y1 = sum16(y1); \
        yb[(s) * 64] = (k16 & 1) ? y1 : y0; } } while (0)
            SC_RD(wA, kA, aA, bA, rA, vA, 0);
            if (wout) {
#pragma unroll 2
                for (int s = 0; s < 32; s += 2) { SC_RD(wB, kB, aB, bB, rB, vB, s + 1); SC_STEP(wA, kA, aA, bA, rA, vA, true, s);
                                                  SC_RD(wA, kA, aA, bA, rA, vA, s + 2); SC_STEP(wB, kB, aB, bB, rB, vB, true, s + 1); }
            } else {
#pragma unroll 2
                for (int s = 0; s < 32; s += 2) { SC_RD(wB, kB, aB, bB, rB, vB, s + 1); SC_STEP(wA, kA, aA, bA, rA, vA, false, s);
                                                  SC_RD(wA, kA, aA, bA, rA, vA, s + 2); SC_STEP(wB, kB, aB, bB, rB, vB, false, s + 1); }
            }
#undef SC_RD
#undef SC_STEP
        }
        if (c + 1 < NCH) SC_WRITE((c + 1) & 1);
        __syncthreads();
    }
    { const f32x4 yv = *(const LAS f32x4*)((const LAS float*)lds + YB0 + ((NCH - 1) & 1) * 2048 + lst * 64 + q4 * 4);
      *(f32x4*)(a_y + (size_t)scan_row((NCH - 1) * 32 + lst, dir, bl) * 256) = yv; }
    __syncthreads();
#undef SC_LOAD
#undef SC_WRITE
}

constexpr int CK_RAW = 0, CK_XA = 24576, CK_ZB = 29184, CK_EZ = 33792  , CK_UV = 44032  , CK_PP = 54272, CK_S0 = 56832, CK_GF = 66048, CK_R0 = 70656, CK_DC = 79872  , CK_END = 80384;
__device__ __forceinline__ void ck_images(LAS float* RAW, LAS bf16_t* XA, LAS bf16_t* ZB, LAS bf16_t* EZ, LAS bf16_t* UV, LAS float* DC, int s) {
    const int lt = s >> 5, kp = (s & 31) * 2;
    float c0 = 1.f, c1 = 1.f, cp0 = 1.f, cp1 = 1.f, ct0 = 1.f, ct1 = 1.f;
#pragma unroll
    for (int j = 0; j < 16; ++j) { const f32x2 w = *(const LAS f32x2*)(RAW + j * 64 + kp); if (j == lt) { cp0 = c0; cp1 = c1; } c0 *= w[0]; c1 *= w[1]; if (j == lt) { ct0 = c0; ct1 = c1; } }
    const f32x2 aa = *(const LAS f32x2*)(RAW + 1024 + lt * 64 + kp), bb = *(const LAS f32x2*)(RAW + 2048 + lt * 64 + kp), km = *(const LAS f32x2*)(RAW + 3072 + lt * 64 + kp),
                rr = *(const LAS f32x2*)(RAW + 4096 + lt * 64 + kp), vv = *(const LAS f32x2*)(RAW + 5120 + lt * 64 + kp);
    const float en0 = frcp(ct0), en1 = frcp(ct1), ee0 = c0 * en0, ee1 = c1 * en1;
    *(LAS unsigned*)(XA + lt * 72 + kp) = cvt_pk_bf16(aa[0] * cp0, aa[1] * cp1);
    *(LAS unsigned*)(XA + (16 + lt) * 72 + kp) = cvt_pk_bf16(rr[0] * ct0, rr[1] * ct1);
    *(LAS unsigned*)(ZB + lt * 72 + kp) = cvt_pk_bf16(bb[0] * en0, bb[1] * en1);
    *(LAS unsigned*)(ZB + (16 + lt) * 72 + kp) = cvt_pk_bf16(km[0] * en0, km[1] * en1);
    const unsigned eb = cvt_pk_bf16(bb[0] * ee0, bb[1] * ee1), ek = cvt_pk_bf16(km[0] * ee0, km[1] * ee1), ev = cvt_pk_bf16(vv[0], vv[1]);
    EZ[kp * 40 + lt] = (bf16_t)(eb & 0xffffu); EZ[(kp + 1) * 40 + lt] = (bf16_t)(eb >> 16);
    EZ[kp * 40 + 16 + lt] = (bf16_t)(ek & 0xffffu); EZ[(kp + 1) * 40 + 16 + lt] = (bf16_t)(ek >> 16);
    UV[kp * 40 + 16 + lt] = (bf16_t)(ev & 0xffffu); UV[(kp + 1) * 40 + 16 + lt] = (bf16_t)(ev >> 16);
    if (lt == 0) *(LAS f32x2*)(DC + kp) = (f32x2){c0, c1};
}
__device__ __forceinline__ void scan_chunked(const Ctx& C, int l, int u, LAS unsigned char* lds) {
    const int bl = u >> 3, hd = (u >> 1) & 3, dir = u & 1;
    const int tid0 = opaque(threadIdx.x), wid = __builtin_amdgcn_readfirstlane(tid0 >> 6);
    constexpr size_t ARR = (size_t)MH * 256;
    LAS float* RAW = (LAS float*)(lds + CK_RAW);
    LAS bf16_t* XA = (LAS bf16_t*)(lds + CK_XA);
    LAS bf16_t* ZB = (LAS bf16_t*)(lds + CK_ZB);
    LAS bf16_t* EZ0 = (LAS bf16_t*)(lds + CK_EZ);
    LAS bf16_t* UV0 = (LAS bf16_t*)(lds + CK_UV);
    LAS bf16_t* PP = (LAS bf16_t*)(lds + CK_PP);
    LAS bf16_t* S0 = (LAS bf16_t*)(lds + CK_S0);
    LAS float* GF = (LAS float*)(lds + CK_GF);
    LAS float* R0 = (LAS float*)(lds + CK_R0);
    LAS float* DC0 = (LAS float*)(lds + CK_DC);
    const bf16_t* sb16 = (const bf16_t*)(C.SC + 2 * ARR);
    f32x2 ld_w; unsigned ld_km, ld_bb, ld_aa, ld_r, ld_v;
#define CK_LOAD(c) do { const int tl_ = opaque(tid0); const size_t row_ = (size_t)scan_row((c) * 16 + (tl_ >> 5), dir, bl); const size_t o2_ = row_ * 256 + hd * 64 + (tl_ & 31) * 2, op_ = row_ * DIN + hd * 64 + (tl_ & 31) * 2; \
        ld_w = __builtin_nontemporal_load((const f32x2*)(C.SC + (size_t)dir * ARR + o2_)); ld_km = __builtin_nontemporal_load((const unsigned*)(sb16 + (size_t)dir * ARR + o2_)); \
        ld_bb = __builtin_nontemporal_load((const unsigned*)(sb16 + (size_t)(2 + dir) * ARR + o2_)); ld_aa = __builtin_nontemporal_load((const unsigned*)(sb16 + 4 * ARR + o2_)); ld_r = __builtin_nontemporal_load((const unsigned*)(C.P + C_R + op_)); ld_v = __builtin_nontemporal_load((const unsigned*)(C.P + C_V + op_)); } while (0)
#define CK_STORE() do { const int ts_ = opaque(tid0); LAS float* q_ = RAW + (ts_ >> 5) * 64 + (ts_ & 31) * 2; \
        *(LAS f32x2*)(q_) = ld_w; *(LAS f32x2*)(q_ + 1024) = (f32x2){bf_lo(ld_aa), bf_hi(ld_aa)}; \
        *(LAS f32x2*)(q_ + 2048) = (f32x2){bf_lo(ld_bb), bf_hi(ld_bb)}; *(LAS f32x2*)(q_ + 3072) = (f32x2){bf_lo(ld_km), bf_hi(ld_km)}; \
        *(LAS f32x2*)(q_ + 4096) = (f32x2){bf_lo(ld_r), bf_hi(ld_r)}; *(LAS f32x2*)(q_ + 5120) = (f32x2){bf_lo(ld_v), bf_hi(ld_v)}; } while (0)
    for (int e = tid0; e < CK_END / 4; e += 512) ((LAS unsigned*)lds)[e] = 0u;
    __syncthreads();
    f32x16 S = {};
    const int vt = (wid >> 1) & 1, kt = wid & 1;
    constexpr int NCH = (CTX + SEQ) / 16;
    CK_LOAD(0); CK_STORE(); __syncthreads();
    ck_images(RAW, XA, ZB, EZ0, UV0, DC0, opaque(tid0));
    CK_LOAD(1);
    __syncthreads();
#pragma unroll 1
    for (int c = 0; c < NCH; ++c) {
        const int pb = c & 1;
        LAS bf16_t* EZ = EZ0 + pb * (64 * 40); LAS bf16_t* UV = UV0 + pb * (64 * 40); LAS float* DC = DC0 + pb * 64;
        if (c + 1 < NCH) CK_STORE();
        if (c + 2 < NCH) CK_LOAD(c + 2);
        if (wid == 0) {
            const int ln = opaque(tid0) & 63, r32 = ln & 31, hi = ln >> 5;
            f32x16 acc = {};
#pragma unroll
            for (int d0 = 0; d0 < 4; ++d0) { const bf16x8 a = *(const LAS bf16x8*)(XA + r32 * 72 + d0 * 16 + hi * 8), b = *(const LAS bf16x8*)(ZB + r32 * 72 + d0 * 16 + hi * 8);
                acc = __builtin_amdgcn_mfma_f32_32x32x16_bf16(a, b, acc, 0, 0, 0); }
#pragma unroll
            for (int r = 0; r < 16; ++r) GF[crow(r, hi) * 36 + r32] = acc[r];
        } else if (wid <= 2) {
            const int ln = opaque(tid0) & 63, r32 = ln & 31, hi = ln >> 5;
            const int v0 = (wid - 1) * 32;
            f32x16 acc = {};
#pragma unroll
            for (int d0 = 0; d0 < 4; ++d0) { const bf16x8 a = *(const LAS bf16x8*)(S0 + (v0 + r32) * 72 + d0 * 16 + hi * 8), b = *(const LAS bf16x8*)(XA + r32 * 72 + d0 * 16 + hi * 8);
                acc = __builtin_amdgcn_mfma_f32_32x32x16_bf16(a, b, acc, 0, 0, 0); }
#pragma unroll
            for (int r = 0; r < 16; ++r) R0[(v0 + crow(r, hi)) * 36 + r32] = acc[r];
        }
        __syncthreads();
        if (wid == 3) {
            const int v = opaque(tid0) & 63;
            float uu[16], vq[16];
#pragma unroll
            for (int q = 0; q < 4; ++q) { const f32x4 x = *(const LAS f32x4*)(R0 + v * 36 + 4 * q); uu[4 * q] = x[0]; uu[4 * q + 1] = x[1]; uu[4 * q + 2] = x[2]; uu[4 * q + 3] = x[3]; }
#pragma unroll
            for (int q = 0; q < 2; ++q) { const u32x4 x = *(const LAS u32x4*)(UV + v * 40 + 16 + 8 * q);
#pragma unroll
                for (int e = 0; e < 4; ++e) { vq[8 * q + 2 * e] = bf_lo(x[e]); vq[8 * q + 2 * e + 1] = bf_hi(x[e]); } }
#pragma unroll
            for (int t = 1; t < 16; ++t) {
                float a0 = uu[t], a1 = 0.f, a2 = 0.f, a3 = 0.f;
#pragma unroll
                for (int q = 0; q * 4 < t; ++q) { const f32x4 m = *(const LAS f32x4*)(GF + t * 36 + 4 * q), n = *(const LAS f32x4*)(GF + t * 36 + 16 + 4 * q);
#pragma unroll
                    for (int e = 0; e < 4; ++e) if (4 * q + e < t) { if (e & 1) { a1 = fmaf(uu[4 * q + e], m[e], a1); a3 = fmaf(vq[4 * q + e], n[e], a3); } else { a0 = fmaf(uu[4 * q + e], m[e], a0); a2 = fmaf(vq[4 * q + e], n[e], a2); } } }
                uu[t] = (a0 + a1) + (a2 + a3);
            }
            u32x4 w0, w1;
            w0[0] = cvt_pk_bf16(uu[0], uu[1]); w0[1] = cvt_pk_bf16(uu[2], uu[3]); w0[2] = cvt_pk_bf16(uu[4], uu[5]); w0[3] = cvt_pk_bf16(uu[6], uu[7]);
            w1[0] = cvt_pk_bf16(uu[8], uu[9]); w1[1] = cvt_pk_bf16(uu[10], uu[11]); w1[2] = cvt_pk_bf16(uu[12], uu[13]); w1[3] = cvt_pk_bf16(uu[14], uu[15]);
            *(LAS u32x4*)(UV + v * 40) = w0; *(LAS u32x4*)(UV + v * 40 + 8) = w1;
        } else if (wid == 4) {
            const int ln = opaque(tid0) & 63; const int t = ln >> 2, jq = (ln & 3) * 8;
            const f32x4 g0 = *(const LAS f32x4*)(GF + (16 + t) * 36 + jq), g1 = *(const LAS f32x4*)(GF + (16 + t) * 36 + jq + 4);
            float x[8] = {g0[0], g0[1], g0[2], g0[3], g1[0], g1[1], g1[2], g1[3]};
#pragma unroll
            for (int e = 0; e < 8; ++e) { const int i = (jq + e) & 15; if (i > t) x[e] = 0.f; }
            u32x4 w; w[0] = cvt_pk_bf16(x[0], x[1]); w[1] = cvt_pk_bf16(x[2], x[3]); w[2] = cvt_pk_bf16(x[4], x[5]); w[3] = cvt_pk_bf16(x[6], x[7]);
            *(LAS u32x4*)(PP + t * 40 + jq) = w;
        } else if (c + 1 < NCH) {
            const int w6 = (wid < 3) ? wid : wid - 2;
            const int s0 = w6 * 64 + (opaque(tid0) & 63);
            LAS bf16_t* EZn = EZ0 + (pb ^ 1) * (64 * 40); LAS bf16_t* UVn = UV0 + (pb ^ 1) * (64 * 40); LAS float* DCn = DC0 + (pb ^ 1) * 64;
            ck_images(RAW, XA, ZB, EZn, UVn, DCn, s0);
            if (s0 < 128) ck_images(RAW, XA, ZB, EZn, UVn, DCn, s0 + 384);
        }
        __syncthreads();
        if (wid < 4) {
            const int ln = opaque(tid0) & 63, r32 = ln & 31, hi = ln >> 5;
            const float dc = DC[kt * 32 + r32];
#pragma unroll
            for (int r = 0; r < 16; ++r) S[r] *= dc;
#pragma unroll
            for (int js = 0; js < 2; ++js) { const bf16x8 a = *(const LAS bf16x8*)(UV + (vt * 32 + r32) * 40 + js * 16 + hi * 8), b = *(const LAS bf16x8*)(EZ + (kt * 32 + r32) * 40 + js * 16 + hi * 8);
                S = __builtin_amdgcn_mfma_f32_32x32x16_bf16(a, b, S, 0, 0, 0); }
            asm volatile("s_nop 15\n\ts_nop 7" : "+v"(S));
#pragma unroll
            for (int r = 0; r < 16; r += 2) { const unsigned pk = cvt_pk_bf16(S[r], S[r + 1]);
                S0[(vt * 32 + crow(r, hi)) * 72 + kt * 32 + r32] = (bf16_t)(pk & 0xffffu); S0[(vt * 32 + crow(r + 1, hi)) * 72 + kt * 32 + r32] = (bf16_t)(pk >> 16); }
        } else if ((wid == 5 || wid == 6) && ((c >= CTX / 16) || (l == 0))) {
            const int ln = opaque(tid0) & 63, r32 = ln & 31, hi = ln >> 5;
            const int v0 = (wid - 5) * 32;
            f32x16 acc;
#pragma unroll
            for (int r = 0; r < 16; ++r) acc[r] = (r32 < 16) ? R0[(v0 + crow(r, hi)) * 36 + 16 + r32] : 0.f;
#pragma unroll
            for (int js = 0; js < 2; ++js) { const bf16x8 a = *(const LAS bf16x8*)(UV + (v0 + r32) * 40 + js * 16 + hi * 8), b = *(const LAS bf16x8*)(PP + r32 * 40 + js * 16 + hi * 8);
                acc = __builtin_amdgcn_mfma_f32_32x32x16_bf16(a, b, acc, 0, 0, 0); }
            if (r32 < 16) { float* yp = C.YS + (size_t)dir * ARR + hd * 64 + (size_t)scan_row(c * 16 + r32, dir, bl) * 256 + v0 + 4 * hi;
#pragma unroll
                for (int q = 0; q < 4; ++q) *(f32x4*)(yp + 8 * q) = (f32x4){acc[4 * q], acc[4 * q + 1], acc[4 * q + 2], acc[4 * q + 3]}; }
        }
        __syncthreads();
    }
#undef CK_LOAD
#undef CK_STORE
}

#define KSWZ(row, colB) ((row) * 256 + ((colB) ^ (((row) & 7) << 4)))
#define SBAR() __builtin_amdgcn_sched_barrier(0)
constexpr int SHM_KV = 64 * 128 * 2;
constexpr float ATT_THR = 11.5f;
__device__ __forceinline__ int v_st(int k, int c) { const int kk = (k & ~0xC) | ((k & 4) << 1) | ((k & 8) >> 1); return ((kk >> 3) * 4 + (c >> 5)) * 512 + ((kk & 7) * 32 + (c & 31)) * 2; }
__device__ __forceinline__ int v_rd_base(int lane) { return ((lane & 3) << 3) | (((lane >> 2) & 3) << 6) | (((lane >> 4) & 1) << 5) | (((lane >> 5) & 1) << 8); }
constexpr int v_rd_off(int d0, int ks, int half) { return d0 * 512 + ks * 4096 + half * 2048; }
template <int OFF> __device__ __forceinline__ s16x4 tr_read(int vb) { s16x4 r; asm volatile("ds_read_b64_tr_b16 %0, %1 offset:%2" : "=&v"(r) : "v"(vb), "i"(OFF) : "memory"); return r; }
struct VFrag { s16x4 l0, h0, l1, h1, l2, h2, l3, h3; };
template <int D0> __device__ __forceinline__ void v_reads(VFrag& f, int vb) {
    f.l0 = tr_read<v_rd_off(D0, 0, 0)>(vb); f.h0 = tr_read<v_rd_off(D0, 0, 1)>(vb); f.l1 = tr_read<v_rd_off(D0, 1, 0)>(vb); f.h1 = tr_read<v_rd_off(D0, 1, 1)>(vb);
    f.l2 = tr_read<v_rd_off(D0, 2, 0)>(vb); f.h2 = tr_read<v_rd_off(D0, 2, 1)>(vb); f.l3 = tr_read<v_rd_off(D0, 3, 0)>(vb); f.h3 = tr_read<v_rd_off(D0, 3, 1)>(vb);
}
__device__ __forceinline__ void pv_mma(f32x16& od, const VFrag& f, bf16x8 pa0, bf16x8 pa1, bf16x8 pa2, bf16x8 pa3) {
#define PKV(L, H) (bf16x8){L[0], L[1], L[2], L[3], H[0], H[1], H[2], H[3]}
    od = __builtin_amdgcn_mfma_f32_32x32x16_bf16(pa0, PKV(f.l0, f.h0), od, 0, 0, 0);
    od = __builtin_amdgcn_mfma_f32_32x32x16_bf16(pa1, PKV(f.l1, f.h1), od, 0, 0, 0);
    od = __builtin_amdgcn_mfma_f32_32x32x16_bf16(pa2, PKV(f.l2, f.h2), od, 0, 0, 0);
    od = __builtin_amdgcn_mfma_f32_32x32x16_bf16(pa3, PKV(f.l3, f.h3), od, 0, 0, 0);
#undef PKV
}
template <int KS> __device__ __forceinline__ void v_reads_ks(s16x4 (&l)[4], s16x4 (&h)[4], int vb) {
    l[0] = tr_read<v_rd_off(0, KS, 0)>(vb); h[0] = tr_read<v_rd_off(0, KS, 1)>(vb); l[1] = tr_read<v_rd_off(1, KS, 0)>(vb); h[1] = tr_read<v_rd_off(1, KS, 1)>(vb);
    l[2] = tr_read<v_rd_off(2, KS, 0)>(vb); h[2] = tr_read<v_rd_off(2, KS, 1)>(vb); l[3] = tr_read<v_rd_off(3, KS, 0)>(vb); h[3] = tr_read<v_rd_off(3, KS, 1)>(vb);
}
__device__ __forceinline__ void pv_mma_ks(f32x16 (&o)[4], const s16x4 (&l)[4], const s16x4 (&h)[4], bf16x8 pa) {
#define PKV(L, H) (bf16x8){L[0], L[1], L[2], L[3], H[0], H[1], H[2], H[3]}
    __builtin_amdgcn_s_setprio(1);
    o[0] = __builtin_amdgcn_mfma_f32_32x32x16_bf16(pa, PKV(l[0], h[0]), o[0], 0, 0, 0);
    o[1] = __builtin_amdgcn_mfma_f32_32x32x16_bf16(pa, PKV(l[1], h[1]), o[1], 0, 0, 0);
    o[2] = __builtin_amdgcn_mfma_f32_32x32x16_bf16(pa, PKV(l[2], h[2]), o[2], 0, 0, 0);
    o[3] = __builtin_amdgcn_mfma_f32_32x32x16_bf16(pa, PKV(l[3], h[3]), o[3], 0, 0, 0);
    __builtin_amdgcn_s_setprio(0);
#undef PKV
}
__device__ __forceinline__ void pv_all(f32x16 (&o)[4], int vb, bf16x8 pa0, bf16x8 pa1, bf16x8 pa2, bf16x8 pa3) {
    s16x4 l[4], h[4];
    v_reads_ks<0>(l, h, vb); asm volatile("s_waitcnt lgkmcnt(0)" ::: "memory"); SBAR(); pv_mma_ks(o, l, h, pa0);
    v_reads_ks<1>(l, h, vb); asm volatile("s_waitcnt lgkmcnt(0)" ::: "memory"); SBAR(); pv_mma_ks(o, l, h, pa1);
    v_reads_ks<2>(l, h, vb); asm volatile("s_waitcnt lgkmcnt(0)" ::: "memory"); SBAR(); pv_mma_ks(o, l, h, pa2);
    v_reads_ks<3>(l, h, vb); asm volatile("s_waitcnt lgkmcnt(0)" ::: "memory"); SBAR(); pv_mma_ks(o, l, h, pa3);
}
__device__ __forceinline__ void qk_tile(f32x16& p0, f32x16& p1, const bf16x8* qr, const char* Ks, int cb0, int r32, int hi) {
    bf16x8 kf[8];
#pragma unroll
    for (int d0 = 0; d0 < 4; ++d0) { const int cb = cb0 + (d0 * 16 + hi * 8) * 2; kf[2 * d0] = *(const bf16x8*)(Ks + KSWZ(r32, cb)); kf[2 * d0 + 1] = *(const bf16x8*)(Ks + KSWZ(32 + r32, cb)); }
    p0 = f32x16{}; p1 = f32x16{};
    __builtin_amdgcn_s_setprio(1);
#pragma unroll
    for (int d0 = 0; d0 < 4; ++d0) {
        p0 = __builtin_amdgcn_mfma_f32_32x32x16_bf16(kf[2 * d0], qr[d0], p0, 0, 0, 0);
        p1 = __builtin_amdgcn_mfma_f32_32x32x16_bf16(kf[2 * d0 + 1], qr[d0], p1, 0, 0, 0); }
    __builtin_amdgcn_s_setprio(0);
}
__device__ __forceinline__ void sm_pv(f32x16 (&o)[4], f32x16& p0, f32x16& p1, float& m_reg, float& l_reg, int vb, float* al_l, int r32, int hi) {
    float pmax;
    { float m0 = fmaxf(p0[0], p1[0]), m1 = fmaxf(p0[1], p1[1]), m2 = fmaxf(p0[2], p1[2]), m3 = fmaxf(p0[3], p1[3]);
#pragma unroll
      for (int r = 4; r < 16; r += 4) { m0 = fmaxf(fmaxf(m0, p0[r]), p1[r]); m1 = fmaxf(fmaxf(m1, p0[r + 1]), p1[r + 1]); m2 = fmaxf(fmaxf(m2, p0[r + 2]), p1[r + 2]); m3 = fmaxf(fmaxf(m3, p0[r + 3]), p1[r + 3]); }
      pmax = fmaxf(fmaxf(m0, m1), fmaxf(m2, m3)); }
    { auto rr = __builtin_amdgcn_permlane32_swap(__float_as_uint(pmax), __float_as_uint(pmax), false, false); pmax = fmaxf(__uint_as_float(rr[0]), __uint_as_float(rr[1])); }
    float mn, alpha;
    if (__builtin_expect(__all(pmax - m_reg <= ATT_THR), 1)) { mn = m_reg; alpha = 1.f; }
    else { mn = fmaxf(m_reg, pmax); alpha = fexp2(m_reg - mn); m_reg = mn; }
#pragma unroll
    for (int r = 0; r < 16; ++r) { p0[r] = fexp2(p0[r] - mn); p1[r] = fexp2(p1[r] - mn); }
    float ps;
    { float s0 = p0[0] + p1[0], s1 = p0[1] + p1[1], s2 = p0[2] + p1[2], s3 = p0[3] + p1[3];
#pragma unroll
      for (int r = 4; r < 16; r += 4) { s0 += p0[r] + p1[r]; s1 += p0[r + 1] + p1[r + 1]; s2 += p0[r + 2] + p1[r + 2]; s3 += p0[r + 3] + p1[r + 3]; }
      ps = (s0 + s1) + (s2 + s3); }
    { auto rr = __builtin_amdgcn_permlane32_swap(__float_as_uint(ps), __float_as_uint(ps), false, false); ps = __uint_as_float(rr[0]) + __uint_as_float(rr[1]); }
    l_reg = l_reg * alpha + ps;
    if (__any(alpha < 1.f)) { if (hi == 0) al_l[r32] = alpha; asm volatile("s_waitcnt lgkmcnt(0)" ::: "memory");
#pragma unroll
        for (int d = 0; d < 4; ++d)
#pragma unroll
            for (int r = 0; r < 16; ++r) o[d][r] *= al_l[crow(r, hi)]; }
    bf16x8 pa0, pa1, pa2, pa3;
#define PK4(P, BASE, OUT) do { unsigned a0 = cvt_pk_bf16(P[BASE + 0], P[BASE + 1]), a1 = cvt_pk_bf16(P[BASE + 2], P[BASE + 3]); \
        unsigned b0 = cvt_pk_bf16(P[BASE + 4], P[BASE + 5]), b1 = cvt_pk_bf16(P[BASE + 6], P[BASE + 7]); \
        auto r0 = __builtin_amdgcn_permlane32_swap(a0, b0, false, false); auto r1 = __builtin_amdgcn_permlane32_swap(a1, b1, false, false); \
        u32x4 w = {r0[0], r1[0], r0[1], r1[1]}; OUT = __builtin_bit_cast(bf16x8, w); } while (0)
    PK4(p0, 0, pa0); PK4(p0, 8, pa1); PK4(p1, 0, pa2); PK4(p1, 8, pa3);
#undef PK4
    pv_all(o, vb, pa0, pa1, pa2, pa3);
}
__device__ __forceinline__ void attn_unit(const Ctx& C, int l, int hd, int qrow0, int latbase, int ctxbase, int nlat, int NT, float lam, char* lds) {
    const int tid = opaque(threadIdx.x), wid = __builtin_amdgcn_readfirstlane(tid >> 6), lane = tid & 63, r32 = lane & 31, hi = lane >> 5, g = wid & 3, sj = wid >> 2;
    char* V_lds = lds; char* K_lds = lds + 2 * SHM_KV;
    float* wsf = (float*)(lds + 5 * SHM_KV) + wid * 64; float* al_l = wsf; float* li_l = wsf + 32;
    const bf16_t* Qw = C.P + (size_t)(qrow0 + g * 32 + r32) * DIN + C_AQ + hd * 128 + sj * 64 + hi * 8;
    bf16x8 qr[4];
#pragma unroll
    for (int d0 = 0; d0 < 4; ++d0) qr[d0] = __builtin_nontemporal_load((const bf16x8*)(Qw + d0 * 16));
    const int sr = tid >> 4, sc = (tid & 15) * 8, vst0 = v_st(sr, sc), vst1 = v_st(32 + sr, sc);
    const int vb0 = (int)(uintptr_t)V_lds + v_rd_base(lane);
    const bf16_t* Kc = C.P + C_AK + hd * 128 + sc; const bf16_t* Vc = C.P + C_AV + hd * 128 + sc;
    bf16x8 vs0, vs1, ks0, ks1;
#define TROW(t) ((t) < nlat ? latbase + (t) * 64 : ctxbase + ((t) - nlat) * 64)
#define LOADK(t) do { const size_t rb_ = (size_t)TROW(t); ks0 = *(const bf16x8*)(Kc + (rb_ + sr) * DIN); ks1 = *(const bf16x8*)(Kc + (rb_ + 32 + sr) * DIN); } while (0)
#define LOADV(t) do { const size_t rb_ = (size_t)TROW(t); vs0 = *(const bf16x8*)(Vc + (rb_ + sr) * DIN); vs1 = *(const bf16x8*)(Vc + (rb_ + 32 + sr) * DIN); } while (0)
#define WRITEK(b) do { *(bf16x8*)(K_lds + (b) * SHM_KV + KSWZ(sr, sc * 2)) = ks0; *(bf16x8*)(K_lds + (b) * SHM_KV + KSWZ(32 + sr, sc * 2)) = ks1; } while (0)
#define WRITEV(b) do { *(bf16x8*)(V_lds + (b) * SHM_KV + vst0) = vs0; *(bf16x8*)(V_lds + (b) * SHM_KV + vst1) = vs1; } while (0)
    float m_reg = -1e30f, l_reg = 0.f;
    f32x16 o[4] = {};
    f32x16 pA0, pA1, pB0, pB1;
    LOADK(0); LOADV(0); WRITEK(0); WRITEV(0); LOADK(1); WRITEK(1); __syncthreads();
    qk_tile(pA0, pA1, qr, K_lds, sj * 128, r32, hi);
    int kb1 = 1, kb2 = 2;
#define ATT_STEP(PC0, PC1, PN0, PN1, jj) do { \
        if ((jj) + 2 < NT) LOADK((jj) + 2); if ((jj) + 1 < NT) LOADV((jj) + 1); \
        if ((jj) + 1 < NT) qk_tile(PN0, PN1, qr, K_lds + kb1 * SHM_KV, sj * 128, r32, hi); \
        sm_pv(o, PC0, PC1, m_reg, l_reg, vb0 + ((jj) & 1) * SHM_KV, al_l, r32, hi); \
        if ((jj) + 2 < NT) WRITEK(kb2); if ((jj) + 1 < NT) WRITEV(((jj) + 1) & 1); \
        kb1 = kb2; kb2 = (kb2 == 2) ? 0 : kb2 + 1; \
        __syncthreads(); } while (0)
#pragma unroll 1
    for (int j = 0; j < NT; j += 2) {
        ATT_STEP(pA0, pA1, pB0, pB1, j);
        ATT_STEP(pB0, pB1, pA0, pA1, j + 1);
    }
#undef ATT_STEP
#undef TROW
#undef LOADK
#undef LOADV
#undef WRITEK
#undef WRITEV
    if (hi == 0) li_l[r32] = (sj ? lam : 1.f) * frcp(l_reg);
    asm volatile("s_waitcnt lgkmcnt(0)" ::: "memory");
    float* xb = (float*)lds + g * 4096 + lane;
    if (sj == 1) {
#pragma unroll
        for (int r = 0; r < 16; ++r) { const float a = li_l[crow(r, hi)];
#pragma unroll
            for (int d = 0; d < 4; ++d) xb[(d * 16 + r) * 64] = o[d][r] * a; }
    }
    __syncthreads();
    if (sj == 0) {
        const float lam1m = (l == 0) ? 0.8f : (1.f - 0.35550906759f);
        float g4[4];
#pragma unroll
        for (int d = 0; d < 4; ++d) g4[d] = C.subg[l * 128 + d * 32 + r32] * lam1m;
#pragma unroll
        for (int r = 0; r < 16; ++r) { const int rw = crow(r, hi); const float a = li_l[rw];
            float ss = 0.f; float v4[4];
#pragma unroll
            for (int d = 0; d < 4; ++d) { const float v = o[d][r] * a - xb[(d * 16 + r) * 64]; v4[d] = v; ss += v * v; }
            ss = sum32(ss);
            const float rstd = __builtin_amdgcn_rsqf(ss * (1.f / 128.f) + NORM_EPS);
            const size_t row = (size_t)(qrow0 + g * 32 + rw);
            const bf16_t* zp = C.P + row * DIN + C_AZ + hd * 128 + r32; bf16_t* op = C.H + row * DM + 512 + hd * 128 + r32;
#pragma unroll
            for (int d = 0; d < 4; ++d) { const float z = bf2f(zp[d * 32]); const float v = v4[d] * rstd * g4[d] * siluf_(z);
                op[d * 32] = (bf16_t)(cvt_pk_bf16(v, 0.f) & 0xffffu); } }
    }
    __syncthreads();
}

__device__ __forceinline__ void readout_row(const Ctx& C, int l, int lr, int lane_in) {
    const int lane = opaque(lane_in);
    constexpr size_t ARR = (size_t)MH * 256;
    const int j = 4 * lane; const size_t off = (size_t)lr * 256 + j;
    f32x4 y = __builtin_nontemporal_load((const f32x4*)(C.YS + off)) + __builtin_nontemporal_load((const f32x4*)(C.YS + ARR + off));
    float s = (y[0] + y[1]) + (y[2] + y[3]);
    s = sum16(s);
    const float mu = s * (1.f / 64.f);
    y = y - mu;
    float q = (y[0] * y[0] + y[1] * y[1]) + (y[2] * y[2] + y[3] * y[3]);
    q = sum16(q);
    const float rstd = __builtin_amdgcn_rsqf(q * (1.f / 64.f) + GN_EPS);
    const f32x4 lg = *(const f32x4*)(C.ln_g + l * 256 + j), lb = *(const f32x4*)(C.ln_b + l * 256 + j), rk = *(const f32x4*)(C.r_k + l * 256 + j);
    const bf16_t* pr = C.P + (size_t)lr * DIN;
    const f32x4 r = ld_bf4_nt(pr + C_R + j), v = ld_bf4_nt(pr + C_V + j), z = ld_bf4_nt(pr + C_ZR + j);
    const bf16_t* sb16 = (const bf16_t*)(C.SC + 2 * ARR);
    const f32x4 ks = ld_bf4_nt(sb16 + off) + ld_bf4_nt(sb16 + ARR + off);
    const f32x4 t = r * ks * rk;
    float bs = (t[0] + t[1]) + (t[2] + t[3]);
    bs = sum16(bs);
    f32x4 o = y * rstd * lg + lb + bs * v;
    o[0] *= siluf_(z[0]); o[1] *= siluf_(z[1]); o[2] *= siluf_(z[2]); o[3] *= siluf_(z[3]);
    st_bf4(C.H + (size_t)lr * DM + j, o);
}

#define XB_TMO      128
#define XB_XCNT(j)  (256  + 64 * (j))
#define XB_XSUB(j)  (1280 + 64 * (j))
#define XB_XGEN(j)  (2304 + 64 * (j))
#define XB_TOP      3328
#define XB_TOPGEN   3392
#define XCD_BAR_WORDS 3456
#define XB_SPIN_CAP (1u << 20)
__device__ __forceinline__ unsigned xb_ld(unsigned* p)              { return __hip_atomic_load(p, __ATOMIC_RELAXED, __HIP_MEMORY_SCOPE_AGENT); }
__device__ __forceinline__ unsigned xb_add(unsigned* p, unsigned v) { return __hip_atomic_fetch_add(p, v, __ATOMIC_RELAXED, __HIP_MEMORY_SCOPE_AGENT); }
__device__ __forceinline__ unsigned xb_xcc_id() { return (unsigned)__builtin_amdgcn_s_getreg((3 << 11) | 20) & 0xFu; }
#define XB_SPIN(cond, bar) do { unsigned _sp = 0; while (cond) { __builtin_amdgcn_s_sleep(1); \
    if ((++_sp & 255u) == 0u) { if (xb_ld(&(bar)[XB_TMO])) break; if (_sp > XB_SPIN_CAP) { atomicAdd(&(bar)[XB_TMO], 1u); break; } } } } while (0)
struct XcdBarrier { unsigned* bar; unsigned x; volatile LAS unsigned* st; };
__device__ __forceinline__ XcdBarrier xcd_barrier_post(unsigned* bar, volatile LAS unsigned* st) {
    XcdBarrier b; b.bar = bar; b.x = xb_xcc_id(); b.st = st;
    if (threadIdx.x == 0) (void)xb_add(&bar[XB_XCNT(b.x)], 1u);
    return b;
}
__device__ __forceinline__ void xcd_barrier_complete(unsigned* bar, unsigned x, unsigned& nloc, unsigned& nx) {
    const unsigned G = gridDim.x * gridDim.y * gridDim.z;
    unsigned sum, cnt, mine, sp = 0u;
    for (;;) {
        sum = 0u; cnt = 0u; mine = 0u;
#pragma unroll
        for (unsigned j = 0; j < 16; ++j) { const unsigned c = xb_ld(&bar[XB_XCNT(j)]); sum += c; cnt += (c > 0u) ? 1u : 0u; mine = (j == x) ? c : mine; }
        if (sum == G) break;
        __builtin_amdgcn_s_sleep(1);
        if ((++sp & 255u) == 0u) { if (xb_ld(&bar[XB_TMO])) break; if (sp > XB_SPIN_CAP) { atomicAdd(&bar[XB_TMO], 1u); break; } }
    }
    nloc = mine > 0u ? mine : 1u; nx = cnt > 0u ? cnt : 1u;
}
__device__ __forceinline__ void xcd_barrier(const XcdBarrier& b) {
    asm volatile("s_waitcnt vmcnt(0)" ::: "memory");
    __syncthreads();
    if (threadIdx.x == 0) {
        unsigned* bar = b.bar;
        __builtin_amdgcn_s_waitcnt(0);
        unsigned nloc = b.st[0], nx = b.st[1];
        if (nloc == 0u) { xcd_barrier_complete(bar, b.x, nloc, nx); b.st[0] = nloc; b.st[1] = nx; }
        const unsigned old = xb_add(&bar[XB_XSUB(b.x)], 1u);
        const unsigned gen = old / nloc;
        if (old + 1u == (gen + 1u) * nloc) {
            __builtin_amdgcn_fence(__ATOMIC_RELEASE, "agent");
            asm volatile("s_waitcnt vmcnt(0)" ::: "memory");
            const unsigned og = xb_add(&bar[XB_TOP], 1u);
            const unsigned tg = og / nx;
            if (og + 1u == (tg + 1u) * nx) xb_add(&bar[XB_TOPGEN], 1u);
            else XB_SPIN(xb_ld(&bar[XB_TOPGEN]) == tg, bar);
            __builtin_amdgcn_fence(__ATOMIC_ACQUIRE, "agent");
            xb_add(&bar[XB_XGEN(b.x)], 1u);
            asm volatile("s_waitcnt vmcnt(0)" ::: "memory");
        } else {
            XB_SPIN(xb_ld(&bar[XB_XGEN(b.x)]) == gen, bar);
            __builtin_amdgcn_fence(__ATOMIC_ACQUIRE, "agent");
            asm volatile("s_waitcnt vmcnt(0)" ::: "memory");
        }
    }
    __syncthreads();
}

#ifndef REP_ATT
#define REP_ATT 1
#endif
#ifndef REP_SCAN
#define REP_SCAN 1
#endif
#ifndef REP_G1
#define REP_G1 1
#endif
#ifndef REP_P3
#define REP_P3 1
#endif
#ifndef REP_RD
#define REP_RD 1
#endif
#ifndef REP_G0
#define REP_G0 1
#endif
#ifndef REP_P1
#define REP_P1 1
#endif
#ifndef REP_SYNC
#define REP_SYNC 1
#endif
#ifndef REP_G2
#define REP_G2 1
#endif
#ifndef REP_FIN
#define REP_FIN 1
#endif
struct Args { const float* in[22]; float* out; unsigned char* ws; };
__global__ void __launch_bounds__(512, 2) mk_fwd(Args a) {
    extern __shared__ __attribute__((aligned(16))) unsigned char lds_raw[];
    cg::grid_group grid = cg::this_grid();
    LAS unsigned char* lds = (LAS unsigned char*)lds_raw;
    Ctx C;
    C.x = a.in[0]; C.c = a.in[1]; C.ctx = a.in[2]; C.c_ctx = a.in[3]; C.mod_w = a.in[4]; C.mod_b = a.in[5]; C.pre_g = a.in[6]; C.post_g = a.in[7]; C.w_in = a.in[8]; C.w_out = a.in[9];
    C.w0 = a.in[10]; C.w_up = a.in[11]; C.a0 = a.in[12]; C.a_up = a.in[13]; C.k_k = a.in[14]; C.k_a = a.in[15]; C.r_k = a.in[16]; C.ln_g = a.in[17]; C.ln_b = a.in[18]; C.conv_w = a.in[19];
    C.dlam = a.in[20]; C.subg = a.in[21]; C.out = a.out;
    unsigned char* ws = a.ws;
    C.WinT = (bf16_t*)(ws + WS_WIN); C.WoutT = (bf16_t*)(ws + WS_WOUT); C.WupT = (bf16_t*)(ws + WS_WUP); C.mod = (float*)(ws + WS_MOD); C.rope = (float*)(ws + WS_ROPE);
    C.xc1 = (float*)(ws + WS_XC1); C.H = (bf16_t*)(ws + WS_H); C.P = (bf16_t*)(ws + WS_P); C.Y = (bf16_t*)(ws + WS_P); C.SC = (float*)(ws + WS_SC); C.YS = (float*)(ws + WS_YS);
    const int tid = threadIdx.x, wid = __builtin_amdgcn_readfirstlane(tid >> 6), G = gridDim.x, bx = blockIdx.x;
#define lane (opaque(tid) & 63)
    const int gw0 = bx * 8 + wid, ngw = G * 8;
#define gw opaque_s(gw0)

    if (bx == 0) for (int i = tid; i < 4096; i += 512) ((unsigned*)ws)[i] = 0u;
    if (tid < 2) ((volatile LAS unsigned*)(lds + 131072 + 1024))[tid] = 0u;
    __syncthreads();
#ifdef PROBE_A
    unsigned long long tprev = __builtin_amdgcn_s_memrealtime(); float tacc[9] = {0.f, 0.f, 0.f, 0.f, 0.f, 0.f, 0.f, 0.f, 0.f};
#define STAMP(k) do { const unsigned long long tn_ = __builtin_amdgcn_s_memrealtime(); tacc[k] += (float)(tn_ - tprev) * 0.01f; tprev = tn_; } while (0)
#else
#define STAMP(k) do { } while (0)
#endif
#ifndef NO_G0
    for (int rep = 0; rep < REP_G0; ++rep) g0_prologue(C, lds);
#endif
    grid.sync(); STAMP(0);
    const XcdBarrier xbar = xcd_barrier_post((unsigned*)ws, (volatile LAS unsigned*)(lds + 131072 + 1024));
#define GSYNC() xcd_barrier(xbar)
#pragma unroll 1
    for (int hf = 0; hf < 2; ++hf) {
#pragma unroll 1
        for (int l = 0; l < 2; ++l) {
#ifndef NO_NORM
            for (int rep = 0; rep < REP_P1; ++rep) { if (l == 0) norm_phase<0>(C, hf, gw, ngw, lane); else norm_phase<1>(C, hf, gw, ngw, lane); }
#endif
            for (int rep = 0; rep < REP_SYNC; ++rep) GSYNC();
            STAMP(1);
            { pg8::Gemm g{C.H, C.WinT + (size_t)l * DIN * DM, MH, DIN, DM}; pg8::StaticOrder S;
              if (l == 0) S.init(MH, DIN, G, bx); else { S.init(LATH, DIN, G, bx); S.nxt0 = LATH / 256; S.nxtra = CTXH / 256; }
#ifndef NO_GEMM1
              pg8::EpiBf16 E{C.P, DIN}; for (int rep = 0; rep < REP_G1; ++rep) pg8::gemm_phase<pg8::EpiBf16, true>(lds, g, S, E);
#endif
            }
            GSYNC(); STAMP(2);
#ifndef NO_PREP
            for (int rep = 0; rep < REP_P3; ++rep) for (int t = bx; t < MH / 64; t += G) prep_block(C, l, t, lds);
#endif
            for (int r4 = gw; r4 < MH / 4; r4 += ngw) { const bool do_conv = (l == 0) || (r4 < LATH / 4); if (do_conv || r4 < LATH / 4) rowpass4(C, l, r4 * 4, lane, do_conv); }
            GSYNC(); STAMP(3);
#ifndef NO_SCAN
            unsigned* sdone = (unsigned*)ws + 3840 + (hf * 2 + l) * 64;
            { unsigned nscan = 0;
              if (G == 256) { if (((bx >> 3) & 1) == 0) { scan_chunked(C, l, (bx >> 4) * 8 + (bx & 7), lds); nscan = 1; } } else { for (int u = bx; u < 128; u += G) { scan_chunked(C, l, u, lds); ++nscan; } }
              if (nscan) { asm volatile("s_waitcnt vmcnt(0)" ::: "memory"); __syncthreads();
                  if (tid == 0) { __builtin_amdgcn_fence(__ATOMIC_RELEASE, "agent"); asm volatile("s_waitcnt vmcnt(0)" ::: "memory");
                                  (void)__hip_atomic_fetch_add(sdone, nscan, __ATOMIC_RELAXED, __HIP_MEMORY_SCOPE_AGENT); } } }
#endif
            STAMP(4);
#ifndef NO_ATT
            {
                float lam;
                { const int ln = opaque(lane); const float* dl = C.dlam + l * 256; const float sa = wave_sum_dpp(dl[ln] * dl[64 + ln]), sb = wave_sum_dpp(dl[128 + ln] * dl[192 + ln]);
                  lam = fexp2(1.4426950408889634f * sa) - fexp2(1.4426950408889634f * sb) + ((l == 0) ? 0.2f : 0.35550906759f); }
                unsigned* qctr = (unsigned*)ws + 3584 + (hf * 2 + l) * 64;
                volatile LAS unsigned* qslot = (volatile LAS unsigned*)(lds + 131072 + 1024 + 64);
                const int nunits = (l == 0) ? 1024 + 128 : 1024;
                for (;;) {
                    if (tid == 0) qslot[0] = __hip_atomic_fetch_add(qctr, 1u, __ATOMIC_RELAXED, __HIP_MEMORY_SCOPE_AGENT);
                    __syncthreads();
                    const int u = (int)qslot[0];
                    __syncthreads();
                    if (u >= nunits) break;
                    if (u < 1024) { const int bl = u >> 6, hd = (u >> 4) & 3, qb = u & 15;
                        attn_unit(C, l, hd, bl * SEQ + qb * 128, bl * SEQ, LATH + bl * CTX, 32, 36, lam, (char*)lds_raw); }
                    else { const int v = u - 1024; const int bl = v >> 3, hd = (v >> 1) & 3, qb = v & 1;
                        attn_unit(C, l, hd, LATH + bl * CTX + qb * 128, 0, LATH + bl * CTX, 0, 4, lam, (char*)lds_raw); }
                }
            }
#endif
            STAMP(5);
            {
                volatile LAS unsigned* qslot = (volatile LAS unsigned*)(lds + 131072 + 1024 + 64);
                if (tid == 0) { unsigned sp = 0;
                    while (__hip_atomic_load(sdone, __ATOMIC_RELAXED, __HIP_MEMORY_SCOPE_AGENT) < 128u) { __builtin_amdgcn_s_sleep(4); if (++sp > (1u << 22)) break; }
                    __builtin_amdgcn_fence(__ATOMIC_ACQUIRE, "agent"); asm volatile("s_waitcnt vmcnt(0)" ::: "memory"); }
                __syncthreads();
                unsigned* rq = sdone + 16;
                const int nch = ((l == 0) ? MH : LATH) / 64;
                for (;;) {
                    if (tid == 0) qslot[0] = __hip_atomic_fetch_add(rq, 1u, __ATOMIC_RELAXED, __HIP_MEMORY_SCOPE_AGENT);
                    __syncthreads();
                    const int ch = (int)qslot[0];
                    __syncthreads();
                    if (ch >= nch) break;
#pragma unroll 1
                    for (int i = 0; i < 4; ++i) { const int r = ch * 64 + wid * 8 + i * 2; readout_row(C, l, r, lane); readout_row(C, l, r + 1, lane); }
                }
            }
            GSYNC(); STAMP(6);
            { const int M5 = (l == 0) ? MH : LATH; pg8::Gemm g{C.H, C.WoutT + (size_t)l * DM * DM, M5, DM, DM}; pg8::StaticOrder S; S.init(M5, DM, G, bx);
#ifndef NO_GEMM2
              pg8::EpiBf16 E{C.Y, DM}; for (int rep = 0; rep < REP_G2; ++rep) pg8::gemm_phase<pg8::EpiBf16, true>(lds, g, S, E);
#endif
            }
            GSYNC(); STAMP(7);
        }
#ifdef PROBE_A
        norm_phase<2>(C, hf, gw, ngw, lane, 2e-3f * tacc[PROBE_A], 1e-3f * tacc[PROBE_B]); STAMP(8);
#else
        norm_phase<2>(C, hf, gw, ngw, lane);
#endif
    }
#undef gw
#undef lane
}

extern "C" void kernel_launch(void* const* d_in, const int* in_sizes, int n_in, void* d_out, int out_size, void* d_ws, size_t ws_size, hipStream_t stream) {
    static int grid = 0;
    if (grid == 0) {
        if (n_in != 22 || ws_size < WS_END) { fprintf(stderr, "kernel_launch: unexpected n_in %d / ws %zu\n", n_in, ws_size); grid = -1; return; }
        int dev = 0, cus = 0, per_cu = 0;
        hipGetDevice(&dev); hipDeviceGetAttribute(&cus, hipDeviceAttributeMultiprocessorCount, dev);
        if (hipFuncSetAttribute((const void*)mk_fwd, hipFuncAttributeMaxDynamicSharedMemorySize, LDS_BYTES) != hipSuccess) { fprintf(stderr, "kernel_launch: hipFuncSetAttribute failed\n"); grid = -1; return; }
        if (hipOccupancyMaxActiveBlocksPerMultiprocessor(&per_cu, (const void*)mk_fwd, 512, LDS_BYTES) != hipSuccess || per_cu < 1) { fprintf(stderr, "kernel_launch: occupancy query says %d\n", per_cu); per_cu = 1; }
        (void)hipGetLastError();
        grid = cus * 1;
    }
    if (grid < 0) return;
    Args a{};
    for (int i = 0; i < 22; ++i) a.in[i] = (const float*)d_in[i];
    a.out = (float*)d_out; a.ws = (unsigned char*)d_ws;
    void* args[] = {&a};
    hipError_t e = hipLaunchCooperativeKernel((const void*)mk_fwd, dim3(grid), dim3(512), args, LDS_BYTES, stream);
    if (e != hipSuccess) fprintf(stderr, "cooperative launch failed: %s (grid %d)\n", hipGetErrorString(e), grid);
}
```
